# Optimizing an MI355X kernel written in HIP

```python
import math, functools
import jax, jax.numpy as jnp
from jax import lax
import numpy as np

D_MODEL = 2048
BATCH = 8
SEQ = 2048
DEPTH = 2

N_HEADS = 16
HEAD_DIM = D_MODEL // N_HEADS
NSA_KV_GROUPS = 4
NSA_Q_PER_GROUP = N_HEADS // NSA_KV_GROUPS
CMP_BLOCK = 32
CMP_STRIDE = 16
CMP_HIDDEN = 256
SEL_BLOCK = 64
SEL_TOP_N = 16
WINDOW = 512
ATTN_QBLOCK = 128
SEL_QBLOCK = 16
FOX_KV_HEADS = 4
FOX_Q_PER_KV = N_HEADS // FOX_KV_HEADS
N_EXPERTS = 32
N_EXPERT_GROUPS = 4
EXPERTS_PER_GROUP = N_EXPERTS // N_EXPERT_GROUPS
TOP_K = 2
D_EXPERT = 1024
MOE_BLOCK = 256
RMS_EPS = 1e-6
N_A_LAYERS = DEPTH // 2
N_B_LAYERS = DEPTH - N_A_LAYERS
NSA_KV_W = NSA_KV_GROUPS * HEAD_DIM
NSA_IN_W = D_MODEL + 6 * NSA_KV_W + 3 * N_HEADS
FOX_KV_W = FOX_KV_HEADS * HEAD_DIM
SHARED_IN_W = 2 * FOX_KV_W + N_HEADS

kernel_name = "yoco_nsa_fox_grouped_moe"


def _rmsnorm(x, g):
    xf = x.astype(jnp.float32)
    y = xf * lax.rsqrt(jnp.mean(xf * xf, axis=-1, keepdims=True) + RMS_EPS)
    return (y * g.astype(jnp.float32)).astype(x.dtype)


def _masked_softmax(s, mask, axis):
    s = jnp.where(mask, s.astype(jnp.float32), -jnp.inf)
    m = jnp.max(s, axis=axis, keepdims=True)
    m = jnp.where(jnp.isfinite(m), m, 0.0)
    e = jnp.exp(s - m)
    d = jnp.sum(e, axis=axis, keepdims=True)
    return e / jnp.where(d > 0, d, 1.0)


def _alibi_slopes():
    sl = 2.0 ** (-8.0 * np.arange(1, N_HEADS + 1) / N_HEADS)
    return jnp.asarray(sl, jnp.float32).reshape(NSA_KV_GROUPS, NSA_Q_PER_GROUP)


def _cmp_to_sel_matrix(n_cmp, n_sel):
    cs = np.arange(n_cmp)[:, None] * CMP_STRIDE
    ce = cs + CMP_BLOCK
    ss = np.arange(n_sel)[None, :] * SEL_BLOCK
    se = ss + SEL_BLOCK
    ov = np.clip(np.minimum(ce, se) - np.maximum(cs, ss), 0, None) / CMP_BLOCK
    return jnp.asarray(ov, jnp.float32)


def _compress(x, pe, w1, w2):
    B, T, G, hd = x.shape
    n_cmp = (T - CMP_BLOCK) // CMP_STRIDE + 1
    idx = np.arange(n_cmp)[:, None] * CMP_STRIDE + np.arange(CMP_BLOCK)[None, :]
    blocks = x[:, idx] + pe[None, None, :, None, :]
    flat = jnp.moveaxis(blocks, 3, 2).reshape(B, n_cmp, G, CMP_BLOCK * hd)
    return jax.nn.gelu(flat @ w1) @ w2


def _nsa(h, w_in, pe_k, pe_v, w1_k, w2_k, w1_v, w2_v, w_out, slopes):
    B, T, _ = h.shape
    G, R, hd = NSA_KV_GROUPS, NSA_Q_PER_GROUP, HEAD_DIM
    dt = h.dtype
    proj = h @ w_in
    cuts = [D_MODEL + i * NSA_KV_W for i in range(7)]
    q, kc, vc, ks, vs, kw, vw, gl = jnp.split(proj, cuts, axis=-1)
    q = q.reshape(B, T, G, R, hd) * (hd ** -0.5)
    kc, vc, ks, vs, kw, vw = [a.reshape(B, T, G, hd) for a in (kc, vc, ks, vs, kw, vw)]
    gates = jax.nn.sigmoid(gl.astype(jnp.float32)).reshape(B, T, G, R, 3).astype(dt)
    t_pos = jnp.arange(T)

    kcmp = _compress(kc, pe_k, w1_k, w2_k)
    vcmp = _compress(vc, pe_v, w1_v, w2_v)
    n_cmp = kcmp.shape[1]
    cmp_end = jnp.arange(n_cmp) * CMP_STRIDE + CMP_BLOCK - 1
    dist_c = t_pos[:, None] - cmp_end[None, :]
    s_c = jnp.einsum('btgrd,bngd->bgrtn', q, kcmp).astype(jnp.float32)
    s_c = s_c - slopes[:, :, None, None] * dist_c.astype(jnp.float32)
    p_cmp = _masked_softmax(s_c, dist_c >= 0, -1)
    o_cmp = jnp.einsum('bgrtn,bngd->btgrd', p_cmp.astype(dt), vcmp)

    n_sel = T // SEL_BLOCK
    imp = jnp.einsum('bgrtn,nj->bgtj', p_cmp, _cmp_to_sel_matrix(n_cmp, n_sel))
    cur = t_pos // SEL_BLOCK
    jb = jnp.arange(n_sel)
    forced = (jb[None, :] == 0) | (jb[None, :] == cur[:, None]) | (jb[None, :] == cur[:, None] - 1)
    imp = jnp.where(jb[None, :] > cur[:, None], -jnp.inf, jnp.where(forced, jnp.inf, imp))
    n_top = min(SEL_TOP_N, n_sel)
    _, sel_idx = lax.top_k(imp, n_top)

    ks_blk = ks.reshape(B, n_sel, SEL_BLOCK, G, hd).transpose(0, 3, 1, 2, 4)
    vs_blk = vs.reshape(B, n_sel, SEL_BLOCK, G, hd).transpose(0, 3, 1, 2, 4)
    nq = T // SEL_QBLOCK
    q_c = q.reshape(B, nq, SEL_QBLOCK, G, R, hd).transpose(1, 0, 2, 3, 4, 5)
    idx_c = sel_idx.reshape(B, G, nq, SEL_QBLOCK, n_top).transpose(2, 0, 1, 3, 4)
    t_c = t_pos.reshape(nq, SEL_QBLOCK)
    bi = jnp.arange(B)[:, None, None, None]
    gi = jnp.arange(G)[None, :, None, None]
    in_blk = jnp.arange(SEL_BLOCK)

    def sel_step(args):
        qb, ib, tb = args
        kg = ks_blk[bi, gi, ib]
        vg = vs_blk[bi, gi, ib]
        pos = ib[..., None] * SEL_BLOCK + in_blk
        dist = (tb[None, None, :, None, None] - pos)[:, :, None]
        s = jnp.einsum('bqgrd,bgqnld->bgrqnl', qb, kg).astype(jnp.float32)
        s = s - slopes[None, :, :, None, None, None] * dist.astype(jnp.float32)
        p = _masked_softmax(s, dist >= 0, (-2, -1))
        return jnp.einsum('bgrqnl,bgqnld->bqgrd', p.astype(dt), vg)

    o_slc = lax.map(sel_step, (q_c, idx_c, t_c))
    o_slc = o_slc.transpose(1, 0, 2, 3, 4, 5).reshape(B, T, G, R, hd)

    kw_p = jnp.pad(kw, ((0, 0), (WINDOW, 0), (0, 0), (0, 0)))
    vw_p = jnp.pad(vw, ((0, 0), (WINDOW, 0), (0, 0), (0, 0)))
    nb = T // ATTN_QBLOCK
    span = WINDOW + ATTN_QBLOCK
    q_w = q.reshape(B, nb, ATTN_QBLOCK, G, R, hd).transpose(1, 0, 2, 3, 4, 5)

    def win_step(args):
        qb, bidx = args
        q0 = bidx * ATTN_QBLOCK
        kb = lax.dynamic_slice_in_dim(kw_p, q0, span, axis=1)
        vb = lax.dynamic_slice_in_dim(vw_p, q0, span, axis=1)
        tq = q0 + jnp.arange(ATTN_QBLOCK)
        sk = q0 - WINDOW + jnp.arange(span)
        dist = tq[:, None] - sk[None, :]
        mask = (dist >= 0) & (dist < WINDOW) & (sk[None, :] >= 0)
        s = jnp.einsum('bqgrd,bkgd->bgrqk', qb, kb).astype(jnp.float32)
        s = s - slopes[:, :, None, None] * dist.astype(jnp.float32)
        p = _masked_softmax(s, mask, -1)
        return jnp.einsum('bgrqk,bkgd->bqgrd', p.astype(dt), vb)

    o_win = lax.map(win_step, (q_w, jnp.arange(nb)))
    o_win = o_win.transpose(1, 0, 2, 3, 4, 5).reshape(B, T, G, R, hd)

    o = gates[..., 0, None] * o_cmp + gates[..., 1, None] * o_slc + gates[..., 2, None] * o_win
    return o.reshape(B, T, D_MODEL) @ w_out


def _shared_kv(x, g_kv, w_kv, b_f):
    B, T, _ = x.shape
    h = _rmsnorm(x, g_kv)
    k, v, f = jnp.split(h @ w_kv, [FOX_KV_W, 2 * FOX_KV_W], axis=-1)
    logf = jax.nn.log_sigmoid(f.astype(jnp.float32) + b_f.astype(jnp.float32))
    c = jnp.cumsum(logf, axis=1)
    return (k.reshape(B, T, FOX_KV_HEADS, HEAD_DIM),
            v.reshape(B, T, FOX_KV_HEADS, HEAD_DIM), c)


def _fox(h, w_q, w_out, k_sh, v_sh, c_sh):
    B, T, _ = h.shape
    Gb, Rb, hd = FOX_KV_HEADS, FOX_Q_PER_KV, HEAD_DIM
    dt = h.dtype
    q = (h @ w_q).reshape(B, T, Gb, Rb, hd) * (hd ** -0.5)
    c = c_sh.reshape(B, T, Gb, Rb)
    c_key = c.transpose(0, 2, 3, 1)
    nb = T // ATTN_QBLOCK
    q_b = q.reshape(B, nb, ATTN_QBLOCK, Gb, Rb, hd).transpose(1, 0, 2, 3, 4, 5)
    c_b = c.reshape(B, nb, ATTN_QBLOCK, Gb, Rb).transpose(1, 0, 2, 3, 4)
    k_pos = jnp.arange(T)

    def step(args):
        qb, cb, bidx = args
        tq = bidx * ATTN_QBLOCK + jnp.arange(ATTN_QBLOCK)
        s = jnp.einsum('bqgrd,bkgd->bgrqk', qb, k_sh).astype(jnp.float32)
        s = s + cb.transpose(0, 2, 3, 1)[..., None] - c_key[:, :, :, None, :]
        p = _masked_softmax(s, tq[:, None] >= k_pos[None, :], -1)
        return jnp.einsum('bgrqk,bkgd->bqgrd', p.astype(dt), v_sh)

    o = lax.map(step, (q_b, c_b, jnp.arange(nb)))
    return o.transpose(1, 0, 2, 3, 4, 5).reshape(B, T, D_MODEL) @ w_out


def _route(h2, w_router, b_router):
    probs = jax.nn.softmax((h2 @ w_router).astype(jnp.float32), axis=-1)
    sel = probs + b_router.astype(jnp.float32)
    grp = sel.reshape(-1, N_EXPERT_GROUPS, EXPERTS_PER_GROUP)
    grp_score = jnp.sum(lax.top_k(grp, 2)[0], axis=-1)
    best_g = jnp.argmax(grp_score, axis=-1)
    in_group = (jnp.arange(N_EXPERTS) // EXPERTS_PER_GROUP)[None, :] == best_g[:, None]
    _, e_idx = lax.top_k(jnp.where(in_group, sel, -jnp.inf), TOP_K)
    w = jnp.take_along_axis(probs, e_idx, axis=-1)
    return e_idx, w / jnp.sum(w, axis=-1, keepdims=True)


def _moe(h, w_router, b_router, w_gate, w_up, w_down):
    B, T, D = h.shape
    h2 = h.reshape(B * T, D)
    n_tok = B * T
    n_asg = n_tok * TOP_K
    e_idx, e_w = _route(h2, w_router, b_router)
    flat_e = e_idx.reshape(-1)
    flat_tok = jnp.arange(n_asg, dtype=jnp.int32) // TOP_K
    order = jnp.argsort(flat_e)
    e_sorted = flat_e[order]
    tok_sorted = flat_tok[order]
    w_sorted = e_w.reshape(-1)[order]
    counts = jnp.bincount(flat_e, length=N_EXPERTS)
    padded = (counts + MOE_BLOCK - 1) // MOE_BLOCK * MOE_BLOCK
    pad_end = jnp.cumsum(padded)
    pad_start = pad_end - padded
    start = jnp.cumsum(counts) - counts
    dest = pad_start[e_sorted] + jnp.arange(n_asg) - start[e_sorted]
    n_blocks = -(-(n_asg + N_EXPERTS * (MOE_BLOCK - 1)) // MOE_BLOCK)
    buf_tok = jnp.zeros((n_blocks * MOE_BLOCK,), jnp.int32).at[dest].set(tok_sorted)
    block_e = jnp.minimum(
        jnp.searchsorted(pad_end, jnp.arange(n_blocks) * MOE_BLOCK, side='right'), N_EXPERTS - 1)
    xb = h2[buf_tok].reshape(n_blocks, MOE_BLOCK, D)

    def expert_block(args):
        xe, e = args
        return (jax.nn.silu(xe @ w_gate[e]) * (xe @ w_up[e])) @ w_down[e]

    yb = lax.map(expert_block, (xb, block_e)).reshape(-1, D)
    y = yb[dest] * w_sorted[:, None].astype(h.dtype)
    return jnp.zeros_like(h2).at[tok_sorted].add(y).reshape(B, T, D)


def setup_inputs(seed: int = 0) -> dict:
    key = jax.random.key(seed)
    ks = jax.random.split(key, 22)
    nrm = lambda k, shape, scale: jax.random.normal(k, shape, jnp.float32) * scale
    D, hd, E, F = D_MODEL, HEAD_DIM, N_EXPERTS, D_EXPERT
    out_scale = D ** -0.5 * (2 * DEPTH) ** -0.5
    return {
        "x": nrm(ks[0], (BATCH, SEQ, D), 1.0),
        "nsa_w_in": nrm(ks[1], (N_A_LAYERS, D, NSA_IN_W), D ** -0.5),
        "nsa_pe_k": nrm(ks[2], (N_A_LAYERS, CMP_BLOCK, hd), 0.1),
        "nsa_pe_v": nrm(ks[3], (N_A_LAYERS, CMP_BLOCK, hd), 0.1),
        "nsa_cmp_w1_k": nrm(ks[4], (N_A_LAYERS, CMP_BLOCK * hd, CMP_HIDDEN), (CMP_BLOCK * hd) ** -0.5),
        "nsa_cmp_w2_k": nrm(ks[5], (N_A_LAYERS, CMP_HIDDEN, hd), CMP_HIDDEN ** -0.5),
        "nsa_cmp_w1_v": nrm(ks[6], (N_A_LAYERS, CMP_BLOCK * hd, CMP_HIDDEN), (CMP_BLOCK * hd) ** -0.5),
        "nsa_cmp_w2_v": nrm(ks[7], (N_A_LAYERS, CMP_HIDDEN, hd), CMP_HIDDEN ** -0.5),
        "nsa_w_out": nrm(ks[8], (N_A_LAYERS, D, D), out_scale),
        "shared_norm": 1.0 + nrm(ks[9], (D,), 0.02),
        "shared_w_kv": nrm(ks[10], (D, SHARED_IN_W), D ** -0.5),
        "shared_b_f": 2.0 + nrm(ks[11], (N_HEADS,), 0.5),
        "fox_w_q": nrm(ks[12], (N_B_LAYERS, D, D), D ** -0.5),
        "fox_w_out": nrm(ks[13], (N_B_LAYERS, D, D), out_scale),
        "attn_norm": 1.0 + nrm(ks[14], (DEPTH, D), 0.02),
        "ffn_norm": 1.0 + nrm(ks[15], (DEPTH, D), 0.02),
        "router_w": nrm(ks[16], (D, E), D ** -0.5),
        "router_b": nrm(ks[17], (E,), 0.01),
        "moe_w_gate": nrm(ks[18], (DEPTH, E, D, F), D ** -0.5),
        "moe_w_up": nrm(ks[19], (DEPTH, E, D, F), D ** -0.5),
        "moe_w_down": nrm(ks[20], (DEPTH, E, F, D), F ** -0.5 * (2 * DEPTH) ** -0.5),
        "final_norm": 1.0 + nrm(ks[21], (D,), 0.02),
    }


def reference(x, nsa_w_in, nsa_pe_k, nsa_pe_v, nsa_cmp_w1_k, nsa_cmp_w2_k, nsa_cmp_w1_v,
              nsa_cmp_w2_v, nsa_w_out, shared_norm, shared_w_kv, shared_b_f, fox_w_q,
              fox_w_out, attn_norm, ffn_norm, router_w, router_b, moe_w_gate, moe_w_up,
              moe_w_down, final_norm):
    slopes = _alibi_slopes()
    k_sh = v_sh = c_sh = None
    for layer in range(DEPTH):
        h = _rmsnorm(x, attn_norm[layer])
        if layer < N_A_LAYERS:
            a = layer
            x = x + _nsa(h, nsa_w_in[a], nsa_pe_k[a], nsa_pe_v[a], nsa_cmp_w1_k[a],
                         nsa_cmp_w2_k[a], nsa_cmp_w1_v[a], nsa_cmp_w2_v[a], nsa_w_out[a], slopes)
        else:
            b = layer - N_A_LAYERS
            x = x + _fox(h, fox_w_q[b], fox_w_out[b], k_sh, v_sh, c_sh)
        h = _rmsnorm(x, ffn_norm[layer])
        x = x + _moe(h, router_w, router_b, moe_w_gate[layer], moe_w_up[layer], moe_w_down[layer])
        if layer == N_A_LAYERS - 1:
            k_sh, v_sh, c_sh = _shared_kv(x, shared_norm, shared_w_kv, shared_b_f)
    return _rmsnorm(x, final_norm)
```

```cpp
#include <hip/hip_runtime.h>
#include <cstdint>
#include <cstdio>

#ifndef MK_LAUNCHES
#define MK_LAUNCHES 1
#endif

namespace {

typedef unsigned short bf16_t;
typedef short bf16x8 __attribute__((ext_vector_type(8)));
typedef short s16x4 __attribute__((ext_vector_type(4)));
typedef float f32x4 __attribute__((ext_vector_type(4)));
typedef float f32x16 __attribute__((ext_vector_type(16)));
typedef unsigned u32x4 __attribute__((ext_vector_type(4)));
typedef unsigned u32x2 __attribute__((ext_vector_type(2)));

constexpr int NTOK = 16384, DM = 2048, SEQ = 2048, NBATCH = 8, NH = 16, HD = 128;
constexpr int NSA_IN_W = 5168, KV6_W = 3072, NEXP = 32, DEXP = 1024, LISTCAP = 32768;
constexpr int NTHREADS = 512;
constexpr float LOG2E = 1.4426950408889634f;
constexpr float QSCALE = 0.08838834764831845f;
constexpr float RMS_EPS = 1e-6f;
constexpr int LDS_BYTES = 147456;
constexpr int NPHASES = 17;

constexpr size_t al256(size_t x) { return (x + 255) & ~(size_t)255; }
constexpr size_t WS_CTL   = 0;
constexpr size_t CTL_BYTES = 65536;
constexpr size_t WS_WIN   = WS_CTL + CTL_BYTES;
constexpr size_t WS_CW1   = WS_WIN + (size_t)5376 * 2048 * 2;
constexpr size_t WS_WOUT  = WS_CW1 + (size_t)2 * 256 * 4096 * 2;
constexpr size_t WS_WKVQ  = WS_WOUT + (size_t)2048 * 2048 * 2;
constexpr size_t WS_WFO   = WS_WKVQ + (size_t)3072 * 2048 * 2;
constexpr size_t WS_GU    = WS_WFO + (size_t)2048 * 2048 * 2;
constexpr size_t WS_DN    = WS_GU + (size_t)2 * 32 * 2048 * 2048 * 2;
constexpr size_t WS_BIAS1 = WS_DN + (size_t)2 * 32 * 2048 * 1024 * 2;
constexpr size_t WS_RW    = WS_BIAS1 + 2 * 256 * 4;
constexpr size_t WS_WF    = WS_RW + (size_t)2 * 2048 * 32 * 4;
constexpr size_t WS_XBA   = al256(WS_WF + (size_t)2048 * 32 * 4);
constexpr size_t WS_XBB   = WS_XBA + (size_t)NTOK * DM * 2;
constexpr size_t WS_Q     = WS_XBB + (size_t)NTOK * DM * 2;
constexpr size_t WS_KV6   = WS_Q + (size_t)NTOK * DM * 2;
constexpr size_t WS_GATES = WS_KV6 + (size_t)NTOK * KV6_W * 2;
constexpr size_t WS_CPART = WS_GATES + (size_t)NTOK * 48 * 4;
constexpr size_t WS_KVCMP = WS_CPART + (size_t)2 * 8 * 4096 * 256 * 4;
constexpr size_t WS_OATT  = WS_KVCMP + (size_t)2 * 8 * 128 * 512 * 2;
constexpr size_t WS_X1    = WS_OATT + (size_t)NTOK * DM * 2;
constexpr size_t WS_X2    = WS_X1 + (size_t)NTOK * DM * 4;
constexpr size_t WS_H     = WS_X2 + (size_t)NTOK * DM * 4;
constexpr size_t WS_Y     = WS_H + (size_t)40960 * 1024 * 2;
constexpr size_t WS_LIST  = WS_Y + (size_t)32768 * 2048 * 2;
constexpr size_t WS_EW    = WS_LIST + (size_t)2 * 32 * LISTCAP * 4;
constexpr size_t WS_RSTD  = WS_EW + (size_t)2 * NTOK * 2 * 4;
constexpr size_t WS_KV2   = WS_RSTD + (size_t)3 * NTOK * 4;
constexpr size_t WS_LOGF  = WS_KV2 + (size_t)NTOK * 1024 * 2;
constexpr size_t WS_C2    = WS_LOGF + (size_t)NTOK * 16 * 4;
constexpr size_t WS_END   = WS_C2 + (size_t)8 * 16 * 2048 * 4;
constexpr int CW_BAR = 0;
constexpr int CW_CNT = 4096;
constexpr int CW_END = CW_CNT + 2 * 32 * 64;
static_assert(CW_END * 4 <= (int)CTL_BYTES, "ctl");

struct Params {
    const float* in[22];
    float* out;
    unsigned char* ws;
    int ph_lo, ph_hi;
};

__device__ __forceinline__ unsigned cvtpk(float lo, float hi) {
    unsigned r; asm volatile("v_cvt_pk_bf16_f32 %0, %1, %2" : "=v"(r) : "v"(lo), "v"(hi)); return r;
}
__device__ __forceinline__ float bflo(unsigned w) { return __uint_as_float(w << 16); }
__device__ __forceinline__ float bfhi(unsigned w) { return __uint_as_float(w & 0xffff0000u); }
__device__ __forceinline__ bf16x8 pack8(f32x4 a, f32x4 b) {
    u32x4 w = {cvtpk(a[0], a[1]), cvtpk(a[2], a[3]), cvtpk(b[0], b[1]), cvtpk(b[2], b[3])};
    return *reinterpret_cast<bf16x8*>(&w);
}
__device__ __forceinline__ float wave_sum(float v) {
#pragma unroll
    for (int o = 32; o >= 1; o >>= 1) v += __shfl_xor(v, o);
    return v;
}
__device__ __forceinline__ float fast_exp2(float x) { return __builtin_amdgcn_exp2f(x); }
__device__ __forceinline__ float fast_rcp(float x) { return __builtin_amdgcn_rcpf(x); }

__device__ __forceinline__ const void* uniform_ptr(const void* p) {
    const unsigned long long a = (unsigned long long)p;
    const unsigned lo = __builtin_amdgcn_readfirstlane((unsigned)a), hi = __builtin_amdgcn_readfirstlane((unsigned)(a >> 32));
    return (const void*)(((unsigned long long)hi << 32) | lo);
}
__device__ __forceinline__ void glds16(unsigned voff, const void* sbase, unsigned ldsaddr) {
    unsigned keep; sbase = uniform_ptr(sbase); ldsaddr = __builtin_amdgcn_readfirstlane(ldsaddr);
    asm volatile("s_mov_b32 %0, m0\n\ts_mov_b32 m0, %3\n\ts_nop 0\n\tglobal_load_lds_dwordx4 %1, %2\n\ts_mov_b32 m0, %0"
                 : "=&s"(keep) : "v"(voff), "s"(sbase), "s"(ldsaddr) : "memory");
}
__device__ __forceinline__ void glds4(unsigned voff, const void* sbase, unsigned ldsaddr) {
    unsigned keep; sbase = uniform_ptr(sbase); ldsaddr = __builtin_amdgcn_readfirstlane(ldsaddr);
    asm volatile("s_mov_b32 %0, m0\n\ts_mov_b32 m0, %3\n\ts_nop 0\n\tglobal_load_lds_dword %1, %2\n\ts_mov_b32 m0, %0"
                 : "=&s"(keep) : "v"(voff), "s"(sbase), "s"(ldsaddr) : "memory");
}
__device__ __forceinline__ unsigned lds_addr(const void* p) { return (unsigned)(size_t)(__attribute__((address_space(3))) const char*)p; }

#define XB_TMO      128
#define XB_XCNT(j)  (256  + 64 * (j))
#define XB_XSUB(j)  (1280 + 64 * (j))
#define XB_XGEN(j)  (2304 + 64 * (j))
#define XB_TOP      3328
#define XB_TOPGEN   3392
#define XCD_BAR_WORDS 3456
#define XB_SPIN_CAP (1u << 20)
#define LAS __attribute__((address_space(3)))

__device__ __forceinline__ unsigned xb_ld(unsigned* p)              { return __hip_atomic_load(p, __ATOMIC_RELAXED, __HIP_MEMORY_SCOPE_AGENT); }
__device__ __forceinline__ unsigned xb_add(unsigned* p, unsigned v) { return __hip_atomic_fetch_add(p, v, __ATOMIC_RELAXED, __HIP_MEMORY_SCOPE_AGENT); }
__device__ __forceinline__ unsigned xb_xcc_id() { return (unsigned)__builtin_amdgcn_s_getreg((3 << 11) | 20) & 0xFu; }
#define XB_SPIN(cond, bar) do { unsigned _sp = 0; while (cond) { __builtin_amdgcn_s_sleep(1); \
    if ((++_sp & 255u) == 0u) { if (xb_ld(&(bar)[XB_TMO])) break; if (_sp > XB_SPIN_CAP) { atomicAdd(&(bar)[XB_TMO], 1u); break; } } } } while (0)

struct XcdBarrier { unsigned* bar; unsigned x; volatile LAS unsigned* st; };

__device__ __forceinline__ XcdBarrier xcd_barrier_post(unsigned* bar, volatile LAS unsigned* st) {
    XcdBarrier b; b.bar = bar; b.x = xb_xcc_id(); b.st = st;
    if (threadIdx.x == 0) (void)xb_add(&bar[XB_XCNT(b.x)], 1u);
    return b;
}
__device__ __forceinline__ void xcd_barrier_complete(unsigned* bar, unsigned x, unsigned& nloc, unsigned& nx) {
    const unsigned G = gridDim.x * gridDim.y * gridDim.z;
    unsigned sum, cnt, mine, sp = 0u;
    for (;;) {
        sum = 0u; cnt = 0u; mine = 0u;
#pragma unroll
        for (unsigned j = 0; j < 16; ++j) { const unsigned c = xb_ld(&bar[XB_XCNT(j)]); sum += c; cnt += (c > 0u) ? 1u : 0u; mine = (j == x) ? c : mine; }
        if (sum == G) break;
        __builtin_amdgcn_s_sleep(1);
        if ((++sp & 255u) == 0u) { if (xb_ld(&bar[XB_TMO])) break; if (sp > XB_SPIN_CAP) { atomicAdd(&bar[XB_TMO], 1u); break; } }
    }
    nloc = mine > 0u ? mine : 1u; nx = cnt > 0u ? cnt : 1u;
}
__device__ __forceinline__ void xcd_barrier(const XcdBarrier& b) {
    asm volatile("s_waitcnt vmcnt(0)" ::: "memory");
    __syncthreads();
    if (threadIdx.x == 0) {
        unsigned* bar = b.bar;
        __builtin_amdgcn_s_waitcnt(0);
        unsigned nloc = b.st[0], nx = b.st[1];
        if (nloc == 0u) { xcd_barrier_complete(bar, b.x, nloc, nx); b.st[0] = nloc; b.st[1] = nx; }
        const unsigned old = xb_add(&bar[XB_XSUB(b.x)], 1u);
        const unsigned gen = old / nloc;
        if (old + 1u == (gen + 1u) * nloc) {
            __builtin_amdgcn_fence(__ATOMIC_RELEASE, "agent");
            asm volatile("s_waitcnt vmcnt(0)" ::: "memory");
            const unsigned og = xb_add(&bar[XB_TOP], 1u);
            const unsigned tg = og / nx;
            if (og + 1u == (tg + 1u) * nx) xb_add(&bar[XB_TOPGEN], 1u);
            else XB_SPIN(xb_ld(&bar[XB_TOPGEN]) == tg, bar);
            __builtin_amdgcn_fence(__ATOMIC_ACQUIRE, "agent");
            xb_add(&bar[XB_XGEN(b.x)], 1u);
            asm volatile("s_waitcnt vmcnt(0)" ::: "memory");
        } else {
            XB_SPIN(xb_ld(&bar[XB_XGEN(b.x)]) == gen, bar);
            __builtin_amdgcn_fence(__ATOMIC_ACQUIRE, "agent");
            asm volatile("s_waitcnt vmcnt(0)" ::: "memory");
        }
    }
    __syncthreads();
}

__device__ __forceinline__ int lds_byte(int r, int c) { const int st = (r >> 4) * 2 + (c >> 5), rr = r & 15, cc = c & 31, ob = rr * 64 + cc * 2; return st * 1024 + (ob ^ (((ob >> 9) & 1) << 5)); }
__device__ __forceinline__ void stage_rc(int b, int& R, int& C) { const int st = b / 1024, sb = b % 1024, swz = sb ^ (((sb >> 9) & 1) << 5); R = (st >> 1) * 16 + swz / 64; C = (st & 1) * 32 + (swz % 64) / 2; }
__device__ __forceinline__ int perm32(int rho) { const int n = rho >> 4, i = rho & 15; return 8 * (i >> 2) + 4 * n + (i & 3); }

typedef f32x4 AccT[2][2][4][2];

#define G_SA(b, h) (ldsb + (((b) * 2 + (h)) * 16384))
#define G_SB(b, h) (ldsb + ((4 + (b) * 2 + (h)) * 16384))
#define AKOFF(t) ((size_t)((unsigned)((t) >> 1) * astep2 + (unsigned)((t) & 1) * 128u))
#define STAGE_A(buf, h, t) do { const char* _p = Ab + AKOFF(t); \
    glds16((h) ? ao2 : ao0, _p, ldsw + ((buf) * 2 + (h)) * 16384); glds16((h) ? ao3 : ao1, _p, ldsw + ((buf) * 2 + (h)) * 16384 + 8192); } while (0)
#define STAGE_B(buf, h, t) do { const char* _p = Bb + (size_t)(h) * 128 * ldb + (size_t)(t) * 128u; \
    glds16(bo, _p, ldsw + (4 + (buf) * 2 + (h)) * 16384); glds16(bo, _p + (size_t)64 * ldb, ldsw + (4 + (buf) * 2 + (h)) * 16384 + 8192); } while (0)
#define LDA(dst, b, h) for (int m = 0; m < 4; ++m) for (int k = 0; k < 2; ++k) \
    dst[m][k] = *reinterpret_cast<const bf16x8*>(G_SA(b, h) + lds_byte(wr * 64 + m * 16 + fr, k * 32 + fq * 8))
#define LDB(dst, b, h) for (int n = 0; n < 2; ++n) for (int k = 0; k < 2; ++k) \
    dst[n][k] = *reinterpret_cast<const bf16x8*>(G_SB(b, h) + lds_byte(wc * 32 + n * 16 + fr, k * 32 + fq * 8))
#define MMA(ai, bj, At_, Bt_) do { __builtin_amdgcn_s_setprio(1); \
    for (int m = 0; m < 4; ++m) for (int n = 0; n < 2; ++n) for (int k = 0; k < 2; ++k) \
      acc[ai][bj][m][n] = __builtin_amdgcn_mfma_f32_16x16x32_bf16(Bt_[n][k], At_[m][k], acc[ai][bj][m][n], 0, 0, 0); \
    __builtin_amdgcn_s_setprio(0); } while (0)
#define WAIT_V(n) asm volatile("s_waitcnt vmcnt(" #n ")" ::: "memory")
#define WAIT_L(n) asm volatile("s_waitcnt lgkmcnt(" #n ")" ::: "memory")
#define BAR __builtin_amdgcn_s_barrier()
#define SCHED __builtin_amdgcn_sched_barrier(0)

template <bool PERM, class Epi>
__device__ __forceinline__ void gemm256(unsigned char* lds, const char* __restrict__ Ab, const char* __restrict__ Bb, const unsigned ldb,
                                        const unsigned astep2, const int nt, const unsigned ao0, const unsigned ao1, const unsigned ao2,
                                        const unsigned ao3, const Epi& epi) {
    char* ldsb = (char*)lds;
    int tid = threadIdx.x;
    const unsigned ldsw = lds_addr(lds) + (unsigned)__builtin_amdgcn_readfirstlane(tid >> 6) * 1024u;
    int wid = tid >> 6, lane = tid & 63, wr = wid >> 2, wc = wid & 3, fr = lane & 15, fq = lane >> 4;
    unsigned bo; { int R, C; stage_rc(tid * 16, R, C); const int pr = PERM ? ((R & ~31) | perm32(R & 31)) : R; bo = (unsigned)pr * ldb + (unsigned)C * 2u; }
    AccT acc = {};
    bf16x8 At[4][2], B0[2][2], B1[2][2];
    STAGE_B(0, 0, 0); STAGE_A(0, 0, 0);
    STAGE_B(0, 1, 0); STAGE_A(0, 1, 0);
    if (wr == 1) BAR;
    WAIT_V(4); BAR;
    STAGE_B(1, 0, 1); STAGE_A(1, 0, 1); STAGE_B(1, 1, 1);
    WAIT_V(6); BAR;
    for (int t = 0; t < nt - 2; t += 2) {
        LDB(B0, 0, 0); SCHED; LDA(At, 0, 0); STAGE_A(1, 1, t + 1);
        WAIT_L(8); BAR; WAIT_L(0); MMA(0, 0, At, B0); BAR; SCHED;
        LDB(B1, 0, 1); STAGE_B(0, 0, t + 2);
        BAR; WAIT_L(0); MMA(0, 1, At, B1); BAR;
        LDA(At, 0, 1); STAGE_A(0, 0, t + 2);
        BAR; WAIT_L(0); MMA(1, 0, At, B0); BAR; SCHED;
        STAGE_B(0, 1, t + 2);
        WAIT_V(6); BAR; MMA(1, 1, At, B1); BAR;
        LDB(B0, 1, 0); SCHED; LDA(At, 1, 0); STAGE_A(0, 1, t + 2);
        WAIT_L(8); BAR; WAIT_L(0); MMA(0, 0, At, B0); BAR; SCHED;
        LDB(B1, 1, 1); STAGE_B(1, 0, t + 3);
        BAR; WAIT_L(0); MMA(0, 1, At, B1); BAR;
        LDA(At, 1, 1); STAGE_A(1, 0, t + 3);
        BAR; WAIT_L(0); MMA(1, 0, At, B0); BAR; SCHED;
        STAGE_B(1, 1, t + 3);
        WAIT_V(6); BAR; MMA(1, 1, At, B1); BAR;
    }
    { int tz = threadIdx.x; asm volatile("" : "+v"(tz)); tid = tz; wid = tz >> 6; lane = tz & 63; wr = wid >> 2; wc = wid & 3; fr = lane & 15; fq = lane >> 4; }
    { LDB(B0, 0, 0); WAIT_V(0); LDA(At, 0, 0); STAGE_A(1, 1, nt - 1);
      BAR; WAIT_L(0); MMA(0, 0, At, B0); BAR;
      LDB(B1, 0, 1); BAR; WAIT_L(0); MMA(0, 1, At, B1); BAR;
      LDA(At, 0, 1); WAIT_V(4); BAR; WAIT_L(0); MMA(1, 0, At, B0); MMA(1, 1, At, B1); BAR; }
    { LDB(B0, 1, 0); LDA(At, 1, 0); WAIT_V(2); BAR; WAIT_L(0); MMA(0, 0, At, B0); BAR;
      LDB(B1, 1, 1); WAIT_V(0); BAR; WAIT_L(0); MMA(0, 1, At, B1); BAR;
      LDA(At, 1, 1); BAR; WAIT_L(0); MMA(1, 0, At, B0); MMA(1, 1, At, B1); BAR; }
    if (wr == 0) BAR;
    epi(acc, wr, wc, fr, fq);
    __syncthreads();
}

__device__ __forceinline__ void tile_order(int L, int nM, int nN, int& pm, int& pn) {
    const int nwg = nM * nN; int wgid = L;
    { const int q = nwg / 8, r = nwg % 8, xcd = wgid % 8, off = wgid / 8; wgid = (xcd < r ? xcd * (q + 1) : r * (q + 1) + (xcd - r) * q) + off; }
    const int nig = 8 * nN, gid = wgid / nig, fm = gid * 8, gsz = (nM - fm) < 8 ? (nM - fm) : 8;
    pm = fm + ((wgid % nig) % gsz); pn = (wgid % nig) / gsz;
}
__device__ __forceinline__ void stage_row_col(int tid, int& R0, int& C) { stage_rc(tid * 16, R0, C); }


__device__ __forceinline__ u32x4 pack8v(f32x4 a, f32x4 b) { u32x4 w = {cvtpk(a[0], a[1]), cvtpk(a[2], a[3]), cvtpk(b[0], b[1]), cvtpk(b[2], b[3])}; return w; }
__device__ __forceinline__ float sigmoidf_(float x) { return fast_rcp(1.f + fast_exp2(-x * LOG2E)); }

struct EpiProj0 {
    bf16_t* Q; bf16_t* KV6; float* gates; int row0, pn;
    __device__ __forceinline__ void operator()(const AccT& acc, int wr, int wc, int fr, int fq) const {
#pragma unroll
        for (int ai = 0; ai < 2; ++ai)
#pragma unroll
            for (int m = 0; m < 4; ++m) {
                const size_t row = (size_t)(row0 + ai * 128 + wr * 64 + m * 16 + fr);
#pragma unroll
                for (int bj = 0; bj < 2; ++bj) {
                    const int col8 = bj * 128 + wc * 32 + 8 * fq;
                    f32x4 v0 = acc[ai][bj][m][0], v1 = acc[ai][bj][m][1];
                    if (pn < 8) { v0 *= QSCALE; v1 *= QSCALE; *(u32x4*)(Q + row * DM + pn * 256 + col8) = pack8v(v0, v1); }
                    else if (pn < 20) { *(u32x4*)(KV6 + row * KV6_W + (pn - 8) * 256 + col8) = pack8v(v0, v1); }
                    else if (col8 < 48) {
                        f32x4 s0, s1;
#pragma unroll
                        for (int j = 0; j < 4; ++j) { s0[j] = sigmoidf_(v0[j]); s1[j] = sigmoidf_(v1[j]); }
                        *(f32x4*)(gates + row * 48 + col8) = s0; *(f32x4*)(gates + row * 48 + col8 + 4) = s1;
                    }
                }
            }
    }
};
struct EpiF32 {
    float* C;
    __device__ __forceinline__ void operator()(const AccT& acc, int wr, int wc, int fr, int fq) const {
#pragma unroll
        for (int ai = 0; ai < 2; ++ai)
#pragma unroll
            for (int m = 0; m < 4; ++m) {
                float* rowp = C + (size_t)(ai * 128 + wr * 64 + m * 16 + fr) * 256 + wc * 32 + 4 * fq;
#pragma unroll
                for (int bj = 0; bj < 2; ++bj)
#pragma unroll
                    for (int n = 0; n < 2; ++n) *(f32x4*)(rowp + bj * 128 + n * 16) = acc[ai][bj][m][n];
            }
    }
};
struct EpiOut {
    const float* xold; float* xnew; bf16_t* xb; int row0, col0;
    __device__ __forceinline__ void operator()(const AccT& acc, int wr, int wc, int fr, int fq) const {
#pragma unroll
        for (int ai = 0; ai < 2; ++ai)
#pragma unroll
            for (int m = 0; m < 4; ++m) {
                const size_t row = (size_t)(row0 + ai * 128 + wr * 64 + m * 16 + fr);
#pragma unroll
                for (int bj = 0; bj < 2; ++bj) {
                    const size_t off = row * DM + col0 + bj * 128 + wc * 32 + 8 * fq;
                    f32x4 v0 = acc[ai][bj][m][0] + *(const f32x4*)(xold + off), v1 = acc[ai][bj][m][1] + *(const f32x4*)(xold + off + 4);
                    *(f32x4*)(xnew + off) = v0; *(f32x4*)(xnew + off + 4) = v1;
                    *(u32x4*)(xb + off) = pack8v(v0, v1);
                }
            }
    }
};
struct EpiKVQ {
    bf16_t* KV2; bf16_t* Q; const float* rstd; int row0, pn;
    __device__ __forceinline__ void operator()(const AccT& acc, int wr, int wc, int fr, int fq) const {
#pragma unroll
        for (int ai = 0; ai < 2; ++ai)
#pragma unroll
            for (int m = 0; m < 4; ++m) {
                const size_t row = (size_t)(row0 + ai * 128 + wr * 64 + m * 16 + fr);
                float rs = rstd[row]; if (pn >= 4) rs *= QSCALE;
#pragma unroll
                for (int bj = 0; bj < 2; ++bj) {
                    const int col8 = bj * 128 + wc * 32 + 8 * fq;
                    const f32x4 v0 = acc[ai][bj][m][0] * rs, v1 = acc[ai][bj][m][1] * rs;
                    if (pn < 4) *(u32x4*)(KV2 + row * 1024 + pn * 256 + col8) = pack8v(v0, v1);
                    else *(u32x4*)(Q + row * DM + (pn - 4) * 256 + col8) = pack8v(v0, v1);
                }
            }
    }
};
struct EpiGU {
    bf16_t* H; const int* list; const float* rstd; int hrow0, pn, nvalid;
    __device__ __forceinline__ void operator()(const AccT& acc, int wr, int wc, int fr, int fq) const {
#pragma unroll
        for (int ai = 0; ai < 2; ++ai)
#pragma unroll
            for (int m = 0; m < 4; ++m) {
                const int lr = ai * 128 + wr * 64 + m * 16 + fr;
                if (lr < nvalid) {
                    const float rs = rstd[list[lr] >> 1];
                    f32x4 h0, h1;
#pragma unroll
                    for (int j = 0; j < 4; ++j) {
                        const float g0 = acc[ai][0][m][0][j] * rs, u0 = acc[ai][1][m][0][j] * rs, g1 = acc[ai][0][m][1][j] * rs, u1 = acc[ai][1][m][1][j] * rs;
                        h0[j] = g0 * sigmoidf_(g0) * u0; h1[j] = g1 * sigmoidf_(g1) * u1;
                    }
                    *(u32x4*)(H + (size_t)(hrow0 + lr) * DEXP + pn * 128 + wc * 32 + 8 * fq) = pack8v(h0, h1);
                }
            }
    }
};
struct EpiDN {
    bf16_t* Y; const int* list; int pn, nvalid;
    __device__ __forceinline__ void operator()(const AccT& acc, int wr, int wc, int fr, int fq) const {
#pragma unroll
        for (int ai = 0; ai < 2; ++ai)
#pragma unroll
            for (int m = 0; m < 4; ++m) {
                const int lr = ai * 128 + wr * 64 + m * 16 + fr;
                if (lr < nvalid) {
                    bf16_t* rowp = Y + (size_t)list[lr] * DM + pn * 256 + wc * 32 + 8 * fq;
#pragma unroll
                    for (int bj = 0; bj < 2; ++bj) *(u32x4*)(rowp + bj * 128) = pack8v(acc[ai][bj][m][0], acc[ai][bj][m][1]);
                }
            }
    }
};

struct CvtJob { const float* src; bf16_t* dst; const float* gain; int K, ld, ncols, tilesN, tilesKN; size_t srcE, dstE; int pA, pB, pC; };
constexpr int NJOBS = 13;
__device__ __forceinline__ int job_tiles(int j) {
    switch (j) { case 0: return 16 * 81; case 1: case 2: return 32 * 4; case 3: return 16 * 32; case 4: return 16 * 16; case 5: case 6: return 16 * 32; default: return 8192; }
}
__device__ __forceinline__ void get_job(const Params& P, int j, CvtJob& J) {
    unsigned char* ws = P.ws;
    J.gain = nullptr; J.srcE = 0; J.dstE = 0; J.pA = 1 << 30; J.pB = 0; J.pC = 0;
    const int l = (j >= 10) ? 1 : 0;
    switch (j) {
    case 0: J.src = P.in[1]; J.dst = (bf16_t*)(ws + WS_WIN); J.K = 2048; J.ld = 5168; J.ncols = 5168; break;
    case 1: J.src = P.in[4]; J.dst = (bf16_t*)(ws + WS_CW1); J.K = 4096; J.ld = 256; J.ncols = 256; break;
    case 2: J.src = P.in[6]; J.dst = (bf16_t*)(ws + WS_CW1) + (size_t)256 * 4096; J.K = 4096; J.ld = 256; J.ncols = 256; break;
    case 3: J.src = P.in[8]; J.dst = (bf16_t*)(ws + WS_WOUT); J.K = 2048; J.ld = 2048; J.ncols = 2048; break;
    case 4: J.src = P.in[10]; J.dst = (bf16_t*)(ws + WS_WKVQ); J.K = 2048; J.ld = 1040; J.ncols = 1024; J.gain = P.in[9]; break;
    case 5: J.src = P.in[12]; J.dst = (bf16_t*)(ws + WS_WKVQ) + (size_t)1024 * 2048; J.K = 2048; J.ld = 2048; J.ncols = 2048; J.gain = P.in[14] + DM; break;
    case 6: J.src = P.in[13]; J.dst = (bf16_t*)(ws + WS_WFO); J.K = 2048; J.ld = 2048; J.ncols = 2048; break;
    case 7: case 10: J.src = P.in[18] + (size_t)l * 32 * 2048 * 1024; J.dst = (bf16_t*)(ws + WS_GU) + (size_t)l * 32 * 2048 * 2048; J.K = 2048; J.ld = 1024; J.ncols = 1024;
        J.gain = P.in[15] + l * DM; J.srcE = (size_t)2048 * 1024; J.dstE = (size_t)2048 * 2048; J.pA = 128; J.pB = 256; J.pC = 0; break;
    case 8: case 11: J.src = P.in[19] + (size_t)l * 32 * 2048 * 1024; J.dst = (bf16_t*)(ws + WS_GU) + (size_t)l * 32 * 2048 * 2048; J.K = 2048; J.ld = 1024; J.ncols = 1024;
        J.gain = P.in[15] + l * DM; J.srcE = (size_t)2048 * 1024; J.dstE = (size_t)2048 * 2048; J.pA = 128; J.pB = 256; J.pC = 128; break;
    default: J.src = P.in[20] + (size_t)l * 32 * 1024 * 2048; J.dst = (bf16_t*)(ws + WS_DN) + (size_t)l * 32 * 2048 * 1024; J.K = 1024; J.ld = 2048; J.ncols = 2048;
        J.srcE = (size_t)1024 * 2048; J.dstE = (size_t)2048 * 1024; break;
    }
    J.tilesN = (J.ncols + 63) / 64; J.tilesKN = J.tilesN * (J.K / 128);
}
__device__ __forceinline__ void cvt_tile(const CvtJob& J, int idx, float* T  ) {
    const int tid = threadIdx.x;
    const int e = idx / J.tilesKN, rem = idx - e * J.tilesKN, ktile = rem / J.tilesN, ntile = rem - ktile * J.tilesN;
    const float* src = J.src + (size_t)e * J.srcE; bf16_t* dst = J.dst + (size_t)e * J.dstE;
    const int k0 = ktile * 128, n0 = ntile * 64;
    {
        const int nn = (tid & 15) * 4; const bool okc = (n0 + nn) < J.ncols;
#pragma unroll
        for (int p = 0; p < 4; ++p) {
            const int kk = (tid >> 4) + 32 * p;
            f32x4 v = {0.f, 0.f, 0.f, 0.f};
            if (okc) v = *(const f32x4*)(src + (size_t)(k0 + kk) * J.ld + n0 + nn);
            if (J.gain) v *= J.gain[k0 + kk];
            float* t = T + kk * 65 + nn; t[0] = v[0]; t[1] = v[1]; t[2] = v[2]; t[3] = v[3];
        }
    }
    __syncthreads();
    {
        const int kc = (tid & 15) * 8;
#pragma unroll
        for (int p = 0; p < 2; ++p) {
            const int n = (tid >> 4) + 32 * p, ng = n0 + n;
            if (ng < J.ncols) {
                const float* t = T + kc * 65 + n;
                f32x4 a = {t[0], t[65], t[130], t[195]}, b = {t[260], t[325], t[390], t[455]};
                const int drow = (ng / J.pA) * J.pB + J.pC + (ng % J.pA);
                *(u32x4*)(dst + (size_t)drow * J.K + k0 + kc) = pack8v(a, b);
            }
        }
    }
    __syncthreads();
}
__device__ __forceinline__ void phase_convert(const Params& P, unsigned char* lds, int jlo, int jhi) {
    float* T = (float*)lds;
    int base = 0;
    for (int j = 0; j < jlo; ++j) base += job_tiles(j);
    int total = base;
    for (int j = jlo; j < jhi; ++j) total += job_tiles(j);
    int jcur = -1, jbase = 0, jend = 0; CvtJob J;
    for (int g = base + blockIdx.x; g < total; g += gridDim.x) {
        if (jcur < 0 || g >= jend) {
            int b2 = 0; int j = 0;
            for (; j < NJOBS; ++j) { const int n = job_tiles(j); if (g < b2 + n) break; b2 += n; }
            jcur = j; jbase = b2; jend = b2 + job_tiles(j); get_job(P, j, J);
        }
        cvt_tile(J, g - jbase, T);
    }
}
__device__ __forceinline__ void phase0_misc(const Params& P, unsigned char* lds) {
    unsigned char* ws = P.ws;
    const int tid = threadIdx.x, lane = tid & 63, wave = tid >> 6;
    {
        const float* x = P.in[0]; const float* gain = P.in[14]; bf16_t* h0 = (bf16_t*)(ws + WS_XBA);
        for (int row = blockIdx.x * 8 + wave; row < NTOK; row += gridDim.x * 8) {
            const float* xr = x + (size_t)row * DM + lane * 4;
            f32x4 v[8]; float ss = 0.f;
#pragma unroll
            for (int j = 0; j < 8; ++j) { v[j] = *(const f32x4*)(xr + j * 256); ss += v[j][0] * v[j][0] + v[j][1] * v[j][1] + v[j][2] * v[j][2] + v[j][3] * v[j][3]; }
            ss = wave_sum(ss);
            const float rstd = rsqrtf(ss * (1.f / DM) + RMS_EPS);
#pragma unroll
            for (int j = 0; j < 8; ++j) {
                const f32x4 gv = *(const f32x4*)(gain + j * 256 + lane * 4);
                const f32x4 o = v[j] * rstd * gv;
                u32x2 w = {cvtpk(o[0], o[1]), cvtpk(o[2], o[3])};
                *(u32x2*)(h0 + (size_t)row * DM + j * 256 + lane * 4) = w;
            }
        }
    }
    {
        float* rw = (float*)(ws + WS_RW); float* wf = (float*)(ws + WS_WF);
        const int gtid = blockIdx.x * NTHREADS + tid, gsz = gridDim.x * NTHREADS;
        for (int i = gtid; i < 2 * 2048 * 32; i += gsz) { const int l = i >> 16, k = (i >> 5) & 2047, e = i & 31; rw[i] = P.in[15][l * DM + k] * P.in[16][k * 32 + e]; }
        for (int i = gtid; i < 2048 * 32; i += gsz) { const int k = i >> 5, j = i & 31; wf[i] = (j < 16) ? P.in[9][k] * P.in[10][(size_t)k * 1040 + 1024 + j] : 0.f; }
    }
    if (blockIdx.x < 2) {
        const int kv = blockIdx.x; const float* pe = P.in[kv ? 3 : 2]; const float* w1 = P.in[kv ? 6 : 4];
        float* red = (float*)lds;
        const int j = tid & 255, half = tid >> 8; float s = 0.f;
        for (int i = half * 2048; i < half * 2048 + 2048; ++i) s += pe[i] * w1[(size_t)i * 256 + j];
        red[tid] = s; __syncthreads();
        if (tid < 256) ((float*)(ws + WS_BIAS1))[kv * 256 + tid] = red[tid] + red[tid + 256];
        __syncthreads();
    }
}

__device__ __forceinline__ void lin_offsets(int tid, unsigned lda, unsigned& a0, unsigned& a1, unsigned& a2, unsigned& a3) {
    int R0, C; stage_rc(tid * 16, R0, C);
    a0 = (unsigned)R0 * lda + C * 2; a1 = (unsigned)(R0 + 64) * lda + C * 2; a2 = (unsigned)(R0 + 128) * lda + C * 2; a3 = (unsigned)(R0 + 192) * lda + C * 2;
}
__device__ __forceinline__ void phase_proj0(const Params& P, unsigned char* lds) {
    unsigned char* ws = P.ws;
    unsigned a0, a1, a2, a3; lin_offsets(threadIdx.x, DM * 2, a0, a1, a2, a3);
    for (int L = blockIdx.x; L < 64 * 21; L += gridDim.x) {
        int pm, pn; tile_order(L, 64, 21, pm, pn);
        EpiProj0 E{(bf16_t*)(ws + WS_Q), (bf16_t*)(ws + WS_KV6), (float*)(ws + WS_GATES), pm * 256, pn};
        gemm256<true>(lds, (const char*)(ws + WS_XBA) + (size_t)pm * 256 * DM * 2, (const char*)(ws + WS_WIN) + (size_t)pn * 256 * DM * 2, DM * 2, 256u, DM / 64, a0, a1, a2, a3, E);
    }
}
__device__ __forceinline__ void phase_cmp1(const Params& P, unsigned char* lds) {
    unsigned char* ws = P.ws;
    int R0, C; stage_rc(threadIdx.x * 16, R0, C);
    for (int u = blockIdx.x; u < 256; u += gridDim.x) {
        const int kv = u >> 7, mt = (u >> 3) & 15, ks = u & 7;
        unsigned ao[4];
#pragma unroll
        for (int q = 0; q < 4; ++q) {
            int r = mt * 256 + R0 + 64 * q; if (r > 4063) r = 4063;
            const int b = r / 508, rem = r - b * 508, n = rem >> 2, g = rem & 3;
            ao[q] = (unsigned)(((b * SEQ + n * 16) * KV6_W + kv * 512 + g * 128 + C) * 2);
        }
        EpiF32 E{(float*)(ws + WS_CPART) + ((size_t)(kv * 8 + ks) * 4096 + mt * 256) * 256};
        gemm256<false>(lds, (const char*)(ws + WS_KV6) + (size_t)ks * 4 * KV6_W * 2, (const char*)(ws + WS_CW1) + ((size_t)kv * 256 * 4096 + ks * 512) * 2, 4096 * 2,
                       (unsigned)(KV6_W * 2), 8, ao[0], ao[1], ao[2], ao[3], E);
    }
}
__device__ __forceinline__ float gelu_tanh(float x) {
    const float u = 0.7978845608028654f * (x + 0.044715f * x * x * x);
    const float t = 1.f - 2.f * fast_rcp(1.f + fast_exp2(2.f * LOG2E * u));
    return 0.5f * x * (1.f + t);
}
__device__ __forceinline__ void phase_cmp2(const Params& P, unsigned char* lds) {
    unsigned char* ws = P.ws;
    const int tid = threadIdx.x;
    float* hid = (float*)lds;
    const float* part = (const float*)(ws + WS_CPART);
    bf16_t* kvc = (bf16_t*)(ws + WS_KVCMP);
    for (int grp = blockIdx.x; grp < 256; grp += gridDim.x) {
        const int kv = grp >> 7, r0 = (grp & 127) * 32;
        {
            const int col = tid & 255, i0 = tid >> 8;
            const float bias = ((const float*)(ws + WS_BIAS1))[kv * 256 + col];
#pragma unroll 4
            for (int ii = 0; ii < 16; ++ii) {
                const int i = i0 + 2 * ii, r = r0 + i;
                float s = bias;
#pragma unroll
                for (int ks = 0; ks < 8; ++ks) s += part[((size_t)(kv * 8 + ks) * 4096 + r) * 256 + col];
                hid[i * 256 + col] = gelu_tanh(s);
            }
        }
        __syncthreads();
        {
            const float* w2 = P.in[kv ? 7 : 5];
            const int j = tid & 127, i0 = tid >> 7;
            float acc[8];
#pragma unroll
            for (int ii = 0; ii < 8; ++ii) acc[ii] = 0.f;
            for (int k = 0; k < 256; k += 4) {
                const float w0 = w2[(k + 0) * 128 + j], w1 = w2[(k + 1) * 128 + j], w2v = w2[(k + 2) * 128 + j], w3 = w2[(k + 3) * 128 + j];
#pragma unroll
                for (int ii = 0; ii < 8; ++ii) {
                    const f32x4 h = *(const f32x4*)(hid + (i0 + 4 * ii) * 256 + k);
                    acc[ii] += h[0] * w0 + h[1] * w1 + h[2] * w2v + h[3] * w3;
                }
            }
#pragma unroll
            for (int ii = 0; ii < 8; ++ii) {
                const int r = r0 + i0 + 4 * ii;
                if (r < 4064) {
                    const int b = r / 508, rem = r - b * 508, n = rem >> 2, g = rem & 3;
                    const float v = acc[ii], vn = __shfl_xor(v, 1);
                    if ((j & 1) == 0) *(unsigned*)(kvc + (size_t)kv * (8 * 128 * 512) + ((size_t)(b * 128 + n) * 4 + g) * 128 + j) = cvtpk(v, vn);
                }
            }
        }
        __syncthreads();
    }
    if (blockIdx.x == 0) {
        for (int i = tid; i < 2 * 8 * 512 / 2; i += NTHREADS) { const int kv = i >> 11, b = (i >> 8) & 7, c2 = i & 255;
            *(unsigned*)(kvc + (size_t)kv * (8 * 128 * 512) + ((size_t)(b * 128 + 127) * 512) + c2 * 2) = 0u; }
    }
}
__device__ __forceinline__ void phase_outproj(const Params& P, unsigned char* lds, size_t wsW, const float* xold, float* xnew, bf16_t* xb) {
    unsigned char* ws = P.ws;
    unsigned a0, a1, a2, a3; lin_offsets(threadIdx.x, DM * 2, a0, a1, a2, a3);
    for (int L = blockIdx.x; L < 64 * 8; L += gridDim.x) {
        int pm, pn; tile_order(L, 64, 8, pm, pn);
        EpiOut E{xold, xnew, xb, pm * 256, pn * 256};
        gemm256<true>(lds, (const char*)(ws + WS_OATT) + (size_t)pm * 256 * DM * 2, (const char*)(ws + wsW) + (size_t)pn * 256 * DM * 2, DM * 2, 256u, DM / 64, a0, a1, a2, a3, E);
    }
}
__device__ __forceinline__ void phase_kvq(const Params& P, unsigned char* lds) {
    unsigned char* ws = P.ws;
    unsigned a0, a1, a2, a3; lin_offsets(threadIdx.x, DM * 2, a0, a1, a2, a3);
    for (int L = blockIdx.x; L < 64 * 12; L += gridDim.x) {
        int pm, pn; tile_order(L, 64, 12, pm, pn);
        EpiKVQ E{(bf16_t*)(ws + WS_KV2), (bf16_t*)(ws + WS_Q), (const float*)(ws + WS_RSTD) + NTOK, pm * 256, pn};
        gemm256<true>(lds, (const char*)(ws + WS_XBA) + (size_t)pm * 256 * DM * 2, (const char*)(ws + WS_WKVQ) + (size_t)pn * 256 * DM * 2, DM * 2, 256u, DM / 64, a0, a1, a2, a3, E);
    }
    const int wave = threadIdx.x >> 6, lane = threadIdx.x & 63;
    for (int gw = blockIdx.x * 8 + wave; gw < 128; gw += gridDim.x * 8) {
        const int b = gw >> 4, h = gw & 15;
        const float* lf = (const float*)(ws + WS_LOGF) + ((size_t)b * SEQ + lane * 32) * 16 + h;
        float v[32]; float s = 0.f;
#pragma unroll
        for (int i = 0; i < 32; ++i) { s += lf[i * 16]; v[i] = s; }
        float incl = s;
#pragma unroll
        for (int o = 1; o < 64; o <<= 1) { const float t = __shfl_up(incl, o); if (lane >= o) incl += t; }
        const float excl = incl - s;
        float* c2 = (float*)(ws + WS_C2) + ((size_t)b * 16 + h) * SEQ + lane * 32;
#pragma unroll
        for (int i = 0; i < 32; ++i) c2[i] = (excl + v[i]) * LOG2E;
    }
}
__device__ __forceinline__ void moe_table(const unsigned* gcnt, int* tl  ) {
    if (threadIdx.x == 0) { int s = 0; for (int e = 0; e < 32; ++e) { const int c = (int)__hip_atomic_load(gcnt + e * 64, __ATOMIC_RELAXED, __HIP_MEMORY_SCOPE_AGENT); tl[40 + e] = c; tl[e] = s; s += (c + 255) >> 8; } tl[32] = s; }
    __syncthreads();
}
__device__ __forceinline__ void phase_moe_gu(const Params& P, unsigned char* lds, int layer) {
    unsigned char* ws = P.ws;
    int* tl = (int*)(lds + 131072);
    moe_table((const unsigned*)(ws + WS_CTL) + CW_CNT + layer * 32 * 64, tl);
    const int ntiles = tl[32];
    int R0, C; stage_rc(threadIdx.x * 16, R0, C);
    const float* rstd = (const float*)(ws + WS_RSTD) + (layer ? 2 * NTOK : 0);
    const char* xb = (const char*)(ws + WS_XBB);
    for (int u = blockIdx.x; u < ntiles * 8; u += gridDim.x) {
        const int ti = u >> 3, pn = u & 7;
        int e = 0;
        for (int q = 1; q < 32; ++q) if (tl[q] <= ti) e = q;
        e = __builtin_amdgcn_readfirstlane(e);
        const int mt = __builtin_amdgcn_readfirstlane(ti - tl[e]), nvalid = __builtin_amdgcn_readfirstlane(min(256, tl[40 + e] - mt * 256));
        const int* list = (const int*)(ws + WS_LIST) + ((size_t)(layer * 32 + e) * LISTCAP + mt * 256);
        unsigned ao[4];
#pragma unroll
        for (int q = 0; q < 4; ++q) { const int lr = R0 + 64 * q; const int tok = (lr < nvalid) ? (list[lr] >> 1) : 0; ao[q] = (unsigned)tok * (DM * 2) + C * 2; }
        EpiGU E{(bf16_t*)(ws + WS_H), list, rstd, ti * 256, pn, nvalid};
        gemm256<true>(lds, xb, (const char*)(ws + WS_GU) + ((size_t)(layer * 32 + e) * 2048 + pn * 256) * DM * 2, DM * 2, 256u, DM / 64, ao[0], ao[1], ao[2], ao[3], E);
    }
}
__device__ __forceinline__ void phase_moe_dn(const Params& P, unsigned char* lds, int layer) {
    unsigned char* ws = P.ws;
    int* tl = (int*)(lds + 131072);
    moe_table((const unsigned*)(ws + WS_CTL) + CW_CNT + layer * 32 * 64, tl);
    const int ntiles = tl[32];
    unsigned a0, a1, a2, a3; lin_offsets(threadIdx.x, DEXP * 2, a0, a1, a2, a3);
    for (int u = blockIdx.x; u < ntiles * 8; u += gridDim.x) {
        const int ti = u >> 3, pn = u & 7;
        int e = 0;
        for (int q = 1; q < 32; ++q) if (tl[q] <= ti) e = q;
        e = __builtin_amdgcn_readfirstlane(e);
        const int mt = __builtin_amdgcn_readfirstlane(ti - tl[e]), nvalid = __builtin_amdgcn_readfirstlane(min(256, tl[40 + e] - mt * 256));
        const int* list = (const int*)(ws + WS_LIST) + ((size_t)(layer * 32 + e) * LISTCAP + mt * 256);
        EpiDN E{(bf16_t*)(ws + WS_Y), list, pn, nvalid};
        gemm256<true>(lds, (const char*)(ws + WS_H) + (size_t)ti * 256 * DEXP * 2, (const char*)(ws + WS_DN) + ((size_t)(layer * 32 + e) * 2048 + pn * 256) * DEXP * 2, DEXP * 2, 256u,
                      DEXP / 64, a0, a1, a2, a3, E);
    }
}


constexpr int AT_V = 0, AT_K = 32768, AT_KB = 65536, AT_WS = 67584, AT_IMP = 69632, AT_VALS = 136192, AT_SEL = 144640;
#define KSWZ(row, colB) ((row) * 256 + ((colB) ^ (((row) & 7) << 4)))
__device__ __forceinline__ int v_st(int k, int c) { const int kk = (k & ~0xC) | ((k & 4) << 1) | ((k & 8) >> 1); return ((kk >> 3) * 4 + (c >> 5)) * 512 + ((kk & 7) * 32 + (c & 31)) * 2; }
__device__ __forceinline__ int v_rd_base(int lane) { return ((lane & 3) << 3) | (((lane >> 2) & 3) << 6) | (((lane >> 4) & 1) << 5) | (((lane >> 5) & 1) << 8); }
constexpr int v_rd_off(int d0, int ks, int half) { return d0 * 512 + ks * 4096 + half * 2048; }
__device__ __forceinline__ int crow(int r, int hi) { return (r & 3) + 8 * (r >> 2) + 4 * hi; }

template <int KB>
__device__ __forceinline__ void attn_qkt(f32x16& p0, f32x16& p1, const char* K_lds, int r32, int hi, const bf16x8 (&qr)[8]) {
    p0 = f32x16{}; p1 = f32x16{};
    const char* kb[4];
#pragma unroll
    for (int dd = 0; dd < 4; ++dd) kb[dd] = K_lds + KB * 16384 + KSWZ(r32, (dd * 16 + hi * 8) * 2);
#pragma unroll
    for (int d0 = 0; d0 < 8; ++d0) { const char* a = kb[d0 & 3] + (d0 >> 2) * 128;
        bf16x8 b0 = *reinterpret_cast<const bf16x8*>(a);
        bf16x8 b1 = *reinterpret_cast<const bf16x8*>(a + 32 * 256);
        p0 = __builtin_amdgcn_mfma_f32_32x32x16_bf16(b0, qr[d0], p0, 0, 0, 0);
        p1 = __builtin_amdgcn_mfma_f32_32x32x16_bf16(b1, qr[d0], p1, 0, 0, 0); }
}
template <int VB>
__device__ __forceinline__ void attn_pv(f32x16 (&o)[4], int vb0, bf16x8 pa0, bf16x8 pa1, bf16x8 pa2, bf16x8 pa3) {
#define TRRD(dst, off) asm volatile("ds_read_b64_tr_b16 %0, %1 offset:%2" : "=&v"(dst) : "v"(vb0), "i"(off) : "memory")
#define PV_D0(d0) do { s16x4 l0, l1, l2, l3, h0, h1, h2, h3; constexpr int b_ = VB * 16384 + v_rd_off(d0, 0, 0); \
        TRRD(l0, b_); TRRD(h0, b_ + 2048); TRRD(l1, b_ + 4096); TRRD(h1, b_ + 6144); TRRD(l2, b_ + 8192); TRRD(h2, b_ + 10240); TRRD(l3, b_ + 12288); TRRD(h3, b_ + 14336); \
        asm volatile("s_waitcnt lgkmcnt(0)" ::: "memory"); __builtin_amdgcn_sched_barrier(0); \
        o[d0] = __builtin_amdgcn_mfma_f32_32x32x16_bf16(pa0, (bf16x8){l0[0], l0[1], l0[2], l0[3], h0[0], h0[1], h0[2], h0[3]}, o[d0], 0, 0, 0); \
        o[d0] = __builtin_amdgcn_mfma_f32_32x32x16_bf16(pa1, (bf16x8){l1[0], l1[1], l1[2], l1[3], h1[0], h1[1], h1[2], h1[3]}, o[d0], 0, 0, 0); \
        o[d0] = __builtin_amdgcn_mfma_f32_32x32x16_bf16(pa2, (bf16x8){l2[0], l2[1], l2[2], l2[3], h2[0], h2[1], h2[2], h2[3]}, o[d0], 0, 0, 0); \
        o[d0] = __builtin_amdgcn_mfma_f32_32x32x16_bf16(pa3, (bf16x8){l3[0], l3[1], l3[2], l3[3], h3[0], h3[1], h3[2], h3[3]}, o[d0], 0, 0, 0); } while (0)
    PV_D0(0); PV_D0(1); PV_D0(2); PV_D0(3);
#undef PV_D0
#undef TRRD
}
#define PK4(P, B_, OUT) do { unsigned a0 = cvtpk(P[B_+0], P[B_+1]), a1 = cvtpk(P[B_+2], P[B_+3]); \
        unsigned b0 = cvtpk(P[B_+4], P[B_+5]), b1 = cvtpk(P[B_+6], P[B_+7]); \
        auto r0 = __builtin_amdgcn_permlane32_swap(a0, b0, false, false); auto r1 = __builtin_amdgcn_permlane32_swap(a1, b1, false, false); \
        u32x4 w = {r0[0], r1[0], r0[1], r1[1]}; OUT = *reinterpret_cast<bf16x8*>(&w); } while (0)
__device__ __forceinline__ float row_max2(float v) { auto rr = __builtin_amdgcn_permlane32_swap(__float_as_uint(v), __float_as_uint(v), false, false); return fmaxf(__uint_as_float(rr[0]), __uint_as_float(rr[1])); }
__device__ __forceinline__ float row_sum2(float v) { auto rr = __builtin_amdgcn_permlane32_swap(__float_as_uint(v), __float_as_uint(v), false, false); return __uint_as_float(rr[0]) + __uint_as_float(rr[1]); }

struct KVAddr { unsigned ldsw, ldsb, voffK, voffV, ldb; };
__device__ __forceinline__ KVAddr kv_addr(const char* lds, int tid, int wave, unsigned ldb) {
    KVAddr A; A.ldsb = lds_addr(lds); A.ldsw = A.ldsb + (unsigned)wave * 1024u; A.ldb = ldb;
    const int row = tid >> 4, cp = tid & 15;
    A.voffK = (unsigned)row * ldb + (unsigned)((cp ^ (row & 7)) * 16);
    const int k = ((tid >> 2) & 3) | (((tid >> 7) & 1) << 2) | (((tid >> 4) & 1) << 3) | (((tid >> 8) & 1) << 4);
    const int c = ((tid >> 5) & 3) * 32 + (tid & 3) * 8;
    A.voffV = (unsigned)k * ldb + (unsigned)c * 2u;
    return A;
}
template <int BUF>
__device__ __forceinline__ void kv_issue(const KVAddr& A, const bf16_t* Kp, const bf16_t* Vp, int key0, const float* ctab, int wave, int lane) {
    const char* kb = (const char*)Kp + (size_t)key0 * A.ldb; const char* vb = (const char*)Vp + (size_t)key0 * A.ldb;
    glds16(A.voffK, kb, A.ldsw + AT_K + BUF * 16384); glds16(A.voffK, kb + (size_t)32 * A.ldb, A.ldsw + AT_K + BUF * 16384 + 8192);
    glds16(A.voffV, vb, A.ldsw + AT_V + BUF * 16384); glds16(A.voffV, vb + (size_t)32 * A.ldb, A.ldsw + AT_V + BUF * 16384 + 8192);
    if (ctab != nullptr && wave < 4) glds4((unsigned)lane * 4u, ctab + (size_t)wave * SEQ + key0, A.ldsb + AT_KB + BUF * 1024 + (unsigned)wave * 256u);
}
template <int BUF>
__device__ __forceinline__ void kb_alibi(char* lds, int tid, float sl2_t, int key0) {
    if (tid < 256) ((float*)(lds + AT_KB))[BUF * 256 + tid] = -sl2_t * (float)(key0 + (tid & 63));
}
template <int BUF>
__device__ __forceinline__ void attn_tile(char* lds, const bf16x8 (&qr)[8], f32x16 (&o)[4], float& m_reg, float& l_reg, float rb, int dq, unsigned W,
                                          bool needmask, int wave, int r32, int hi, int vb0) {
    f32x16 p0, p1;
    attn_qkt<BUF>(p0, p1, lds + AT_K, r32, hi, qr);
    const float NEG = -__builtin_inff();
    {
        const float* kbp = (const float*)(lds + AT_KB) + BUF * 256 + (wave & 3) * 64 + 4 * hi;
#pragma unroll
        for (int g2 = 0; g2 < 4; ++g2) {
            const f32x4 ka = *(const f32x4*)(kbp + 8 * g2), kc = *(const f32x4*)(kbp + 32 + 8 * g2);
#pragma unroll
            for (int i = 0; i < 4; ++i) { p0[4 * g2 + i] = fmaf(p0[4 * g2 + i], LOG2E, rb - ka[i]); p1[4 * g2 + i] = fmaf(p1[4 * g2 + i], LOG2E, rb - kc[i]); }
        }
    }
    if (needmask) {
#pragma unroll
        for (int r = 0; r < 16; ++r) { const int c = (r & 3) + 8 * (r >> 2);
            if ((unsigned)(dq - c) >= W) p0[r] = NEG;
            if ((unsigned)(dq - c - 32) >= W) p1[r] = NEG; }
    }
    float pmax = p0[0];
#pragma unroll
    for (int r = 1; r < 16; ++r) pmax = fmaxf(pmax, p0[r]);
#pragma unroll
    for (int r = 0; r < 16; ++r) pmax = fmaxf(pmax, p1[r]);
    pmax = row_max2(pmax);
    const float mn = fmaxf(m_reg, pmax), alpha = fast_exp2(m_reg - mn);
    m_reg = mn;
    float ps = 0.f;
#pragma unroll
    for (int r = 0; r < 16; ++r) { p0[r] = fast_exp2(p0[r] - mn); ps += p0[r]; }
#pragma unroll
    for (int r = 0; r < 16; ++r) { p1[r] = fast_exp2(p1[r] - mn); ps += p1[r]; }
    ps = row_sum2(ps);
    l_reg = l_reg * alpha + ps;
    if (__any(alpha < 1.f)) {
        float* al = (float*)(lds + AT_WS) + wave * 64;
        if (hi == 0) al[r32] = alpha;
        asm volatile("s_waitcnt lgkmcnt(0)" ::: "memory");
#pragma unroll
        for (int g2 = 0; g2 < 4; ++g2) { const f32x4 a4 = *(const f32x4*)(al + 8 * g2 + 4 * hi);
#pragma unroll
            for (int d0 = 0; d0 < 4; ++d0)
#pragma unroll
                for (int i = 0; i < 4; ++i) o[d0][4 * g2 + i] *= a4[i]; }
    }
    bf16x8 pa0, pa1, pa2, pa3;
    PK4(p0, 0, pa0); PK4(p0, 8, pa1); PK4(p1, 0, pa2); PK4(p1, 8, pa3);
    attn_pv<BUF>(o, vb0, pa0, pa1, pa2, pa3);
}
template <bool SELB>
__device__ __forceinline__ void attn_branch(char* lds, const KVAddr& A, const bf16x8 (&qr)[8], f32x16 (&o)[4], float& m_reg, float& l_reg, unsigned tilemask,
                                            const bf16_t* Kp, const bf16_t* Vp, const float* ctab, float sl2_t, float rowb, unsigned selw,
                                            int tq, int tq0w, unsigned W, int wave, int lane, int r32, int hi, int vb0) {
    const int tid = wave * 64 + lane;
    unsigned tm = tilemask;
    int j = 31 - __builtin_clz(tm); tm &= ~(1u << j);
    kv_issue<0>(A, Kp, Vp, j * 64, ctab, wave, lane);
    if (ctab == nullptr) kb_alibi<0>(lds, tid, sl2_t, j * 64);
    const float NEG = -__builtin_inff();
#define ATT_STEP(BUF, NBUF) { \
        asm volatile("s_waitcnt vmcnt(0)" ::: "memory"); \
        __syncthreads(); \
        int jn = -1; if (tm) { jn = 31 - __builtin_clz(tm); tm &= ~(1u << jn); kv_issue<NBUF>(A, Kp, Vp, jn * 64, ctab, wave, lane); if (ctab == nullptr) kb_alibi<NBUF>(lds, tid, sl2_t, jn * 64); } \
        { const int key0 = j * 64; \
          const bool rsel = SELB ? (((selw >> j) & 1u) != 0u) : true; \
          bool active = (key0 <= tq0w + 31) && ((tq0w - key0 - 63) < (int)W); \
          if (SELB) active = active && __any(rsel); \
          if (active) { \
              const bool needmask = (key0 + 63 > tq0w) || ((unsigned)(tq0w + 31 - key0) >= W); \
              attn_tile<BUF>(lds, qr, o, m_reg, l_reg, rsel ? rowb : NEG, tq - key0 - 4 * hi, W, needmask, wave, r32, hi, vb0); } } \
        if (jn < 0) break; \
        j = jn; }
    for (;;) { ATT_STEP(0, 1) ATT_STEP(1, 0) }
#undef ATT_STEP
    __syncthreads();
}
template <bool ADD>
__device__ __forceinline__ void attn_store(bf16_t* Obase  , const f32x16 (&o)[4], char* lds, float srow, int wave, int r32, int hi) {
    float* sc = (float*)(lds + AT_WS) + wave * 64 + 32;
    if (hi == 0) sc[r32] = srow;
    asm volatile("s_waitcnt lgkmcnt(0)" ::: "memory");
#pragma unroll
    for (int g2 = 0; g2 < 4; ++g2) { const f32x4 s4 = *(const f32x4*)(sc + 8 * g2 + 4 * hi);
#pragma unroll
        for (int i = 0; i < 4; ++i) { const int r = 4 * g2 + i; const int orow = crow(r, hi);
#pragma unroll
            for (int d0 = 0; d0 < 4; ++d0) {
                float v = o[d0][r] * s4[i];
                float vn = __shfl_xor(v, 1);
                if ((r32 & 1) == 0) { unsigned* p = (unsigned*)(Obase + (size_t)orow * DM + d0 * 32 + r32);
                    if (ADD) { const unsigned old = *p; v += bflo(old); vn += bfhi(old); }
                    *p = cvtpk(v, vn); } } } }
}

__device__ __forceinline__ void nsa_unit(const Params& P, char* lds, int b, int g, int qt) {
    unsigned char* ws = P.ws;
    int tid = threadIdx.x; asm volatile("" : "+v"(tid));
    const int wave = __builtin_amdgcn_readfirstlane(tid >> 6), lane = tid & 63, r32 = lane & 31, hi = lane >> 5;
    const int head = wave & 3, h = g * 4 + head, tq0w = qt * 64 + (wave >> 2) * 32, tq = tq0w + r32;
    const int vb0 = (int)lds_addr(lds + AT_V) + v_rd_base(lane);
    const bf16_t* Qg = (const bf16_t*)(ws + WS_Q); const bf16_t* KV6 = (const bf16_t*)(ws + WS_KV6);
    const size_t tokrow = (size_t)b * SEQ + tq;
    bf16x8 qr[8];
#pragma unroll
    for (int d0 = 0; d0 < 8; ++d0) qr[d0] = *(const bf16x8*)(Qg + tokrow * DM + h * 128 + d0 * 16 + hi * 8);
    const float* gp = (const float*)(ws + WS_GATES) + tokrow * 48 + h * 3;
    const float sl2 = fast_exp2(-0.5f * (float)(h + 1)) * LOG2E;
    const float sl2_t = fast_exp2(-0.5f * (float)(g * 4 + ((tid >> 6) & 3) + 1)) * LOG2E;
    const float rowb = -sl2 * (float)tq;
    const float NEG = -__builtin_inff();
    bf16_t* Ob = (bf16_t*)(ws + WS_OATT) + ((size_t)b * SEQ + tq0w) * DM + h * 128;
    f32x16 o[4];
    {
        const KVAddr A = kv_addr(lds, tid, wave, 512 * 2);
        const bf16_t* Kc = (const bf16_t*)(ws + WS_KVCMP) + (size_t)b * 128 * 512 + g * 128;
        const bf16_t* Vc = Kc + (size_t)8 * 128 * 512;
        kv_issue<0>(A, Kc, Vc, 0, nullptr, wave, lane);
        kv_issue<1>(A, Kc, Vc, 64, nullptr, wave, lane);
        asm volatile("s_waitcnt vmcnt(0)" ::: "memory");
        __syncthreads();
        f32x16 p0, p1, p2, p3;
        attn_qkt<0>(p0, p1, lds + AT_K, r32, hi, qr);
        attn_qkt<1>(p2, p3, lds + AT_K, r32, hi, qr);
        const int lim = tq - 64 * hi; const float sb = -sl2 * (float)lim;
        float pmax = NEG;
#define CMP_BIAS(PX, N0) _Pragma("unroll") for (int r = 0; r < 16; ++r) { const int kc_ = 16 * ((N0) + (r & 3) + 8 * (r >> 2)) + 31; \
            const float v = fmaf(PX[r], LOG2E, fmaf(sl2, (float)kc_, sb)); PX[r] = (kc_ <= lim) ? v : NEG; pmax = fmaxf(pmax, PX[r]); }
        CMP_BIAS(p0, 0) CMP_BIAS(p1, 32) CMP_BIAS(p2, 64) CMP_BIAS(p3, 96)
#undef CMP_BIAS
        pmax = row_max2(pmax);
        const float mn = fmaxf(pmax, -1e30f);
        float ps = 0.f;
#pragma unroll
        for (int r = 0; r < 16; ++r) { p0[r] = fast_exp2(p0[r] - mn); p1[r] = fast_exp2(p1[r] - mn); p2[r] = fast_exp2(p2[r] - mn); p3[r] = fast_exp2(p3[r] - mn); ps += (p0[r] + p1[r]) + (p2[r] + p3[r]); }
        ps = row_sum2(ps);
        const float invl = ps > 0.f ? 1.f / ps : 0.f;
        {
            float* ia = (float*)(lds + AT_IMP) + (head * 64 + (wave >> 2) * 32 + r32) * 65;
#define IMP_W(PX, J0) _Pragma("unroll") for (int g2 = 0; g2 < 4; ++g2) { const int jj = (J0) + 2 * g2 + hi; const float hb = 0.5f * PX[4 * g2 + 3] * invl; \
            ia[jj] = (PX[4 * g2] + PX[4 * g2 + 1] + PX[4 * g2 + 2]) * invl + hb; ia[32 + jj + 1] = hb; }
            IMP_W(p0, 0) IMP_W(p1, 8) IMP_W(p2, 16) IMP_W(p3, 24)
#undef IMP_W
            if (hi == 0) ia[32] = 0.f;
        }
#pragma unroll
        for (int d0 = 0; d0 < 4; ++d0) o[d0] = f32x16{};
        bf16x8 pa0, pa1, pa2, pa3;
        PK4(p0, 0, pa0); PK4(p0, 8, pa1); PK4(p1, 0, pa2); PK4(p1, 8, pa3);
        attn_pv<0>(o, vb0, pa0, pa1, pa2, pa3);
        PK4(p2, 0, pa0); PK4(p2, 8, pa1); PK4(p3, 0, pa2); PK4(p3, 8, pa3);
        attn_pv<1>(o, vb0, pa0, pa1, pa2, pa3);
        attn_store<false>(Ob, o, lds, gp[0] * invl, wave, r32, hi);
    }
    __syncthreads();
    {
        const float* ia = (const float*)(lds + AT_IMP);
        float* vals = (float*)(lds + AT_VALS);
        unsigned* selm = (unsigned*)(lds + AT_SEL);
        const int jb = tid & 31;
        float myv[4];
#pragma unroll
        for (int pass = 0; pass < 4; ++pass) {
            const int tokl = (tid >> 5) + 16 * pass;
            float v = 0.f;
#pragma unroll
            for (int hh = 0; hh < 4; ++hh) { const float* q = ia + (hh * 64 + tokl) * 65; v += q[jb] + q[32 + jb]; }
            const bool forced = (jb == 0) || (jb == qt) || (jb == qt - 1);
            v = (jb > qt) ? NEG : (forced ? __builtin_inff() : v);
            vals[tokl * 33 + jb] = v; myv[pass] = v;
        }
        __syncthreads();
#pragma unroll
        for (int pass = 0; pass < 4; ++pass) {
            const int tokl = (tid >> 5) + 16 * pass;
            const float v = myv[pass]; int rank = 0;
#pragma unroll 8
            for (int i = 0; i < 32; ++i) { const float vi = vals[tokl * 33 + i]; rank += (vi > v || (vi == v && i < jb)) ? 1 : 0; }
            const unsigned long long bal = __ballot(rank < 16);
            if ((lane & 31) == 0) selm[tokl] = (lane < 32) ? (unsigned)bal : (unsigned)(bal >> 32);
        }
        __syncthreads();
        if (tid < 64) { unsigned mk = selm[tid];
#pragma unroll
            for (int of = 32; of >= 1; of >>= 1) mk |= __shfl_xor(mk, of);
            if (tid == 0) selm[64] = mk; }
        __syncthreads();
    }
    const unsigned causal_bits = (qt >= 31) ? 0xffffffffu : ((2u << qt) - 1u);
    const unsigned selw = ((const unsigned*)(lds + AT_SEL))[(wave >> 2) * 32 + r32];
    const unsigned um = ((const unsigned*)(lds + AT_SEL))[64] & causal_bits;
    const KVAddr A = kv_addr(lds, tid, wave, KV6_W * 2);
    {
#pragma unroll
        for (int d0 = 0; d0 < 4; ++d0) o[d0] = f32x16{};
        float m_reg = -1e30f, l_reg = 0.f;
        const bf16_t* Kp = KV6 + (size_t)b * SEQ * KV6_W + 2 * 512 + g * 128;
        attn_branch<true>(lds, A, qr, o, m_reg, l_reg, um, Kp, Kp + 512, nullptr, sl2_t, rowb, selw, tq, tq0w, 1u << 30, wave, lane, r32, hi, vb0);
        attn_store<true>(Ob, o, lds, l_reg > 0.f ? gp[1] / l_reg : 0.f, wave, r32, hi);
    }
    {
#pragma unroll
        for (int d0 = 0; d0 < 4; ++d0) o[d0] = f32x16{};
        float m_reg = -1e30f, l_reg = 0.f;
        const bf16_t* Kp = KV6 + (size_t)b * SEQ * KV6_W + 4 * 512 + g * 128;
        const unsigned wmask = causal_bits & ~((qt > 8) ? ((1u << (qt - 8)) - 1u) : 0u);
        attn_branch<false>(lds, A, qr, o, m_reg, l_reg, wmask, Kp, Kp + 512, nullptr, sl2_t, rowb, 0u, tq, tq0w, 512u, wave, lane, r32, hi, vb0);
        attn_store<true>(Ob, o, lds, l_reg > 0.f ? gp[2] / l_reg : 0.f, wave, r32, hi);
    }
}
__device__ __forceinline__ void fox_unit(const Params& P, char* lds, int b, int kvh, int qt) {
    unsigned char* ws = P.ws;
    int tid = threadIdx.x; asm volatile("" : "+v"(tid));
    const int wave = __builtin_amdgcn_readfirstlane(tid >> 6), lane = tid & 63, r32 = lane & 31, hi = lane >> 5;
    const int head = wave & 3, h = kvh * 4 + head, tq0w = qt * 64 + (wave >> 2) * 32, tq = tq0w + r32;
    const int vb0 = (int)lds_addr(lds + AT_V) + v_rd_base(lane);
    const bf16_t* Qg = (const bf16_t*)(ws + WS_Q);
    const size_t tokrow = (size_t)b * SEQ + tq;
    bf16x8 qr[8];
#pragma unroll
    for (int d0 = 0; d0 < 8; ++d0) qr[d0] = *(const bf16x8*)(Qg + tokrow * DM + h * 128 + d0 * 16 + hi * 8);
    const float* ctab = (const float*)(ws + WS_C2) + ((size_t)b * 16 + kvh * 4) * SEQ;
    const float rowb = ctab[head * SEQ + tq];
    f32x16 o[4];
#pragma unroll
    for (int d0 = 0; d0 < 4; ++d0) o[d0] = f32x16{};
    float m_reg = -1e30f, l_reg = 0.f;
    const bf16_t* Kp = (const bf16_t*)(ws + WS_KV2) + (size_t)b * SEQ * 1024 + kvh * 128;
    const unsigned causal_bits = (qt >= 31) ? 0xffffffffu : ((2u << qt) - 1u);
    const KVAddr A = kv_addr(lds, tid, wave, 1024 * 2);
    attn_branch<false>(lds, A, qr, o, m_reg, l_reg, causal_bits, Kp, Kp + 512, ctab, 0.f, rowb, 0u, tq, tq0w, 1u << 30, wave, lane, r32, hi, vb0);
    bf16_t* Ob = (bf16_t*)(ws + WS_OATT) + ((size_t)b * SEQ + tq0w) * DM + h * 128;
    attn_store<false>(Ob, o, lds, l_reg > 0.f ? 1.f / l_reg : 0.f, wave, r32, hi);
}
__device__ __forceinline__ void attn_unit_decode(int u, int& b, int& g, int& qt) {
    const int rnd = u >> 8, c = u & 255, k = c >> 5, j = c & 31;
    b = j >> 2; g = j & 3;
    qt = (rnd == 0) ? 31 - k : (rnd == 1) ? 16 + k : (rnd == 2) ? 15 - k : k;
}

__device__ __forceinline__ void rowgemm64(const float* X, int row0, const float* W, float* part, float* ssp) {
    const int tid = threadIdx.x, wave = tid >> 6, lane = tid & 63, m = lane & 31, jh = lane >> 5;
    const int rgrp = wave & 1, kq = wave >> 1;
    const float* xr = X + (size_t)(row0 + rgrp * 32 + m) * DM + kq * 512 + 4 * jh;
    const float* wp = W + (size_t)(kq * 512 + 4 * jh) * 32 + m;
    f32x16 acc = {};
    float ss = 0.f;
#pragma unroll 4
    for (int i = 0; i < 64; ++i) {
        const f32x4 xv = *(const f32x4*)(xr + 8 * i);
        const float w0 = wp[(8 * i + 0) * 32], w1 = wp[(8 * i + 1) * 32], w2 = wp[(8 * i + 2) * 32], w3 = wp[(8 * i + 3) * 32];
        acc = __builtin_amdgcn_mfma_f32_32x32x2f32(xv[0], w0, acc, 0, 0, 0);
        acc = __builtin_amdgcn_mfma_f32_32x32x2f32(xv[1], w1, acc, 0, 0, 0);
        acc = __builtin_amdgcn_mfma_f32_32x32x2f32(xv[2], w2, acc, 0, 0, 0);
        acc = __builtin_amdgcn_mfma_f32_32x32x2f32(xv[3], w3, acc, 0, 0, 0);
        ss += xv[0] * xv[0] + xv[1] * xv[1] + xv[2] * xv[2] + xv[3] * xv[3];
    }
    float* pw = part + wave * (32 * 33);
#pragma unroll
    for (int r = 0; r < 16; ++r) pw[crow(r, jh) * 33 + m] = acc[r];
    ss += __shfl_xor(ss, 32);
    if (jh == 0) ssp[wave * 32 + m] = ss;
}
__device__ __forceinline__ void phase_router(const Params& P, unsigned char* lds, int layer) {
    unsigned char* ws = P.ws;
    const int tid = threadIdx.x;
    float* part = (float*)lds;
    float* ssp = (float*)(lds + 34816);
    float* lg = (float*)(lds + 36864);
    float* sl = (float*)(lds + 36864 + 8448);
    int* lcnt = (int*)(lds + 36864 + 2 * 8448);
    int* asg = lcnt + 64;
    const float* X = (const float*)(ws + WS_X1);
    const float* W = (const float*)(ws + WS_RW) + (size_t)layer * 2048 * 32;
    float* rstd_out = (float*)(ws + WS_RSTD) + (layer ? 2 * NTOK : 0);
    float* ew = (float*)(ws + WS_EW) + (size_t)layer * NTOK * 2;
    unsigned* gcnt = (unsigned*)(ws + WS_CTL) + CW_CNT + layer * 32 * 64;
    int* lists = (int*)(ws + WS_LIST) + (size_t)layer * 32 * LISTCAP;
    for (int rg = blockIdx.x; rg < NTOK / 64; rg += gridDim.x) {
        const int row0 = rg * 64;
        if (tid < 32) lcnt[tid] = 0;
        rowgemm64(X, row0, W, part, ssp);
        __syncthreads();
        if (tid < 64) {
            const int rgrp = tid >> 5, mloc = tid & 31;
            float ss = 0.f;
#pragma unroll
            for (int kq = 0; kq < 4; ++kq) ss += ssp[(kq * 2 + rgrp) * 32 + mloc];
            const float rstd = rsqrtf(ss * (1.f / DM) + RMS_EPS);
            rstd_out[row0 + tid] = rstd;
            float mx = -__builtin_inff();
            for (int e = 0; e < 32; ++e) {
                float d = 0.f;
#pragma unroll
                for (int kq = 0; kq < 4; ++kq) d += part[(kq * 2 + rgrp) * (32 * 33) + mloc * 33 + e];
                d *= rstd; lg[tid * 33 + e] = d; mx = fmaxf(mx, d);
            }
            float sum = 0.f;
            for (int e = 0; e < 32; ++e) { const float p = __expf(lg[tid * 33 + e] - mx); lg[tid * 33 + e] = p; sum += p; }
            const float inv = 1.f / sum;
            for (int e = 0; e < 32; ++e) { const float p = lg[tid * 33 + e] * inv; lg[tid * 33 + e] = p; sl[tid * 33 + e] = p + P.in[17][e]; }
            int bestg = 0; float bests = -__builtin_inff();
            for (int gq = 0; gq < 4; ++gq) {
                float t1 = -__builtin_inff(), t2 = -__builtin_inff();
                for (int i = 0; i < 8; ++i) { const float v = sl[tid * 33 + gq * 8 + i]; if (v > t1) { t2 = t1; t1 = v; } else if (v > t2) t2 = v; }
                const float sc = t1 + t2;
                if (sc > bests) { bests = sc; bestg = gq; }
            }
            int i1 = 0, i2 = 0; float v1 = -__builtin_inff(), v2 = -__builtin_inff();
            for (int i = 0; i < 8; ++i) { const float v = sl[tid * 33 + bestg * 8 + i]; if (v > v1) { v2 = v1; i2 = i1; v1 = v; i1 = i; } else if (v > v2) { v2 = v; i2 = i; } }
            const int e1 = bestg * 8 + i1, e2 = bestg * 8 + i2;
            const float p1 = lg[tid * 33 + e1], p2 = lg[tid * 33 + e2], ip = 1.f / (p1 + p2);
            ew[(size_t)(row0 + tid) * 2 + 0] = p1 * ip; ew[(size_t)(row0 + tid) * 2 + 1] = p2 * ip;
            asg[tid * 2 + 0] = e1; asg[tid * 2 + 1] = e2;
            asg[128 + tid * 2 + 0] = atomicAdd(&lcnt[e1], 1); asg[128 + tid * 2 + 1] = atomicAdd(&lcnt[e2], 1);
        }
        __syncthreads();
        if (tid < 32) { const int c = lcnt[tid]; lcnt[32 + tid] = c ? (int)__hip_atomic_fetch_add(gcnt + tid * 64, (unsigned)c, __ATOMIC_RELAXED, __HIP_MEMORY_SCOPE_AGENT) : 0; }
        __syncthreads();
        if (tid < 128) { const int e = asg[tid], pos = lcnt[32 + e] + asg[128 + tid]; if (pos < LISTCAP) lists[(size_t)e * LISTCAP + pos] = (row0 + (tid >> 1)) * 2 + (tid & 1); }
        __syncthreads();
    }
}
__device__ __forceinline__ void phase_combine0(const Params& P, unsigned char* lds) {
    unsigned char* ws = P.ws;
    const int tid = threadIdx.x, wave = tid >> 6, lane = tid & 63;
    float* part = (float*)lds; float* ssp = (float*)(lds + 34816); float* rs = (float*)(lds + 36864);
    const float* X1 = (const float*)(ws + WS_X1); float* X2 = (float*)(ws + WS_X2); bf16_t* XB = (bf16_t*)(ws + WS_XBA);
    const bf16_t* Y = (const bf16_t*)(ws + WS_Y); const float* ew = (const float*)(ws + WS_EW);
    float* rstd_out = (float*)(ws + WS_RSTD) + NTOK;
    for (int rg = blockIdx.x; rg < NTOK / 64; rg += gridDim.x) {
        const int row0 = rg * 64;
        for (int q = 0; q < 8; ++q) {
            const int row = row0 + wave * 8 + q;
            const float w0 = ew[(size_t)row * 2], w1 = ew[(size_t)row * 2 + 1];
            float ss = 0.f;
#pragma unroll
            for (int j = 0; j < 8; ++j) {
                const size_t off = (size_t)row * DM + j * 256 + lane * 4;
                f32x4 v = *(const f32x4*)(X1 + off);
                const u32x2 y0 = *(const u32x2*)(Y + (size_t)(2 * row) * DM + j * 256 + lane * 4), y1 = *(const u32x2*)(Y + (size_t)(2 * row + 1) * DM + j * 256 + lane * 4);
                v[0] += w0 * bflo(y0[0]) + w1 * bflo(y1[0]); v[1] += w0 * bfhi(y0[0]) + w1 * bfhi(y1[0]);
                v[2] += w0 * bflo(y0[1]) + w1 * bflo(y1[1]); v[3] += w0 * bfhi(y0[1]) + w1 * bfhi(y1[1]);
                *(f32x4*)(X2 + off) = v;
                u32x2 w = {cvtpk(v[0], v[1]), cvtpk(v[2], v[3])};
                *(u32x2*)(XB + off) = w;
                ss += v[0] * v[0] + v[1] * v[1] + v[2] * v[2] + v[3] * v[3];
            }
            ss = wave_sum(ss);
            const float rstd = rsqrtf(ss * (1.f / DM) + RMS_EPS);
            if (lane == 0) { rstd_out[row] = rstd; rs[wave * 8 + q] = rstd; }
        }
        asm volatile("s_waitcnt vmcnt(0)" ::: "memory");
        __syncthreads();
        rowgemm64(X2, row0, (const float*)(ws + WS_WF), part, ssp);
        __syncthreads();
        for (int i = tid; i < 64 * 16; i += NTHREADS) {
            const int r = i >> 4, j = i & 15, rgrp = r >> 5, mloc = r & 31;
            float d = 0.f;
#pragma unroll
            for (int kq = 0; kq < 4; ++kq) d += part[(kq * 2 + rgrp) * (32 * 33) + mloc * 33 + j];
            const float z = d * rs[r] + P.in[11][j];
            ((float*)(ws + WS_LOGF))[(size_t)(row0 + r) * 16 + j] = fminf(z, 0.f) - log1pf(__expf(-fabsf(z)));
        }
        __syncthreads();
    }
}
__device__ __forceinline__ void phase_final(const Params& P) {
    unsigned char* ws = P.ws;
    const int tid = threadIdx.x, wave = tid >> 6, lane = tid & 63;
    const float* X3 = (const float*)(ws + WS_X1); const bf16_t* Y = (const bf16_t*)(ws + WS_Y); const float* ew = (const float*)(ws + WS_EW) + (size_t)NTOK * 2;
    const float* gain = P.in[21];
    for (int row = blockIdx.x * 8 + wave; row < NTOK; row += gridDim.x * 8) {
        const float w0 = ew[(size_t)row * 2], w1 = ew[(size_t)row * 2 + 1];
        f32x4 v[8]; float ss = 0.f;
#pragma unroll
        for (int j = 0; j < 8; ++j) {
            const size_t off = (size_t)row * DM + j * 256 + lane * 4;
            v[j] = *(const f32x4*)(X3 + off);
            const u32x2 y0 = *(const u32x2*)(Y + (size_t)(2 * row) * DM + j * 256 + lane * 4), y1 = *(const u32x2*)(Y + (size_t)(2 * row + 1) * DM + j * 256 + lane * 4);
            v[j][0] += w0 * bflo(y0[0]) + w1 * bflo(y1[0]); v[j][1] += w0 * bfhi(y0[0]) + w1 * bfhi(y1[0]);
            v[j][2] += w0 * bflo(y0[1]) + w1 * bflo(y1[1]); v[j][3] += w0 * bfhi(y0[1]) + w1 * bfhi(y1[1]);
            ss += v[j][0] * v[j][0] + v[j][1] * v[j][1] + v[j][2] * v[j][2] + v[j][3] * v[j][3];
        }
        ss = wave_sum(ss);
        const float rstd = rsqrtf(ss * (1.f / DM) + RMS_EPS);
#pragma unroll
        for (int j = 0; j < 8; ++j) {
            const f32x4 gv = *(const f32x4*)(gain + j * 256 + lane * 4);
            *(f32x4*)(P.out + (size_t)row * DM + j * 256 + lane * 4) = v[j] * rstd * gv;
        }
    }
}

__global__ void __launch_bounds__(NTHREADS, 2) yoco_fwd(Params P) {
    extern __shared__ __attribute__((aligned(16))) unsigned char lds[];
    unsigned char* ws = P.ws;
    const int lo = P.ph_lo, hi = P.ph_hi;
    XcdBarrier bar; bar.bar = (unsigned*)(ws + WS_CTL) + CW_BAR; bar.x = 0; bar.st = nullptr;
    const bool one = (hi - lo) > 1;
    if (one) {
        if (threadIdx.x < 4) ((unsigned*)(lds + LDS_BYTES - 16))[threadIdx.x] = 0u;
        __syncthreads();
        bar = xcd_barrier_post((unsigned*)(ws + WS_CTL) + CW_BAR, (volatile LAS unsigned*)(lds + LDS_BYTES - 16));
    }
#ifdef ONLY_PHASE
#define IN(k) ((k) == ONLY_PHASE && lo <= (k) && (k) < hi)
#else
#define IN(k) (lo <= (k) && (k) < hi)
#endif
#define SEAM(k) do { if (IN(k) && IN((k) + 1)) xcd_barrier(bar); } while (0)
    if (IN(0)) { phase_convert(P, lds, 0, NJOBS); phase0_misc(P, lds); } SEAM(0);
    if (IN(1)) phase_proj0(P, lds); SEAM(1);
    if (IN(2)) phase_cmp1(P, lds); SEAM(2);
    if (IN(3)) phase_cmp2(P, lds); SEAM(3);
    if (IN(4)) { for (int u = blockIdx.x; u < 1024; u += gridDim.x) { int b, g, qt; attn_unit_decode(u, b, g, qt); nsa_unit(P, (char*)lds, b, g, qt); } } SEAM(4);
    if (IN(5)) phase_outproj(P, lds, WS_WOUT, P.in[0], (float*)(ws + WS_X1), (bf16_t*)(ws + WS_XBB)); SEAM(5);
    if (IN(6)) phase_router(P, lds, 0); SEAM(6);
    if (IN(7)) phase_moe_gu(P, lds, 0); SEAM(7);
    if (IN(8)) phase_moe_dn(P, lds, 0); SEAM(8);
    if (IN(9)) phase_combine0(P, lds); SEAM(9);
    if (IN(10)) phase_kvq(P, lds); SEAM(10);
    if (IN(11)) { for (int u = blockIdx.x; u < 1024; u += gridDim.x) { int b, g, qt; attn_unit_decode(u, b, g, qt); fox_unit(P, (char*)lds, b, g, qt); } } SEAM(11);
    if (IN(12)) phase_outproj(P, lds, WS_WFO, (const float*)(ws + WS_X2), (float*)(ws + WS_X1), (bf16_t*)(ws + WS_XBB)); SEAM(12);
    if (IN(13)) phase_router(P, lds, 1); SEAM(13);
    if (IN(14)) phase_moe_gu(P, lds, 1); SEAM(14);
    if (IN(15)) phase_moe_dn(P, lds, 1); SEAM(15);
    if (IN(16)) phase_final(P);
#undef IN
#undef SEAM
}

}

extern "C" void kernel_launch(void* const* d_in, const int* in_sizes, int n_in, void* d_out, int out_size, void* d_ws, size_t ws_size, hipStream_t stream) {
    static int grid = 0;
    if (grid == 0) {
        if (n_in != 22 || in_sizes[0] != NTOK * DM || out_size != NTOK * DM || ws_size < WS_END) {
            fprintf(stderr, "kernel_launch: unexpected shapes (n_in %d, in0 %d, out %d, ws %zu < %zu)\n", n_in, n_in > 0 ? in_sizes[0] : -1, out_size, ws_size, (size_t)WS_END); grid = -1; return; }
        int dev = 0, cus = 0, per_cu = 0;
        (void)hipGetDevice(&dev); (void)hipDeviceGetAttribute(&cus, hipDeviceAttributeMultiprocessorCount, dev);
        if (hipFuncSetAttribute((const void*)yoco_fwd, hipFuncAttributeMaxDynamicSharedMemorySize, LDS_BYTES) != hipSuccess) { fprintf(stderr, "kernel_launch: hipFuncSetAttribute failed\n"); grid = -1; return; }
        if (hipOccupancyMaxActiveBlocksPerMultiprocessor(&per_cu, (const void*)yoco_fwd, NTHREADS, LDS_BYTES) != hipSuccess || per_cu < 1) { fprintf(stderr, "kernel_launch: occupancy query says %d\n", per_cu); }
        (void)hipGetLastError();
        grid = cus > 0 ? cus : 256;
    }
    if (grid < 0) return;
    (void)hipMemsetAsync((char*)d_ws + WS_CTL, 0, CTL_BYTES, stream);
    Params p{};
    for (int i = 0; i < 22; ++i) p.in[i] = (const float*)d_in[i];
    p.out = (float*)d_out; p.ws = (unsigned char*)d_ws;
#if MK_LAUNCHES == 1
    p.ph_lo = 0; p.ph_hi = NPHASES;
    hipLaunchKernelGGL(yoco_fwd, dim3(grid), dim3(NTHREADS), LDS_BYTES, stream, p);
#else
    for (int k = 0; k < NPHASES; ++k) { p.ph_lo = k; p.ph_hi = k + 1; hipLaunchKernelGGL(yoco_fwd, dim3(grid), dim3(NTHREADS), LDS_BYTES, stream, p); }
#endif
}
```

```cpp
#include <hip/hip_runtime.h>
#include <cstdint>
#include <cstdio>

#ifndef MK_LAUNCHES
#define MK_LAUNCHES 1
#endif

namespace {

typedef unsigned short bf16_t;
typedef short bf16x8 __attribute__((ext_vector_type(8)));
typedef short s16x4 __attribute__((ext_vector_type(4)));
typedef float f32x4 __attribute__((ext_vector_type(4)));
typedef float f32x16 __attribute__((ext_vector_type(16)));
typedef unsigned u32x4 __attribute__((ext_vector_type(4)));
typedef unsigned u32x2 __attribute__((ext_vector_type(2)));

constexpr int NTOK = 16384, DM = 2048, SEQ = 2048, NBATCH = 8, NH = 16, HD = 128;
constexpr int NSA_IN_W = 5168, KV6_W = 3072, NEXP = 32, DEXP = 1024, LISTCAP = 32768;
constexpr int NTHREADS = 512;
constexpr float LOG2E = 1.4426950408889634f;
constexpr float QSCALE = 0.08838834764831845f;
constexpr float RMS_EPS = 1e-6f;
constexpr int LDS_BYTES = 147456;
constexpr int NPHASES = 17;

constexpr size_t al256(size_t x) { return (x + 255) & ~(size_t)255; }
constexpr size_t WS_CTL   = 0;
constexpr size_t CTL_BYTES = 65536;
constexpr size_t WS_WIN   = WS_CTL + CTL_BYTES;
constexpr size_t WS_CW1   = WS_WIN + (size_t)5376 * 2048 * 2;
constexpr size_t WS_WOUT  = WS_CW1 + (size_t)2 * 256 * 4096 * 2;
constexpr size_t WS_WKVQ  = WS_WOUT + (size_t)2048 * 2048 * 2;
constexpr size_t WS_WFO   = WS_WKVQ + (size_t)3072 * 2048 * 2;
constexpr size_t WS_GU    = WS_WFO + (size_t)2048 * 2048 * 2;
constexpr size_t WS_DN    = WS_GU + (size_t)2 * 32 * 2048 * 2048 * 2;
constexpr size_t WS_BIAS1 = WS_DN + (size_t)2 * 32 * 2048 * 1024 * 2;
constexpr size_t WS_RW    = WS_BIAS1 + 2 * 32 * 256 * 4;
constexpr size_t WS_WF    = WS_RW + (size_t)2 * 2048 * 32 * 4;
constexpr size_t WS_XBA   = al256(WS_WF + (size_t)2048 * 32 * 4);
constexpr size_t WS_XBB   = WS_XBA + (size_t)NTOK * DM * 2;
constexpr size_t WS_Q     = WS_XBB + (size_t)NTOK * DM * 2;
constexpr size_t WS_KV6   = WS_Q + (size_t)NTOK * DM * 2;
constexpr size_t WS_GATES = WS_KV6 + (size_t)NTOK * KV6_W * 2;
constexpr size_t WS_CPART = WS_GATES + (size_t)NTOK * 48 * 4;
constexpr size_t WS_KVCMP = WS_CPART + (size_t)2 * 8 * 4096 * 256 * 4;
constexpr size_t WS_OATT  = WS_KVCMP + (size_t)2 * 8 * 128 * 512 * 2;
constexpr size_t WS_X1    = WS_OATT + (size_t)NTOK * DM * 2;
constexpr size_t WS_X2    = WS_X1 + (size_t)NTOK * DM * 4;
constexpr size_t WS_H     = WS_X2 + (size_t)NTOK * DM * 4;
constexpr size_t WS_Y     = WS_H + (size_t)40960 * 1024 * 2;
constexpr size_t WS_LIST  = WS_Y + (size_t)32768 * 2048 * 2;
constexpr size_t WS_EW    = WS_LIST + (size_t)2 * 32 * LISTCAP * 4;
constexpr size_t WS_RSTD  = WS_EW + (size_t)2 * NTOK * 2 * 4;
constexpr size_t WS_KV2   = WS_RSTD + (size_t)3 * NTOK * 4;
constexpr size_t WS_LOGF  = WS_KV2 + (size_t)NTOK * 1024 * 2;
constexpr size_t WS_C2    = WS_LOGF + (size_t)NTOK * 16 * 4;
constexpr size_t WS_END   = WS_C2 + (size_t)8 * 16 * 2048 * 4;
constexpr int CW_BAR = 0;
constexpr int CW_CNT = 4096;
constexpr int CW_END = CW_CNT + 2 * 32 * 64;
static_assert(CW_END * 4 <= (int)CTL_BYTES, "ctl");

struct Params {
    const float* in[22];
    float* out;
    unsigned char* ws;
    int ph_lo, ph_hi;
};

__device__ __forceinline__ unsigned cvtpk(float lo, float hi) {
    unsigned r; asm volatile("v_cvt_pk_bf16_f32 %0, %1, %2" : "=v"(r) : "v"(lo), "v"(hi)); return r;
}
__device__ __forceinline__ float bflo(unsigned w) { return __uint_as_float(w << 16); }
__device__ __forceinline__ float bfhi(unsigned w) { return __uint_as_float(w & 0xffff0000u); }
__device__ __forceinline__ bf16x8 pack8(f32x4 a, f32x4 b) {
    u32x4 w = {cvtpk(a[0], a[1]), cvtpk(a[2], a[3]), cvtpk(b[0], b[1]), cvtpk(b[2], b[3])};
    return *reinterpret_cast<bf16x8*>(&w);
}
__device__ __forceinline__ float wave_sum(float v) {
#pragma unroll
    for (int o = 32; o >= 1; o >>= 1) v += __shfl_xor(v, o);
    return v;
}
__device__ __forceinline__ float fast_exp2(float x) { return __builtin_amdgcn_exp2f(x); }
__device__ __forceinline__ float fast_rcp(float x) { return __builtin_amdgcn_rcpf(x); }

__device__ __forceinline__ const void* uniform_ptr(const void* p) {
    const unsigned long long a = (unsigned long long)p;
    const unsigned lo = __builtin_amdgcn_readfirstlane((unsigned)a), hi = __builtin_amdgcn_readfirstlane((unsigned)(a >> 32));
    return (const void*)(((unsigned long long)hi << 32) | lo);
}
__device__ __forceinline__ void glds16(unsigned voff, const void* sbase, unsigned ldsaddr) {
    unsigned keep; sbase = uniform_ptr(sbase); ldsaddr = __builtin_amdgcn_readfirstlane(ldsaddr);
    asm volatile("s_mov_b32 %0, m0\n\ts_mov_b32 m0, %3\n\ts_nop 0\n\tglobal_load_lds_dwordx4 %1, %2\n\ts_mov_b32 m0, %0"
                 : "=&s"(keep) : "v"(voff), "s"(sbase), "s"(ldsaddr) : "memory");
}
__device__ __forceinline__ void glds4(unsigned voff, const void* sbase, unsigned ldsaddr) {
    unsigned keep; sbase = uniform_ptr(sbase); ldsaddr = __builtin_amdgcn_readfirstlane(ldsaddr);
    asm volatile("s_mov_b32 %0, m0\n\ts_mov_b32 m0, %3\n\ts_nop 0\n\tglobal_load_lds_dword %1, %2\n\ts_mov_b32 m0, %0"
                 : "=&s"(keep) : "v"(voff), "s"(sbase), "s"(ldsaddr) : "memory");
}
__device__ __forceinline__ unsigned lds_addr(const void* p) { return (unsigned)(size_t)(__attribute__((address_space(3))) const char*)p; }

#define XB_TMO      128
#define XB_XCNT(j)  (256  + 64 * (j))
#define XB_XSUB(j)  (1280 + 64 * (j))
#define XB_XGEN(j)  (2304 + 64 * (j))
#define XB_TOP      3328
#define XB_TOPGEN   3392
#define XCD_BAR_WORDS 3456
#define XB_SPIN_CAP (1u << 20)
#define LAS __attribute__((address_space(3)))

__device__ __forceinline__ unsigned xb_ld(unsigned* p)              { return __hip_atomic_load(p, __ATOMIC_RELAXED, __HIP_MEMORY_SCOPE_AGENT); }
__device__ __forceinline__ unsigned xb_add(unsigned* p, unsigned v) { return __hip_atomic_fetch_add(p, v, __ATOMIC_RELAXED, __HIP_MEMORY_SCOPE_AGENT); }
__device__ __forceinline__ unsigned xb_xcc_id() { return (unsigned)__builtin_amdgcn_s_getreg((3 << 11) | 20) & 0xFu; }
#define XB_SPIN(cond, bar) do { unsigned _sp = 0; while (cond) { __builtin_amdgcn_s_sleep(1); \
    if ((++_sp & 255u) == 0u) { if (xb_ld(&(bar)[XB_TMO])) break; if (_sp > XB_SPIN_CAP) { atomicAdd(&(bar)[XB_TMO], 1u); break; } } } } while (0)

struct XcdBarrier { unsigned* bar; unsigned x; volatile LAS unsigned* st; };

__device__ __forceinline__ XcdBarrier xcd_barrier_post(unsigned* bar, volatile LAS unsigned* st) {
    XcdBarrier b; b.bar = bar; b.x = xb_xcc_id(); b.st = st;
    if (threadIdx.x == 0) (void)xb_add(&bar[XB_XCNT(b.x)], 1u);
    return b;
}
__device__ __forceinline__ void xcd_barrier_complete(unsigned* bar, unsigned x, unsigned& nloc, unsigned& nx) {
    const unsigned G = gridDim.x * gridDim.y * gridDim.z;
    unsigned sum, cnt, mine, sp = 0u;
    for (;;) {
        sum = 0u; cnt = 0u; mine = 0u;
#pragma unroll
        for (unsigned j = 0; j < 16; ++j) { const unsigned c = xb_ld(&bar[XB_XCNT(j)]); sum += c; cnt += (c > 0u) ? 1u : 0u; mine = (j == x) ? c : mine; }
        if (sum == G) break;
        __builtin_amdgcn_s_sleep(1);
        if ((++sp & 255u) == 0u) { if (xb_ld(&bar[XB_TMO])) break; if (sp > XB_SPIN_CAP) { atomicAdd(&bar[XB_TMO], 1u); break; } }
    }
    nloc = mine > 0u ? mine : 1u; nx = cnt > 0u ? cnt : 1u;
}
__device__ __forceinline__ void xcd_barrier(const XcdBarrier& b) {
    asm volatile("s_waitcnt vmcnt(0)" ::: "memory");
    __syncthreads();
    if (threadIdx.x == 0) {
        unsigned* bar = b.bar;
        __builtin_amdgcn_s_waitcnt(0);
        unsigned nloc = b.st[0], nx = b.st[1];
        if (nloc == 0u) { xcd_barrier_complete(bar, b.x, nloc, nx); b.st[0] = nloc; b.st[1] = nx; }
        const unsigned old = xb_add(&bar[XB_XSUB(b.x)], 1u);
        const unsigned gen = old / nloc;
        if (old + 1u == (gen + 1u) * nloc) {
            __builtin_amdgcn_fence(__ATOMIC_RELEASE, "agent");
            asm volatile("s_waitcnt vmcnt(0)" ::: "memory");
            const unsigned og = xb_add(&bar[XB_TOP], 1u);
            const unsigned tg = og / nx;
            if (og + 1u == (tg + 1u) * nx) xb_add(&bar[XB_TOPGEN], 1u);
            else XB_SPIN(xb_ld(&bar[XB_TOPGEN]) == tg, bar);
            __builtin_amdgcn_fence(__ATOMIC_ACQUIRE, "agent");
            xb_add(&bar[XB_XGEN(b.x)], 1u);
            asm volatile("s_waitcnt vmcnt(0)" ::: "memory");
        } else {
            XB_SPIN(xb_ld(&bar[XB_XGEN(b.x)]) == gen, bar);
            __builtin_amdgcn_fence(__ATOMIC_ACQUIRE, "agent");
            asm volatile("s_waitcnt vmcnt(0)" ::: "memory");
        }
    }
    __syncthreads();
}

__device__ __forceinline__ int lds_byte(int r, int c) { const int st = (r >> 4) * 2 + (c >> 5), rr = r & 15, cc = c & 31, ob = rr * 64 + cc * 2; return st * 1024 + (ob ^ (((ob >> 9) & 1) << 5)); }
__device__ __forceinline__ void stage_rc(int b, int& R, int& C) { const int st = b / 1024, sb = b % 1024, swz = sb ^ (((sb >> 9) & 1) << 5); R = (st >> 1) * 16 + swz / 64; C = (st & 1) * 32 + (swz % 64) / 2; }
__device__ __forceinline__ int perm32(int rho) { const int n = rho >> 4, i = rho & 15; return 8 * (i >> 2) + 4 * n + (i & 3); }

typedef f32x4 AccT[2][2][4][2];

#define G_SA(b, h) (ldsb + (((b) * 2 + (h)) * 16384))
#define G_SB(b, h) (ldsb + ((4 + (b) * 2 + (h)) * 16384))
#define AKOFF(t) ((size_t)((unsigned)((t) >> 1) * astep2 + (unsigned)((t) & 1) * 128u))
#define STAGE_A(buf, h, t) do { const char* _p = Ab + AKOFF(t); \
    glds16((h) ? ao2 : ao0, _p, ldsw + ((buf) * 2 + (h)) * 16384); glds16((h) ? ao3 : ao1, _p, ldsw + ((buf) * 2 + (h)) * 16384 + 8192); } while (0)
#define STAGE_B(buf, h, t) do { const char* _p = Bb + (size_t)(h) * 128 * ldb + (size_t)(t) * 128u; \
    glds16(bo, _p, ldsw + (4 + (buf) * 2 + (h)) * 16384); glds16(bo, _p + (size_t)64 * ldb, ldsw + (4 + (buf) * 2 + (h)) * 16384 + 8192); } while (0)
#define LDA(dst, b, h) for (int m = 0; m < 4; ++m) for (int k = 0; k < 2; ++k) \
    dst[m][k] = *reinterpret_cast<const bf16x8*>(G_SA(b, h) + lds_byte(wr * 64 + m * 16 + fr, k * 32 + fq * 8))
#define LDB(dst, b, h) for (int n = 0; n < 2; ++n) for (int k = 0; k < 2; ++k) \
    dst[n][k] = *reinterpret_cast<const bf16x8*>(G_SB(b, h) + lds_byte(wc * 32 + n * 16 + fr, k * 32 + fq * 8))
#define MMA(ai, bj, At_, Bt_) do { __builtin_amdgcn_s_setprio(1); \
    for (int m = 0; m < 4; ++m) for (int n = 0; n < 2; ++n) for (int k = 0; k < 2; ++k) \
      acc[ai][bj][m][n] = __builtin_amdgcn_mfma_f32_16x16x32_bf16(Bt_[n][k], At_[m][k], acc[ai][bj][m][n], 0, 0, 0); \
    __builtin_amdgcn_s_setprio(0); } while (0)
#define WAIT_V(n) asm volatile("s_waitcnt vmcnt(" #n ")" ::: "memory")
#define WAIT_L(n) asm volatile("s_waitcnt lgkmcnt(" #n ")" ::: "memory")
#define BAR __builtin_amdgcn_s_barrier()
#define SCHED __builtin_amdgcn_sched_barrier(0)

template <bool PERM, class Epi>
__device__ __forceinline__ void gemm256(unsigned char* lds, const char* __restrict__ Ab, const char* __restrict__ Bb, const unsigned ldb,
                                        const unsigned astep2, const int nt, const unsigned ao0, const unsigned ao1, const unsigned ao2,
                                        const unsigned ao3, const Epi& epi) {
    char* ldsb = (char*)lds;
    int tid = threadIdx.x;
    const unsigned ldsw = lds_addr(lds) + (unsigned)__builtin_amdgcn_readfirstlane(tid >> 6) * 1024u;
    int wid = tid >> 6, lane = tid & 63, wr = wid >> 2, wc = wid & 3, fr = lane & 15, fq = lane >> 4;
    unsigned bo; { int R, C; stage_rc(tid * 16, R, C); const int pr = PERM ? ((R & ~31) | perm32(R & 31)) : R; bo = (unsigned)pr * ldb + (unsigned)C * 2u; }
    AccT acc = {};
    bf16x8 At[4][2], B0[2][2], B1[2][2];
    STAGE_B(0, 0, 0); STAGE_A(0, 0, 0);
    STAGE_B(0, 1, 0); STAGE_A(0, 1, 0);
    if (wr == 1) BAR;
    WAIT_V(4); BAR;
    STAGE_B(1, 0, 1); STAGE_A(1, 0, 1); STAGE_B(1, 1, 1);
    WAIT_V(6); BAR;
    for (int t = 0; t < nt - 2; t += 2) {
        LDB(B0, 0, 0); SCHED; LDA(At, 0, 0); STAGE_A(1, 1, t + 1);
        WAIT_L(8); BAR; WAIT_L(0); MMA(0, 0, At, B0); BAR; SCHED;
        LDB(B1, 0, 1); STAGE_B(0, 0, t + 2);
        BAR; WAIT_L(0); MMA(0, 1, At, B1); BAR;
        LDA(At, 0, 1); STAGE_A(0, 0, t + 2);
        BAR; WAIT_L(0); MMA(1, 0, At, B0); BAR; SCHED;
        STAGE_B(0, 1, t + 2);
        WAIT_V(6); BAR; MMA(1, 1, At, B1); BAR;
        LDB(B0, 1, 0); SCHED; LDA(At, 1, 0); STAGE_A(0, 1, t + 2);
        WAIT_L(8); BAR; WAIT_L(0); MMA(0, 0, At, B0); BAR; SCHED;
        LDB(B1, 1, 1); STAGE_B(1, 0, t + 3);
        BAR; WAIT_L(0); MMA(0, 1, At, B1); BAR;
        LDA(At, 1, 1); STAGE_A(1, 0, t + 3);
        BAR; WAIT_L(0); MMA(1, 0, At, B0); BAR; SCHED;
        STAGE_B(1, 1, t + 3);
        WAIT_V(6); BAR; MMA(1, 1, At, B1); BAR;
    }
    { int tz = threadIdx.x; asm volatile("" : "+v"(tz)); tid = tz; wid = tz >> 6; lane = tz & 63; wr = wid >> 2; wc = wid & 3; fr = lane & 15; fq = lane >> 4; }
    { LDB(B0, 0, 0); WAIT_V(0); LDA(At, 0, 0); STAGE_A(1, 1, nt - 1);
      BAR; WAIT_L(0); MMA(0, 0, At, B0); BAR;
      LDB(B1, 0, 1); BAR; WAIT_L(0); MMA(0, 1, At, B1); BAR;
      LDA(At, 0, 1); WAIT_V(4); BAR; WAIT_L(0); MMA(1, 0, At, B0); MMA(1, 1, At, B1); BAR; }
    { LDB(B0, 1, 0); LDA(At, 1, 0); WAIT_V(2); BAR; WAIT_L(0); MMA(0, 0, At, B0); BAR;
      LDB(B1, 1, 1); WAIT_V(0); BAR; WAIT_L(0); MMA(0, 1, At, B1); BAR;
      LDA(At, 1, 1); BAR; WAIT_L(0); MMA(1, 0, At, B0); MMA(1, 1, At, B1); BAR; }
    if (wr == 0) BAR;
    epi(acc, wr, wc, fr, fq);
    __syncthreads();
}

__device__ __forceinline__ void tile_order(int L, int nM, int nN, int& pm, int& pn) {
    const int nwg = nM * nN; int wgid = L;
    { const int q = nwg / 8, r = nwg % 8, xcd = wgid % 8, off = wgid / 8; wgid = (xcd < r ? xcd * (q + 1) : r * (q + 1) + (xcd - r) * q) + off; }
    const int nig = 8 * nN, gid = wgid / nig, fm = gid * 8, gsz = (nM - fm) < 8 ? (nM - fm) : 8;
    pm = fm + ((wgid % nig) % gsz); pn = (wgid % nig) / gsz;
}
__device__ __forceinline__ void stage_row_col(int tid, int& R0, int& C) { stage_rc(tid * 16, R0, C); }


__device__ __forceinline__ u32x4 pack8v(f32x4 a, f32x4 b) { u32x4 w = {cvtpk(a[0], a[1]), cvtpk(a[2], a[3]), cvtpk(b[0], b[1]), cvtpk(b[2], b[3])}; return w; }
__device__ __forceinline__ float sigmoidf_(float x) { return fast_rcp(1.f + fast_exp2(-x * LOG2E)); }

struct EpiProj0 {
    bf16_t* Q; bf16_t* KV6; float* gates; int row0, pn;
    __device__ __forceinline__ void operator()(const AccT& acc, int wr, int wc, int fr, int fq) const {
#pragma unroll
        for (int ai = 0; ai < 2; ++ai)
#pragma unroll
            for (int m = 0; m < 4; ++m) {
                const size_t row = (size_t)(row0 + ai * 128 + wr * 64 + m * 16 + fr);
#pragma unroll
                for (int bj = 0; bj < 2; ++bj) {
                    const int col8 = bj * 128 + wc * 32 + 8 * fq;
                    f32x4 v0 = acc[ai][bj][m][0], v1 = acc[ai][bj][m][1];
                    if (pn < 8) { v0 *= QSCALE; v1 *= QSCALE; *(u32x4*)(Q + row * DM + pn * 256 + col8) = pack8v(v0, v1); }
                    else if (pn < 20) { *(u32x4*)(KV6 + row * KV6_W + (pn - 8) * 256 + col8) = pack8v(v0, v1); }
                    else if (col8 < 48) {
                        f32x4 s0, s1;
#pragma unroll
                        for (int j = 0; j < 4; ++j) { s0[j] = sigmoidf_(v0[j]); s1[j] = sigmoidf_(v1[j]); }
                        *(f32x4*)(gates + row * 48 + col8) = s0; *(f32x4*)(gates + row * 48 + col8 + 4) = s1;
                    }
                }
            }
    }
};
struct EpiF32 {
    float* C;
    __device__ __forceinline__ void operator()(const AccT& acc, int wr, int wc, int fr, int fq) const {
#pragma unroll
        for (int ai = 0; ai < 2; ++ai)
#pragma unroll
            for (int m = 0; m < 4; ++m) {
                float* rowp = C + (size_t)(ai * 128 + wr * 64 + m * 16 + fr) * 256 + wc * 32 + 4 * fq;
#pragma unroll
                for (int bj = 0; bj < 2; ++bj)
#pragma unroll
                    for (int n = 0; n < 2; ++n) *(f32x4*)(rowp + bj * 128 + n * 16) = acc[ai][bj][m][n];
            }
    }
};
struct EpiOut {
    const float* xold; float* xnew; bf16_t* xb; int row0, col0;
    __device__ __forceinline__ void operator()(const AccT& acc, int wr, int wc, int fr, int fq) const {
#pragma unroll
        for (int ai = 0; ai < 2; ++ai)
#pragma unroll
            for (int m = 0; m < 4; ++m) {
                const size_t row = (size_t)(row0 + ai * 128 + wr * 64 + m * 16 + fr);
#pragma unroll
                for (int bj = 0; bj < 2; ++bj) {
                    const size_t off = row * DM + col0 + bj * 128 + wc * 32 + 8 * fq;
                    f32x4 v0 = acc[ai][bj][m][0] + *(const f32x4*)(xold + off), v1 = acc[ai][bj][m][1] + *(const f32x4*)(xold + off + 4);
                    *(f32x4*)(xnew + off) = v0; *(f32x4*)(xnew + off + 4) = v1;
                    *(u32x4*)(xb + off) = pack8v(v0, v1);
                }
            }
    }
};
struct EpiKVQ {
    bf16_t* KV2; bf16_t* Q; const float* rstd; int row0, pn;
    __device__ __forceinline__ void operator()(const AccT& acc, int wr, int wc, int fr, int fq) const {
#pragma unroll
        for (int ai = 0; ai < 2; ++ai)
#pragma unroll
            for (int m = 0; m < 4; ++m) {
                const size_t row = (size_t)(row0 + ai * 128 + wr * 64 + m * 16 + fr);
                float rs = rstd[row]; if (pn >= 4) rs *= QSCALE;
#pragma unroll
                for (int bj = 0; bj < 2; ++bj) {
                    const int col8 = bj * 128 + wc * 32 + 8 * fq;
                    const f32x4 v0 = acc[ai][bj][m][0] * rs, v1 = acc[ai][bj][m][1] * rs;
                    if (pn < 4) *(u32x4*)(KV2 + row * 1024 + pn * 256 + col8) = pack8v(v0, v1);
                    else *(u32x4*)(Q + row * DM + (pn - 4) * 256 + col8) = pack8v(v0, v1);
                }
            }
    }
};
struct EpiGU {
    bf16_t* H; const int* list; const float* rstd; int hrow0, pn, nvalid;
    __device__ __forceinline__ void operator()(const AccT& acc, int wr, int wc, int fr, int fq) const {
#pragma unroll
        for (int ai = 0; ai < 2; ++ai)
#pragma unroll
            for (int m = 0; m < 4; ++m) {
                const int lr = ai * 128 + wr * 64 + m * 16 + fr;
                if (lr < nvalid) {
                    const float rs = rstd[list[lr] >> 1];
                    f32x4 h0, h1;
#pragma unroll
                    for (int j = 0; j < 4; ++j) {
                        const float g0 = acc[ai][0][m][0][j] * rs, u0 = acc[ai][1][m][0][j] * rs, g1 = acc[ai][0][m][1][j] * rs, u1 = acc[ai][1][m][1][j] * rs;
                        h0[j] = g0 * sigmoidf_(g0) * u0; h1[j] = g1 * sigmoidf_(g1) * u1;
                    }
                    *(u32x4*)(H + (size_t)(hrow0 + lr) * DEXP + pn * 128 + wc * 32 + 8 * fq) = pack8v(h0, h1);
                }
            }
    }
};
struct EpiDN {
    bf16_t* Y; const int* list; int pn, nvalid;
    __device__ __forceinline__ void operator()(const AccT& acc, int wr, int wc, int fr, int fq) const {
#pragma unroll
        for (int ai = 0; ai < 2; ++ai)
#pragma unroll
            for (int m = 0; m < 4; ++m) {
                const int lr = ai * 128 + wr * 64 + m * 16 + fr;
                if (lr < nvalid) {
                    bf16_t* rowp = Y + (size_t)list[lr] * DM + pn * 256 + wc * 32 + 8 * fq;
#pragma unroll
                    for (int bj = 0; bj < 2; ++bj) *(u32x4*)(rowp + bj * 128) = pack8v(acc[ai][bj][m][0], acc[ai][bj][m][1]);
                }
            }
    }
};

struct CvtJob { const float* src; bf16_t* dst; const float* gain; int K, ld, ncols, tilesN, tilesKN; size_t srcE, dstE; int pA, pB, pC; };
constexpr int NJOBS = 13;
__device__ __forceinline__ int job_tiles(int j) {
    switch (j) { case 0: return 16 * 41; case 1: case 2: return 32 * 2; case 3: return 16 * 16; case 4: return 16 * 8; case 5: case 6: return 16 * 16; default: return 4096; }
}
__device__ __forceinline__ void get_job(const Params& P, int j, CvtJob& J) {
    unsigned char* ws = P.ws;
    J.gain = nullptr; J.srcE = 0; J.dstE = 0; J.pA = 1 << 30; J.pB = 0; J.pC = 0;
    const int l = (j >= 10) ? 1 : 0;
    switch (j) {
    case 0: J.src = P.in[1]; J.dst = (bf16_t*)(ws + WS_WIN); J.K = 2048; J.ld = 5168; J.ncols = 5168; break;
    case 1: J.src = P.in[4]; J.dst = (bf16_t*)(ws + WS_CW1); J.K = 4096; J.ld = 256; J.ncols = 256; break;
    case 2: J.src = P.in[6]; J.dst = (bf16_t*)(ws + WS_CW1) + (size_t)256 * 4096; J.K = 4096; J.ld = 256; J.ncols = 256; break;
    case 3: J.src = P.in[8]; J.dst = (bf16_t*)(ws + WS_WOUT); J.K = 2048; J.ld = 2048; J.ncols = 2048; break;
    case 4: J.src = P.in[10]; J.dst = (bf16_t*)(ws + WS_WKVQ); J.K = 2048; J.ld = 1040; J.ncols = 1024; J.gain = P.in[9]; break;
    case 5: J.src = P.in[12]; J.dst = (bf16_t*)(ws + WS_WKVQ) + (size_t)1024 * 2048; J.K = 2048; J.ld = 2048; J.ncols = 2048; J.gain = P.in[14] + DM; break;
    case 6: J.src = P.in[13]; J.dst = (bf16_t*)(ws + WS_WFO); J.K = 2048; J.ld = 2048; J.ncols = 2048; break;
    case 7: case 10: J.src = P.in[18] + (size_t)l * 32 * 2048 * 1024; J.dst = (bf16_t*)(ws + WS_GU) + (size_t)l * 32 * 2048 * 2048; J.K = 2048; J.ld = 1024; J.ncols = 1024;
        J.gain = P.in[15] + l * DM; J.srcE = (size_t)2048 * 1024; J.dstE = (size_t)2048 * 2048; J.pA = 128; J.pB = 256; J.pC = 0; break;
    case 8: case 11: J.src = P.in[19] + (size_t)l * 32 * 2048 * 1024; J.dst = (bf16_t*)(ws + WS_GU) + (size_t)l * 32 * 2048 * 2048; J.K = 2048; J.ld = 1024; J.ncols = 1024;
        J.gain = P.in[15] + l * DM; J.srcE = (size_t)2048 * 1024; J.dstE = (size_t)2048 * 2048; J.pA = 128; J.pB = 256; J.pC = 128; break;
    default: J.src = P.in[20] + (size_t)l * 32 * 1024 * 2048; J.dst = (bf16_t*)(ws + WS_DN) + (size_t)l * 32 * 2048 * 1024; J.K = 1024; J.ld = 2048; J.ncols = 2048;
        J.srcE = (size_t)1024 * 2048; J.dstE = (size_t)2048 * 1024; break;
    }
    J.tilesN = (J.ncols + 127) / 128; J.tilesKN = J.tilesN * (J.K / 128);
}
struct CvtRegs { f32x4 v[8]; float gn[8]; };
__device__ __forceinline__ void cvt_load(const CvtJob& J, int idx, CvtRegs& R) {
    const int tid = threadIdx.x;
    const int e = idx / J.tilesKN, rem = idx - e * J.tilesKN, ktile = rem / J.tilesN, ntile = rem - ktile * J.tilesN;
    const float* src = J.src + (size_t)e * J.srcE;
    const int k0 = ktile * 128, n0 = ntile * 128, nn = (tid & 31) * 4;
    const bool okc = (n0 + nn) < J.ncols;
#pragma unroll
    for (int p = 0; p < 8; ++p) {
        const int kk = (tid >> 5) + 16 * p;
        R.v[p] = (f32x4){0.f, 0.f, 0.f, 0.f};
        if (okc) R.v[p] = __builtin_nontemporal_load((const f32x4*)(src + (size_t)(k0 + kk) * J.ld + n0 + nn));
        R.gn[p] = J.gain ? J.gain[k0 + kk] : 1.f;
    }
}
__device__ __forceinline__ void cvt_store(const CvtJob& J, int idx, const CvtRegs& R, float* T  ) {
    const int tid = threadIdx.x;
    const int e = idx / J.tilesKN, rem = idx - e * J.tilesKN, ktile = rem / J.tilesN, ntile = rem - ktile * J.tilesN;
    bf16_t* dst = J.dst + (size_t)e * J.dstE;
    const int k0 = ktile * 128, n0 = ntile * 128, nn = (tid & 31) * 4;
#pragma unroll
    for (int p = 0; p < 8; ++p) {
        const int kk = (tid >> 5) + 16 * p;
        float* t = T + kk * 129 + nn; const f32x4 v = R.v[p] * R.gn[p];
        t[0] = v[0]; t[1] = v[1]; t[2] = v[2]; t[3] = v[3];
    }
    __syncthreads();
    {
        const int kc = (tid & 15) * 8;
#pragma unroll
        for (int p = 0; p < 4; ++p) {
            const int n = (tid >> 4) + 32 * p, ng = n0 + n;
            if (ng < J.ncols) {
                const float* t = T + kc * 129 + n;
                f32x4 a = {t[0], t[129], t[258], t[387]}, b = {t[516], t[645], t[774], t[903]};
                const int drow = (ng / J.pA) * J.pB + J.pC + (ng % J.pA);
                *(u32x4*)(dst + (size_t)drow * J.K + k0 + kc) = pack8v(a, b);
            }
        }
    }
    __syncthreads();
}
__device__ __forceinline__ int find_job(int g, int& jbase) { int b2 = 0, j = 0; for (; j < NJOBS - 1; ++j) { const int n = job_tiles(j); if (g < b2 + n) break; b2 += n; } jbase = b2; return j; }
__device__ __forceinline__ void phase_convert(const Params& P, unsigned char* lds, int jlo, int jhi) {
    float* T = (float*)lds;
    int base = 0;
    for (int j = 0; j < jlo; ++j) base += job_tiles(j);
    int total = base;
    for (int j = jlo; j < jhi; ++j) total += job_tiles(j);
    int g = base + blockIdx.x;
    if (g >= total) return;
    CvtJob Jc, Jn; CvtRegs Rc, Rn;
    int jbc, jbn, jc = find_job(g, jbc); get_job(P, jc, Jc);
    cvt_load(Jc, g - jbc, Rc);
    for (;;) {
        const int gn = g + gridDim.x; const bool more = gn < total;
        if (more) { const int jn = find_job(gn, jbn); get_job(P, jn, Jn); cvt_load(Jn, gn - jbn, Rn); }
        cvt_store(Jc, g - jbc, Rc, T);
        if (!more) break;
        Jc = Jn; Rc = Rn; jbc = jbn; g = gn;
    }
}
__device__ __forceinline__ void phase0_misc(const Params& P, unsigned char* lds) {
    unsigned char* ws = P.ws;
    const int tid = threadIdx.x, lane = tid & 63, wave = tid >> 6;
    {
        const float* x = P.in[0]; const float* gain = P.in[14]; bf16_t* h0 = (bf16_t*)(ws + WS_XBA);
        for (int row = blockIdx.x * 8 + wave; row < NTOK; row += gridDim.x * 8) {
            const float* xr = x + (size_t)row * DM + lane * 4;
            f32x4 v[8]; float ss = 0.f;
#pragma unroll
            for (int j = 0; j < 8; ++j) { v[j] = *(const f32x4*)(xr + j * 256); ss += v[j][0] * v[j][0] + v[j][1] * v[j][1] + v[j][2] * v[j][2] + v[j][3] * v[j][3]; }
            ss = wave_sum(ss);
            const float rstd = rsqrtf(ss * (1.f / DM) + RMS_EPS);
#pragma unroll
            for (int j = 0; j < 8; ++j) {
                const f32x4 gv = *(const f32x4*)(gain + j * 256 + lane * 4);
                const f32x4 o = v[j] * rstd * gv;
                u32x2 w = {cvtpk(o[0], o[1]), cvtpk(o[2], o[3])};
                *(u32x2*)(h0 + (size_t)row * DM + j * 256 + lane * 4) = w;
            }
        }
    }
    {
        float* rw = (float*)(ws + WS_RW); float* wf = (float*)(ws + WS_WF);
        const int gtid = blockIdx.x * NTHREADS + tid, gsz = gridDim.x * NTHREADS;
        for (int i = gtid; i < 2 * 2048 * 32; i += gsz) { const int l = i >> 16, k = (i >> 5) & 2047, e = i & 31; rw[i] = P.in[15][l * DM + k] * P.in[16][k * 32 + e]; }
        for (int i = gtid; i < 2048 * 32; i += gsz) { const int k = i >> 5, j = i & 31; wf[i] = (j < 16) ? P.in[9][k] * P.in[10][(size_t)k * 1040 + 1024 + j] : 0.f; }
    }
    for (int w = blockIdx.x; w < 64; w += gridDim.x) {
        const int kv = w >> 5, ch = w & 31; const float* pe = P.in[kv ? 3 : 2]; const float* w1 = P.in[kv ? 6 : 4];
        float* red = (float*)lds;
        const int j = tid & 255, half = tid >> 8; float s = 0.f;
        const int i0 = ch * 128 + half * 64;
#pragma unroll 16
        for (int i = i0; i < i0 + 64; ++i) s += pe[i] * w1[(size_t)i * 256 + j];
        __syncthreads();
        red[tid] = s; __syncthreads();
        if (tid < 256) ((float*)(ws + WS_BIAS1))[(kv * 32 + ch) * 256 + tid] = red[tid] + red[tid + 256];
        __syncthreads();
    }
}

__device__ __forceinline__ void lin_offsets(int tid, unsigned lda, unsigned& a0, unsigned& a1, unsigned& a2, unsigned& a3) {
    int R0, C; stage_rc(tid * 16, R0, C);
    a0 = (unsigned)R0 * lda + C * 2; a1 = (unsigned)(R0 + 64) * lda + C * 2; a2 = (unsigned)(R0 + 128) * lda + C * 2; a3 = (unsigned)(R0 + 192) * lda + C * 2;
}
__device__ __forceinline__ void phase_proj0(const Params& P, unsigned char* lds) {
    unsigned char* ws = P.ws;
    unsigned a0, a1, a2, a3; lin_offsets(threadIdx.x, DM * 2, a0, a1, a2, a3);
    for (int L = blockIdx.x; L < 64 * 21; L += gridDim.x) {
        int pm, pn; tile_order(L, 64, 21, pm, pn);
        EpiProj0 E{(bf16_t*)(ws + WS_Q), (bf16_t*)(ws + WS_KV6), (float*)(ws + WS_GATES), pm * 256, pn};
        gemm256<true>(lds, (const char*)(ws + WS_XBA) + (size_t)pm * 256 * DM * 2, (const char*)(ws + WS_WIN) + (size_t)pn * 256 * DM * 2, DM * 2, 256u, DM / 64, a0, a1, a2, a3, E);
    }
}
__device__ __forceinline__ void phase_cmp1(const Params& P, unsigned char* lds) {
    unsigned char* ws = P.ws;
    int R0, C; stage_rc(threadIdx.x * 16, R0, C);
    for (int u = blockIdx.x; u < 256; u += gridDim.x) {
        const int kv = u >> 7, mt = (u >> 3) & 15, ks = u & 7;
        unsigned ao[4];
#pragma unroll
        for (int q = 0; q < 4; ++q) {
            int r = mt * 256 + R0 + 64 * q; if (r > 4063) r = 4063;
            const int b = r / 508, rem = r - b * 508, n = rem >> 2, g = rem & 3;
            ao[q] = (unsigned)(((b * SEQ + n * 16) * KV6_W + kv * 512 + g * 128 + C) * 2);
        }
        EpiF32 E{(float*)(ws + WS_CPART) + ((size_t)(kv * 8 + ks) * 4096 + mt * 256) * 256};
        gemm256<false>(lds, (const char*)(ws + WS_KV6) + (size_t)ks * 4 * KV6_W * 2, (const char*)(ws + WS_CW1) + ((size_t)kv * 256 * 4096 + ks * 512) * 2, 4096 * 2,
                       (unsigned)(KV6_W * 2), 8, ao[0], ao[1], ao[2], ao[3], E);
    }
}
__device__ __forceinline__ float gelu_tanh(float x) {
    const float u = 0.7978845608028654f * (x + 0.044715f * x * x * x);
    const float t = 1.f - 2.f * fast_rcp(1.f + fast_exp2(2.f * LOG2E * u));
    return 0.5f * x * (1.f + t);
}
__device__ __forceinline__ void phase_cmp2(const Params& P, unsigned char* lds) {
    unsigned char* ws = P.ws;
    const int tid = threadIdx.x;
    float* hid = (float*)lds;
    const float* part = (const float*)(ws + WS_CPART);
    bf16_t* kvc = (bf16_t*)(ws + WS_KVCMP);
    for (int grp = blockIdx.x; grp < 256; grp += gridDim.x) {
        const int kv = grp >> 7, r0 = (grp & 127) * 32;
        {
            const int col = tid & 255, i0 = tid >> 8;
            float bias = 0.f;
#pragma unroll 8
            for (int ch = 0; ch < 32; ++ch) bias += ((const float*)(ws + WS_BIAS1))[(kv * 32 + ch) * 256 + col];
#pragma unroll 4
            for (int ii = 0; ii < 16; ++ii) {
                const int i = i0 + 2 * ii, r = r0 + i;
                float s = bias;
#pragma unroll
                for (int ks = 0; ks < 8; ++ks) s += part[((size_t)(kv * 8 + ks) * 4096 + r) * 256 + col];
                hid[i * 256 + col] = gelu_tanh(s);
            }
        }
        __syncthreads();
        {
            const float* w2 = P.in[kv ? 7 : 5];
            const int j = tid & 127, i0 = tid >> 7;
            float acc[8];
#pragma unroll
            for (int ii = 0; ii < 8; ++ii) acc[ii] = 0.f;
            for (int k = 0; k < 256; k += 4) {
                const float w0 = w2[(k + 0) * 128 + j], w1 = w2[(k + 1) * 128 + j], w2v = w2[(k + 2) * 128 + j], w3 = w2[(k + 3) * 128 + j];
#pragma unroll
                for (int ii = 0; ii < 8; ++ii) {
                    const f32x4 h = *(const f32x4*)(hid + (i0 + 4 * ii) * 256 + k);
                    acc[ii] += h[0] * w0 + h[1] * w1 + h[2] * w2v + h[3] * w3;
                }
            }
#pragma unroll
            for (int ii = 0; ii < 8; ++ii) {
                const int r = r0 + i0 + 4 * ii;
                if (r < 4064) {
                    const int b = r / 508, rem = r - b * 508, n = rem >> 2, g = rem & 3;
                    const float v = acc[ii], vn = __shfl_xor(v, 1);
                    if ((j & 1) == 0) *(unsigned*)(kvc + (size_t)kv * (8 * 128 * 512) + ((size_t)(b * 128 + n) * 4 + g) * 128 + j) = cvtpk(v, vn);
                }
            }
        }
        __syncthreads();
    }
    if (blockIdx.x == 0) {
        for (int i = tid; i < 2 * 8 * 512 / 2; i += NTHREADS) { const int kv = i >> 11, b = (i >> 8) & 7, c2 = i & 255;
            *(unsigned*)(kvc + (size_t)kv * (8 * 128 * 512) + ((size_t)(b * 128 + 127) * 512) + c2 * 2) = 0u; }
    }
}
__device__ __forceinline__ void phase_outproj(const Params& P, unsigned char* lds, size_t wsW, const float* xold, float* xnew, bf16_t* xb) {
    unsigned char* ws = P.ws;
    unsigned a0, a1, a2, a3; lin_offsets(threadIdx.x, DM * 2, a0, a1, a2, a3);
    for (int L = blockIdx.x; L < 64 * 8; L += gridDim.x) {
        int pm, pn; tile_order(L, 64, 8, pm, pn);
        EpiOut E{xold, xnew, xb, pm * 256, pn * 256};
        gemm256<true>(lds, (const char*)(ws + WS_OATT) + (size_t)pm * 256 * DM * 2, (const char*)(ws + wsW) + (size_t)pn * 256 * DM * 2, DM * 2, 256u, DM / 64, a0, a1, a2, a3, E);
    }
}
__device__ __forceinline__ void phase_kvq(const Params& P, unsigned char* lds) {
    unsigned char* ws = P.ws;
    unsigned a0, a1, a2, a3; lin_offsets(threadIdx.x, DM * 2, a0, a1, a2, a3);
    for (int L = blockIdx.x; L < 64 * 12; L += gridDim.x) {
        int pm, pn; tile_order(L, 64, 12, pm, pn);
        EpiKVQ E{(bf16_t*)(ws + WS_KV2), (bf16_t*)(ws + WS_Q), (const float*)(ws + WS_RSTD) + NTOK, pm * 256, pn};
        gemm256<true>(lds, (const char*)(ws + WS_XBA) + (size_t)pm * 256 * DM * 2, (const char*)(ws + WS_WKVQ) + (size_t)pn * 256 * DM * 2, DM * 2, 256u, DM / 64, a0, a1, a2, a3, E);
    }
    const int wave = threadIdx.x >> 6, lane = threadIdx.x & 63;
    for (int gw = blockIdx.x * 8 + wave; gw < 128; gw += gridDim.x * 8) {
        const int b = gw >> 4, h = gw & 15;
        const float* lf = (const float*)(ws + WS_LOGF) + ((size_t)b * SEQ + lane * 32) * 16 + h;
        float v[32]; float s = 0.f;
#pragma unroll
        for (int i = 0; i < 32; ++i) { s += lf[i * 16]; v[i] = s; }
        float incl = s;
#pragma unroll
        for (int o = 1; o < 64; o <<= 1) { const float t = __shfl_up(incl, o); if (lane >= o) incl += t; }
        const float excl = incl - s;
        float* c2 = (float*)(ws + WS_C2) + ((size_t)b * 16 + h) * SEQ + lane * 32;
#pragma unroll
        for (int i = 0; i < 32; ++i) c2[i] = (excl + v[i]) * LOG2E;
    }
}
__device__ __forceinline__ void moe_table(const unsigned* gcnt, int* tl  ) {
    if (threadIdx.x == 0) { int s = 0; for (int e = 0; e < 32; ++e) { const int c = (int)__hip_atomic_load(gcnt + e * 64, __ATOMIC_RELAXED, __HIP_MEMORY_SCOPE_AGENT); tl[40 + e] = c; tl[e] = s; s += (c + 255) >> 8; } tl[32] = s; }
    __syncthreads();
}
__device__ __forceinline__ void phase_moe_gu(const Params& P, unsigned char* lds, int layer) {
    unsigned char* ws = P.ws;
    int* tl = (int*)(lds + 131072);
    moe_table((const unsigned*)(ws + WS_CTL) + CW_CNT + layer * 32 * 64, tl);
    const int ntiles = tl[32];
    int R0, C; stage_rc(threadIdx.x * 16, R0, C);
    const float* rstd = (const float*)(ws + WS_RSTD) + (layer ? 2 * NTOK : 0);
    const char* xb = (const char*)(ws + WS_XBB);
    for (int u = blockIdx.x; u < ntiles * 8; u += gridDim.x) {
        const int ti = u >> 3, pn = u & 7;
        int e = 0;
        for (int q = 1; q < 32; ++q) if (tl[q] <= ti) e = q;
        e = __builtin_amdgcn_readfirstlane(e);
        const int mt = __builtin_amdgcn_readfirstlane(ti - tl[e]), nvalid = __builtin_amdgcn_readfirstlane(min(256, tl[40 + e] - mt * 256));
        const int* list = (const int*)(ws + WS_LIST) + ((size_t)(layer * 32 + e) * LISTCAP + mt * 256);
        unsigned ao[4];
#pragma unroll
        for (int q = 0; q < 4; ++q) { const int lr = R0 + 64 * q; const int tok = (lr < nvalid) ? (list[lr] >> 1) : 0; ao[q] = (unsigned)tok * (DM * 2) + C * 2; }
        EpiGU E{(bf16_t*)(ws + WS_H), list, rstd, ti * 256, pn, nvalid};
        gemm256<true>(lds, xb, (const char*)(ws + WS_GU) + ((size_t)(layer * 32 + e) * 2048 + pn * 256) * DM * 2, DM * 2, 256u, DM / 64, ao[0], ao[1], ao[2], ao[3], E);
    }
}
__device__ __forceinline__ void phase_moe_dn(const Params& P, unsigned char* lds, int layer) {
    unsigned char* ws = P.ws;
    int* tl = (int*)(lds + 131072);
    moe_table((const unsigned*)(ws + WS_CTL) + CW_CNT + layer * 32 * 64, tl);
    const int ntiles = tl[32];
    unsigned a0, a1, a2, a3; lin_offsets(threadIdx.x, DEXP * 2, a0, a1, a2, a3);
    for (int u = blockIdx.x; u < ntiles * 8; u += gridDim.x) {
        const int ti = u >> 3, pn = u & 7;
        int e = 0;
        for (int q = 1; q < 32; ++q) if (tl[q] <= ti) e = q;
        e = __builtin_amdgcn_readfirstlane(e);
        const int mt = __builtin_amdgcn_readfirstlane(ti - tl[e]), nvalid = __builtin_amdgcn_readfirstlane(min(256, tl[40 + e] - mt * 256));
        const int* list = (const int*)(ws + WS_LIST) + ((size_t)(layer * 32 + e) * LISTCAP + mt * 256);
        EpiDN E{(bf16_t*)(ws + WS_Y), list, pn, nvalid};
        gemm256<true>(lds, (const char*)(ws + WS_H) + (size_t)ti * 256 * DEXP * 2, (const char*)(ws + WS_DN) + ((size_t)(layer * 32 + e) * 2048 + pn * 256) * DEXP * 2, DEXP * 2, 256u,
                      DEXP / 64, a0, a1, a2, a3, E);
    }
}


constexpr int AT_V = 0, AT_K = 32768, AT_KB = 65536, AT_WS = 67584, AT_IMP = 69632, AT_VALS = 136192, AT_SEL = 144640;
#define KSWZ(row, colB) ((row) * 256 + ((colB) ^ (((row) & 7) << 4)))
__device__ __forceinline__ int v_st(int k, int c) { const int kk = (k & ~0xC) | ((k & 4) << 1) | ((k & 8) >> 1); return ((kk >> 3) * 4 + (c >> 5)) * 512 + ((kk & 7) * 32 + (c & 31)) * 2; }
__device__ __forceinline__ int v_rd_base(int lane) { return ((lane & 3) << 3) | (((lane >> 2) & 3) << 6) | (((lane >> 4) & 1) << 5) | (((lane >> 5) & 1) << 8); }
constexpr int v_rd_off(int d0, int ks, int half) { return d0 * 512 + ks * 4096 + half * 2048; }
__device__ __forceinline__ int crow(int r, int hi) { return (r & 3) + 8 * (r >> 2) + 4 * hi; }

template <int KB>
__device__ __forceinline__ void attn_qkt(f32x16& p0, f32x16& p1, const char* K_lds, int r32, int hi, const bf16x8 (&qr)[8]) {
    p0 = f32x16{}; p1 = f32x16{};
    const char* kb[4];
#pragma unroll
    for (int dd = 0; dd < 4; ++dd) kb[dd] = K_lds + KB * 16384 + KSWZ(r32, (dd * 16 + hi * 8) * 2);
#pragma unroll
    for (int d0 = 0; d0 < 8; ++d0) { const char* a = kb[d0 & 3] + (d0 >> 2) * 128;
        bf16x8 b0 = *reinterpret_cast<const bf16x8*>(a);
        bf16x8 b1 = *reinterpret_cast<const bf16x8*>(a + 32 * 256);
        p0 = __builtin_amdgcn_mfma_f32_32x32x16_bf16(b0, qr[d0], p0, 0, 0, 0);
        p1 = __builtin_amdgcn_mfma_f32_32x32x16_bf16(b1, qr[d0], p1, 0, 0, 0); }
}
template <int VB>
__device__ __forceinline__ void attn_pv(f32x16 (&o)[4], int vb0, bf16x8 pa0, bf16x8 pa1, bf16x8 pa2, bf16x8 pa3) {
#define TRRD(dst, off) asm volatile("ds_read_b64_tr_b16 %0, %1 offset:%2" : "=&v"(dst) : "v"(vb0), "i"(off) : "memory")
#define PV_D0(d0) do { s16x4 l0, l1, l2, l3, h0, h1, h2, h3; constexpr int b_ = VB * 16384 + v_rd_off(d0, 0, 0); \
        TRRD(l0, b_); TRRD(h0, b_ + 2048); TRRD(l1, b_ + 4096); TRRD(h1, b_ + 6144); TRRD(l2, b_ + 8192); TRRD(h2, b_ + 10240); TRRD(l3, b_ + 12288); TRRD(h3, b_ + 14336); \
        asm volatile("s_waitcnt lgkmcnt(0)" ::: "memory"); __builtin_amdgcn_sched_barrier(0); \
        o[d0] = __builtin_amdgcn_mfma_f32_32x32x16_bf16(pa0, (bf16x8){l0[0], l0[1], l0[2], l0[3], h0[0], h0[1], h0[2], h0[3]}, o[d0], 0, 0, 0); \
        o[d0] = __builtin_amdgcn_mfma_f32_32x32x16_bf16(pa1, (bf16x8){l1[0], l1[1], l1[2], l1[3], h1[0], h1[1], h1[2], h1[3]}, o[d0], 0, 0, 0); \
        o[d0] = __builtin_amdgcn_mfma_f32_32x32x16_bf16(pa2, (bf16x8){l2[0], l2[1], l2[2], l2[3], h2[0], h2[1], h2[2], h2[3]}, o[d0], 0, 0, 0); \
        o[d0] = __builtin_amdgcn_mfma_f32_32x32x16_bf16(pa3, (bf16x8){l3[0], l3[1], l3[2], l3[3], h3[0], h3[1], h3[2], h3[3]}, o[d0], 0, 0, 0); } while (0)
    PV_D0(0); PV_D0(1); PV_D0(2); PV_D0(3);
#undef PV_D0
#undef TRRD
}
#define PK4(P, B_, OUT) do { unsigned a0 = cvtpk(P[B_+0], P[B_+1]), a1 = cvtpk(P[B_+2], P[B_+3]); \
        unsigned b0 = cvtpk(P[B_+4], P[B_+5]), b1 = cvtpk(P[B_+6], P[B_+7]); \
        auto r0 = __builtin_amdgcn_permlane32_swap(a0, b0, false, false); auto r1 = __builtin_amdgcn_permlane32_swap(a1, b1, false, false); \
        u32x4 w = {r0[0], r1[0], r0[1], r1[1]}; OUT = *reinterpret_cast<bf16x8*>(&w); } while (0)
__device__ __forceinline__ float row_max2(float v) { auto rr = __builtin_amdgcn_permlane32_swap(__float_as_uint(v), __float_as_uint(v), false, false); return fmaxf(__uint_as_float(rr[0]), __uint_as_float(rr[1])); }
__device__ __forceinline__ float row_sum2(float v) { auto rr = __builtin_amdgcn_permlane32_swap(__float_as_uint(v), __float_as_uint(v), false, false); return __uint_as_float(rr[0]) + __uint_as_float(rr[1]); }

struct KVAddr { unsigned ldsw, ldsb, voffK, voffV, ldb; };
__device__ __forceinline__ KVAddr kv_addr(const char* lds, int tid, int wave, unsigned ldb) {
    KVAddr A; A.ldsb = lds_addr(lds); A.ldsw = A.ldsb + (unsigned)wave * 1024u; A.ldb = ldb;
    const int row = tid >> 4, cp = tid & 15;
    A.voffK = (unsigned)row * ldb + (unsigned)((cp ^ (row & 7)) * 16);
    const int k = ((tid >> 2) & 3) | (((tid >> 7) & 1) << 2) | (((tid >> 4) & 1) << 3) | (((tid >> 8) & 1) << 4);
    const int c = ((tid >> 5) & 3) * 32 + (tid & 3) * 8;
    A.voffV = (unsigned)k * ldb + (unsigned)c * 2u;
    return A;
}
template <int BUF>
__device__ __forceinline__ void kv_issue(const KVAddr& A, const bf16_t* Kp, const bf16_t* Vp, int key0, const float* ctab, int wave, int lane) {
    const char* kb = (const char*)Kp + (size_t)key0 * A.ldb; const char* vb = (const char*)Vp + (size_t)key0 * A.ldb;
    glds16(A.voffK, kb, A.ldsw + AT_K + BUF * 16384); glds16(A.voffK, kb + (size_t)32 * A.ldb, A.ldsw + AT_K + BUF * 16384 + 8192);
    glds16(A.voffV, vb, A.ldsw + AT_V + BUF * 16384); glds16(A.voffV, vb + (size_t)32 * A.ldb, A.ldsw + AT_V + BUF * 16384 + 8192);
    if (ctab != nullptr && wave < 4) glds4((unsigned)lane * 4u, ctab + (size_t)wave * SEQ + key0, A.ldsb + AT_KB + BUF * 1024 + (unsigned)wave * 256u);
}
template <int BUF>
__device__ __forceinline__ void kb_alibi(char* lds, int tid, float sl2_t, int key0) {
    if (tid < 256) ((float*)(lds + AT_KB))[BUF * 256 + tid] = -sl2_t * (float)(key0 + (tid & 63));
}
template <int BUF>
__device__ __forceinline__ void attn_tile(char* lds, const bf16x8 (&qr)[8], f32x16 (&o)[4], float& m_reg, float& l_reg, float rb, int dq, unsigned W,
                                          bool needmask, int wave, int r32, int hi, int vb0) {
    f32x16 p0, p1;
    attn_qkt<BUF>(p0, p1, lds + AT_K, r32, hi, qr);
    const float NEG = -__builtin_inff();
    {
        const float* kbp = (const float*)(lds + AT_KB) + BUF * 256 + (wave & 3) * 64 + 4 * hi;
#pragma unroll
        for (int g2 = 0; g2 < 4; ++g2) {
            const f32x4 ka = *(const f32x4*)(kbp + 8 * g2), kc = *(const f32x4*)(kbp + 32 + 8 * g2);
#pragma unroll
            for (int i = 0; i < 4; ++i) { p0[4 * g2 + i] = fmaf(p0[4 * g2 + i], LOG2E, rb - ka[i]); p1[4 * g2 + i] = fmaf(p1[4 * g2 + i], LOG2E, rb - kc[i]); }
        }
    }
    if (needmask) {
#pragma unroll
        for (int r = 0; r < 16; ++r) { const int c = (r & 3) + 8 * (r >> 2);
            if ((unsigned)(dq - c) >= W) p0[r] = NEG;
            if ((unsigned)(dq - c - 32) >= W) p1[r] = NEG; }
    }
    float pmax = p0[0];
#pragma unroll
    for (int r = 1; r < 16; ++r) pmax = fmaxf(pmax, p0[r]);
#pragma unroll
    for (int r = 0; r < 16; ++r) pmax = fmaxf(pmax, p1[r]);
    pmax = row_max2(pmax);
    const float mn = fmaxf(m_reg, pmax), alpha = fast_exp2(m_reg - mn);
    m_reg = mn;
    float ps = 0.f;
#pragma unroll
    for (int r = 0; r < 16; ++r) { p0[r] = fast_exp2(p0[r] - mn); ps += p0[r]; }
#pragma unroll
    for (int r = 0; r < 16; ++r) { p1[r] = fast_exp2(p1[r] - mn); ps += p1[r]; }
    ps = row_sum2(ps);
    l_reg = l_reg * alpha + ps;
    if (__any(alpha < 1.f)) {
        float* al = (float*)(lds + AT_WS) + wave * 64;
        if (hi == 0) al[r32] = alpha;
        asm volatile("s_waitcnt lgkmcnt(0)" ::: "memory");
#pragma unroll
        for (int g2 = 0; g2 < 4; ++g2) { const f32x4 a4 = *(const f32x4*)(al + 8 * g2 + 4 * hi);
#pragma unroll
            for (int d0 = 0; d0 < 4; ++d0)
#pragma unroll
                for (int i = 0; i < 4; ++i) o[d0][4 * g2 + i] *= a4[i]; }
    }
    bf16x8 pa0, pa1, pa2, pa3;
    PK4(p0, 0, pa0); PK4(p0, 8, pa1); PK4(p1, 0, pa2); PK4(p1, 8, pa3);
    attn_pv<BUF>(o, vb0, pa0, pa1, pa2, pa3);
}
template <bool SELB>
__device__ __forceinline__ void attn_branch(char* lds, const KVAddr& A, const bf16x8 (&qr)[8], f32x16 (&o)[4], float& m_reg, float& l_reg, unsigned tilemask,
                                            const bf16_t* Kp, const bf16_t* Vp, const float* ctab, float sl2_t, float rowb, unsigned selw,
                                            int tq, int tq0w, unsigned W, int wave, int lane, int r32, int hi, int vb0) {
    const int tid = wave * 64 + lane;
    unsigned tm = tilemask;
    int j = 31 - __builtin_clz(tm); tm &= ~(1u << j);
    kv_issue<0>(A, Kp, Vp, j * 64, ctab, wave, lane);
    if (ctab == nullptr) kb_alibi<0>(lds, tid, sl2_t, j * 64);
    const float NEG = -__builtin_inff();
#define ATT_STEP(BUF, NBUF) { \
        asm volatile("s_waitcnt vmcnt(0)" ::: "memory"); \
        __syncthreads(); \
        int jn = -1; if (tm) { jn = 31 - __builtin_clz(tm); tm &= ~(1u << jn); kv_issue<NBUF>(A, Kp, Vp, jn * 64, ctab, wave, lane); if (ctab == nullptr) kb_alibi<NBUF>(lds, tid, sl2_t, jn * 64); } \
        { const int key0 = j * 64; \
          const bool rsel = SELB ? (((selw >> j) & 1u) != 0u) : true; \
          bool active = (key0 <= tq0w + 31) && ((tq0w - key0 - 63) < (int)W); \
          if (SELB) active = active && __any(rsel); \
          if (active) { \
              const bool needmask = (key0 + 63 > tq0w) || ((unsigned)(tq0w + 31 - key0) >= W); \
              attn_tile<BUF>(lds, qr, o, m_reg, l_reg, rsel ? rowb : NEG, tq - key0 - 4 * hi, W, needmask, wave, r32, hi, vb0); } } \
        if (jn < 0) break; \
        j = jn; }
    for (;;) { ATT_STEP(0, 1) ATT_STEP(1, 0) }
#undef ATT_STEP
    __syncthreads();
}
template <bool ADD>
__device__ __forceinline__ void attn_store(bf16_t* Obase  , const f32x16 (&o)[4], char* lds, float srow, int wave, int r32, int hi) {
    float* sc = (float*)(lds + AT_WS) + wave * 64 + 32;
    if (hi == 0) sc[r32] = srow;
    asm volatile("s_waitcnt lgkmcnt(0)" ::: "memory");
#pragma unroll
    for (int g2 = 0; g2 < 4; ++g2) { const f32x4 s4 = *(const f32x4*)(sc + 8 * g2 + 4 * hi);
#pragma unroll
        for (int i = 0; i < 4; ++i) { const int r = 4 * g2 + i; const int orow = crow(r, hi);
#pragma unroll
            for (int d0 = 0; d0 < 4; ++d0) {
                float v = o[d0][r] * s4[i];
                float vn = __shfl_xor(v, 1);
                if ((r32 & 1) == 0) { unsigned* p = (unsigned*)(Obase + (size_t)orow * DM + d0 * 32 + r32);
                    if (ADD) { const unsigned old = *p; v += bflo(old); vn += bfhi(old); }
                    *p = cvtpk(v, vn); } } } }
}

__device__ __forceinline__ void nsa_unit(const Params& P, char* lds, int b, int g, int qt) {
    unsigned char* ws = P.ws;
    int tid = threadIdx.x; asm volatile("" : "+v"(tid));
    const int wave = __builtin_amdgcn_readfirstlane(tid >> 6), lane = tid & 63, r32 = lane & 31, hi = lane >> 5;
    const int head = wave & 3, h = g * 4 + head, tq0w = qt * 64 + (wave >> 2) * 32, tq = tq0w + r32;
    const int vb0 = (int)lds_addr(lds + AT_V) + v_rd_base(lane);
    const bf16_t* Qg = (const bf16_t*)(ws + WS_Q); const bf16_t* KV6 = (const bf16_t*)(ws + WS_KV6);
    const size_t tokrow = (size_t)b * SEQ + tq;
    bf16x8 qr[8];
#pragma unroll
    for (int d0 = 0; d0 < 8; ++d0) qr[d0] = *(const bf16x8*)(Qg + tokrow * DM + h * 128 + d0 * 16 + hi * 8);
    const float* gp = (const float*)(ws + WS_GATES) + tokrow * 48 + h * 3;
    const float sl2 = fast_exp2(-0.5f * (float)(h + 1)) * LOG2E;
    const float sl2_t = fast_exp2(-0.5f * (float)(g * 4 + ((tid >> 6) & 3) + 1)) * LOG2E;
    const float rowb = -sl2 * (float)tq;
    const float NEG = -__builtin_inff();
    bf16_t* Ob = (bf16_t*)(ws + WS_OATT) + ((size_t)b * SEQ + tq0w) * DM + h * 128;
    f32x16 o[4];
    {
        const KVAddr A = kv_addr(lds, tid, wave, 512 * 2);
        const bf16_t* Kc = (const bf16_t*)(ws + WS_KVCMP) + (size_t)b * 128 * 512 + g * 128;
        const bf16_t* Vc = Kc + (size_t)8 * 128 * 512;
        kv_issue<0>(A, Kc, Vc, 0, nullptr, wave, lane);
        kv_issue<1>(A, Kc, Vc, 64, nullptr, wave, lane);
        asm volatile("s_waitcnt vmcnt(0)" ::: "memory");
        __syncthreads();
        f32x16 p0, p1, p2, p3;
        attn_qkt<0>(p0, p1, lds + AT_K, r32, hi, qr);
        attn_qkt<1>(p2, p3, lds + AT_K, r32, hi, qr);
        const int lim = tq - 64 * hi; const float sb = -sl2 * (float)lim;
        float pmax = NEG;
#define CMP_BIAS(PX, N0) _Pragma("unroll") for (int r = 0; r < 16; ++r) { const int kc_ = 16 * ((N0) + (r & 3) + 8 * (r >> 2)) + 31; \
            const float v = fmaf(PX[r], LOG2E, fmaf(sl2, (float)kc_, sb)); PX[r] = (kc_ <= lim) ? v : NEG; pmax = fmaxf(pmax, PX[r]); }
        CMP_BIAS(p0, 0) CMP_BIAS(p1, 32) CMP_BIAS(p2, 64) CMP_BIAS(p3, 96)
#undef CMP_BIAS
        pmax = row_max2(pmax);
        const float mn = fmaxf(pmax, -1e30f);
        float ps = 0.f;
#pragma unroll
        for (int r = 0; r < 16; ++r) { p0[r] = fast_exp2(p0[r] - mn); p1[r] = fast_exp2(p1[r] - mn); p2[r] = fast_exp2(p2[r] - mn); p3[r] = fast_exp2(p3[r] - mn); ps += (p0[r] + p1[r]) + (p2[r] + p3[r]); }
        ps = row_sum2(ps);
        const float invl = ps > 0.f ? 1.f / ps : 0.f;
        {
            float* ia = (float*)(lds + AT_IMP) + (head * 64 + (wave >> 2) * 32 + r32) * 65;
#define IMP_W(PX, J0) _Pragma("unroll") for (int g2 = 0; g2 < 4; ++g2) { const int jj = (J0) + 2 * g2 + hi; const float hb = 0.5f * PX[4 * g2 + 3] * invl; \
            ia[jj] = (PX[4 * g2] + PX[4 * g2 + 1] + PX[4 * g2 + 2]) * invl + hb; ia[32 + jj + 1] = hb; }
            IMP_W(p0, 0) IMP_W(p1, 8) IMP_W(p2, 16) IMP_W(p3, 24)
#undef IMP_W
            if (hi == 0) ia[32] = 0.f;
        }
#pragma unroll
        for (int d0 = 0; d0 < 4; ++d0) o[d0] = f32x16{};
        bf16x8 pa0, pa1, pa2, pa3;
        PK4(p0, 0, pa0); PK4(p0, 8, pa1); PK4(p1, 0, pa2); PK4(p1, 8, pa3);
        attn_pv<0>(o, vb0, pa0, pa1, pa2, pa3);
        PK4(p2, 0, pa0); PK4(p2, 8, pa1); PK4(p3, 0, pa2); PK4(p3, 8, pa3);
        attn_pv<1>(o, vb0, pa0, pa1, pa2, pa3);
        attn_store<false>(Ob, o, lds, gp[0] * invl, wave, r32, hi);
    }
    __syncthreads();
    {
        const float* ia = (const float*)(lds + AT_IMP);
        float* vals = (float*)(lds + AT_VALS);
        unsigned* selm = (unsigned*)(lds + AT_SEL);
        const int jb = tid & 31;
        float myv[4];
#pragma unroll
        for (int pass = 0; pass < 4; ++pass) {
            const int tokl = (tid >> 5) + 16 * pass;
            float v = 0.f;
#pragma unroll
            for (int hh = 0; hh < 4; ++hh) { const float* q = ia + (hh * 64 + tokl) * 65; v += q[jb] + q[32 + jb]; }
            const bool forced = (jb == 0) || (jb == qt) || (jb == qt - 1);
            v = (jb > qt) ? NEG : (forced ? __builtin_inff() : v);
            vals[tokl * 33 + jb] = v; myv[pass] = v;
        }
        __syncthreads();
#pragma unroll
        for (int pass = 0; pass < 4; ++pass) {
            const int tokl = (tid >> 5) + 16 * pass;
            const float v = myv[pass]; int rank = 0;
#pragma unroll 8
            for (int i = 0; i < 32; ++i) { const float vi = vals[tokl * 33 + i]; rank += (vi > v || (vi == v && i < jb)) ? 1 : 0; }
            const unsigned long long bal = __ballot(rank < 16);
            if ((lane & 31) == 0) selm[tokl] = (lane < 32) ? (unsigned)bal : (unsigned)(bal >> 32);
        }
        __syncthreads();
        if (tid < 64) { unsigned mk = selm[tid];
#pragma unroll
            for (int of = 32; of >= 1; of >>= 1) mk |= __shfl_xor(mk, of);
            if (tid == 0) selm[64] = mk; }
        __syncthreads();
    }
    const unsigned causal_bits = (qt >= 31) ? 0xffffffffu : ((2u << qt) - 1u);
    const unsigned selw = ((const unsigned*)(lds + AT_SEL))[(wave >> 2) * 32 + r32];
    const unsigned um = ((const unsigned*)(lds + AT_SEL))[64] & causal_bits;
    const KVAddr A = kv_addr(lds, tid, wave, KV6_W * 2);
    {
#pragma unroll
        for (int d0 = 0; d0 < 4; ++d0) o[d0] = f32x16{};
        float m_reg = -1e30f, l_reg = 0.f;
        const bf16_t* Kp = KV6 + (size_t)b * SEQ * KV6_W + 2 * 512 + g * 128;
        attn_branch<true>(lds, A, qr, o, m_reg, l_reg, um, Kp, Kp + 512, nullptr, sl2_t, rowb, selw, tq, tq0w, 1u << 30, wave, lane, r32, hi, vb0);
        attn_store<true>(Ob, o, lds, l_reg > 0.f ? gp[1] / l_reg : 0.f, wave, r32, hi);
    }
    {
#pragma unroll
        for (int d0 = 0; d0 < 4; ++d0) o[d0] = f32x16{};
        float m_reg = -1e30f, l_reg = 0.f;
        const bf16_t* Kp = KV6 + (size_t)b * SEQ * KV6_W + 4 * 512 + g * 128;
        const unsigned wmask = causal_bits & ~((qt > 8) ? ((1u << (qt - 8)) - 1u) : 0u);
        attn_branch<false>(lds, A, qr, o, m_reg, l_reg, wmask, Kp, Kp + 512, nullptr, sl2_t, rowb, 0u, tq, tq0w, 512u, wave, lane, r32, hi, vb0);
        attn_store<true>(Ob, o, lds, l_reg > 0.f ? gp[2] / l_reg : 0.f, wave, r32, hi);
    }
}
__device__ __forceinline__ void fox_unit(const Params& P, char* lds, int b, int kvh, int qt) {
    unsigned char* ws = P.ws;
    int tid = threadIdx.x; asm volatile("" : "+v"(tid));
    const int wave = __builtin_amdgcn_readfirstlane(tid >> 6), lane = tid & 63, r32 = lane & 31, hi = lane >> 5;
    const int head = wave & 3, h = kvh * 4 + head, tq0w = qt * 64 + (wave >> 2) * 32, tq = tq0w + r32;
    const int vb0 = (int)lds_addr(lds + AT_V) + v_rd_base(lane);
    const bf16_t* Qg = (const bf16_t*)(ws + WS_Q);
    const size_t tokrow = (size_t)b * SEQ + tq;
    bf16x8 qr[8];
#pragma unroll
    for (int d0 = 0; d0 < 8; ++d0) qr[d0] = *(const bf16x8*)(Qg + tokrow * DM + h * 128 + d0 * 16 + hi * 8);
    const float* ctab = (const float*)(ws + WS_C2) + ((size_t)b * 16 + kvh * 4) * SEQ;
    const float rowb = ctab[head * SEQ + tq];
    f32x16 o[4];
#pragma unroll
    for (int d0 = 0; d0 < 4; ++d0) o[d0] = f32x16{};
    float m_reg = -1e30f, l_reg = 0.f;
    const bf16_t* Kp = (const bf16_t*)(ws + WS_KV2) + (size_t)b * SEQ * 1024 + kvh * 128;
    const unsigned causal_bits = (qt >= 31) ? 0xffffffffu : ((2u << qt) - 1u);
    const KVAddr A = kv_addr(lds, tid, wave, 1024 * 2);
    attn_branch<false>(lds, A, qr, o, m_reg, l_reg, causal_bits, Kp, Kp + 512, ctab, 0.f, rowb, 0u, tq, tq0w, 1u << 30, wave, lane, r32, hi, vb0);
    bf16_t* Ob = (bf16_t*)(ws + WS_OATT) + ((size_t)b * SEQ + tq0w) * DM + h * 128;
    attn_store<false>(Ob, o, lds, l_reg > 0.f ? 1.f / l_reg : 0.f, wave, r32, hi);
}
__device__ __forceinline__ void attn_unit_decode(int u, int& b, int& g, int& qt) {
    const int rnd = u >> 8, c = u & 255, k = c >> 5, j = c & 31;
    b = j >> 2; g = j & 3;
    qt = (rnd == 0) ? 31 - k : (rnd == 1) ? 16 + k : (rnd == 2) ? 15 - k : k;
}

__device__ __forceinline__ void rowgemm64(const float* X, int row0, const float* W, float* part, float* ssp) {
    const int tid = threadIdx.x, wave = tid >> 6, lane = tid & 63, m = lane & 31, jh = lane >> 5;
    const int rgrp = wave & 1, kq = wave >> 1;
    const float* xr = X + (size_t)(row0 + rgrp * 32 + m) * DM + kq * 512 + 4 * jh;
    const float* wp = W + (size_t)(kq * 512 + 4 * jh) * 32 + m;
    f32x16 acc = {};
    float ss = 0.f;
#pragma unroll 4
    for (int i = 0; i < 64; ++i) {
        const f32x4 xv = *(const f32x4*)(xr + 8 * i);
        const float w0 = wp[(8 * i + 0) * 32], w1 = wp[(8 * i + 1) * 32], w2 = wp[(8 * i + 2) * 32], w3 = wp[(8 * i + 3) * 32];
        acc = __builtin_amdgcn_mfma_f32_32x32x2f32(xv[0], w0, acc, 0, 0, 0);
        acc = __builtin_amdgcn_mfma_f32_32x32x2f32(xv[1], w1, acc, 0, 0, 0);
        acc = __builtin_amdgcn_mfma_f32_32x32x2f32(xv[2], w2, acc, 0, 0, 0);
        acc = __builtin_amdgcn_mfma_f32_32x32x2f32(xv[3], w3, acc, 0, 0, 0);
        ss += xv[0] * xv[0] + xv[1] * xv[1] + xv[2] * xv[2] + xv[3] * xv[3];
    }
    float* pw = part + wave * (32 * 33);
#pragma unroll
    for (int r = 0; r < 16; ++r) pw[crow(r, jh) * 33 + m] = acc[r];
    ss += __shfl_xor(ss, 32);
    if (jh == 0) ssp[wave * 32 + m] = ss;
}
__device__ __forceinline__ void phase_router(const Params& P, unsigned char* lds, int layer) {
    unsigned char* ws = P.ws;
    const int tid = threadIdx.x;
    float* part = (float*)lds;
    float* ssp = (float*)(lds + 34816);
    float* lg = (float*)(lds + 36864);
    float* sl = (float*)(lds + 36864 + 8448);
    int* lcnt = (int*)(lds + 36864 + 2 * 8448);
    int* asg = lcnt + 64;
    const float* X = (const float*)(ws + WS_X1);
    const float* W = (const float*)(ws + WS_RW) + (size_t)layer * 2048 * 32;
    float* rstd_out = (float*)(ws + WS_RSTD) + (layer ? 2 * NTOK : 0);
    float* ew = (float*)(ws + WS_EW) + (size_t)layer * NTOK * 2;
    unsigned* gcnt = (unsigned*)(ws + WS_CTL) + CW_CNT + layer * 32 * 64;
    int* lists = (int*)(ws + WS_LIST) + (size_t)layer * 32 * LISTCAP;
    for (int rg = blockIdx.x; rg < NTOK / 64; rg += gridDim.x) {
        const int row0 = rg * 64;
        if (tid < 32) lcnt[tid] = 0;
        rowgemm64(X, row0, W, part, ssp);
        __syncthreads();
        if (tid < 64) {
            const int rgrp = tid >> 5, mloc = tid & 31;
            float ss = 0.f;
#pragma unroll
            for (int kq = 0; kq < 4; ++kq) ss += ssp[(kq * 2 + rgrp) * 32 + mloc];
            const float rstd = rsqrtf(ss * (1.f / DM) + RMS_EPS);
            rstd_out[row0 + tid] = rstd;
            float mx = -__builtin_inff();
            for (int e = 0; e < 32; ++e) {
                float d = 0.f;
#pragma unroll
                for (int kq = 0; kq < 4; ++kq) d += part[(kq * 2 + rgrp) * (32 * 33) + mloc * 33 + e];
                d *= rstd; lg[tid * 33 + e] = d; mx = fmaxf(mx, d);
            }
            float sum = 0.f;
            for (int e = 0; e < 32; ++e) { const float p = __expf(lg[tid * 33 + e] - mx); lg[tid * 33 + e] = p; sum += p; }
            const float inv = 1.f / sum;
            for (int e = 0; e < 32; ++e) { const float p = lg[tid * 33 + e] * inv; lg[tid * 33 + e] = p; sl[tid * 33 + e] = p + P.in[17][e]; }
            int bestg = 0; float bests = -__builtin_inff();
            for (int gq = 0; gq < 4; ++gq) {
                float t1 = -__builtin_inff(), t2 = -__builtin_inff();
                for (int i = 0; i < 8; ++i) { const float v = sl[tid * 33 + gq * 8 + i]; if (v > t1) { t2 = t1; t1 = v; } else if (v > t2) t2 = v; }
                const float sc = t1 + t2;
                if (sc > bests) { bests = sc; bestg = gq; }
            }
            int i1 = 0, i2 = 0; float v1 = -__builtin_inff(), v2 = -__builtin_inff();
            for (int i = 0; i < 8; ++i) { const float v = sl[tid * 33 + bestg * 8 + i]; if (v > v1) { v2 = v1; i2 = i1; v1 = v; i1 = i; } else if (v > v2) { v2 = v; i2 = i; } }
            const int e1 = bestg * 8 + i1, e2 = bestg * 8 + i2;
            const float p1 = lg[tid * 33 + e1], p2 = lg[tid * 33 + e2], ip = 1.f / (p1 + p2);
            ew[(size_t)(row0 + tid) * 2 + 0] = p1 * ip; ew[(size_t)(row0 + tid) * 2 + 1] = p2 * ip;
            asg[tid * 2 + 0] = e1; asg[tid * 2 + 1] = e2;
            asg[128 + tid * 2 + 0] = atomicAdd(&lcnt[e1], 1); asg[128 + tid * 2 + 1] = atomicAdd(&lcnt[e2], 1);
        }
        __syncthreads();
        if (tid < 32) { const int c = lcnt[tid]; lcnt[32 + tid] = c ? (int)__hip_atomic_fetch_add(gcnt + tid * 64, (unsigned)c, __ATOMIC_RELAXED, __HIP_MEMORY_SCOPE_AGENT) : 0; }
        __syncthreads();
        if (tid < 128) { const int e = asg[tid], pos = lcnt[32 + e] + asg[128 + tid]; if (pos < LISTCAP) lists[(size_t)e * LISTCAP + pos] = (row0 + (tid >> 1)) * 2 + (tid & 1); }
        __syncthreads();
    }
}
__device__ __forceinline__ void phase_combine0(const Params& P, unsigned char* lds) {
    unsigned char* ws = P.ws;
    const int tid = threadIdx.x, wave = tid >> 6, lane = tid & 63;
    float* part = (float*)lds; float* ssp = (float*)(lds + 34816); float* rs = (float*)(lds + 36864);
    const float* X1 = (const float*)(ws + WS_X1); float* X2 = (float*)(ws + WS_X2); bf16_t* XB = (bf16_t*)(ws + WS_XBA);
    const bf16_t* Y = (const bf16_t*)(ws + WS_Y); const float* ew = (const float*)(ws + WS_EW);
    float* rstd_out = (float*)(ws + WS_RSTD) + NTOK;
    for (int rg = blockIdx.x; rg < NTOK / 64; rg += gridDim.x) {
        const int row0 = rg * 64;
        for (int q = 0; q < 8; ++q) {
            const int row = row0 + wave * 8 + q;
            const float w0 = ew[(size_t)row * 2], w1 = ew[(size_t)row * 2 + 1];
            float ss = 0.f;
#pragma unroll
            for (int j = 0; j < 8; ++j) {
                const size_t off = (size_t)row * DM + j * 256 + lane * 4;
                f32x4 v = *(const f32x4*)(X1 + off);
                const u32x2 y0 = *(const u32x2*)(Y + (size_t)(2 * row) * DM + j * 256 + lane * 4), y1 = *(const u32x2*)(Y + (size_t)(2 * row + 1) * DM + j * 256 + lane * 4);
                v[0] += w0 * bflo(y0[0]) + w1 * bflo(y1[0]); v[1] += w0 * bfhi(y0[0]) + w1 * bfhi(y1[0]);
                v[2] += w0 * bflo(y0[1]) + w1 * bflo(y1[1]); v[3] += w0 * bfhi(y0[1]) + w1 * bfhi(y1[1]);
                *(f32x4*)(X2 + off) = v;
                u32x2 w = {cvtpk(v[0], v[1]), cvtpk(v[2], v[3])};
                *(u32x2*)(XB + off) = w;
                ss += v[0] * v[0] + v[1] * v[1] + v[2] * v[2] + v[3] * v[3];
            }
            ss = wave_sum(ss);
            const float rstd = rsqrtf(ss * (1.f / DM) + RMS_EPS);
            if (lane == 0) { rstd_out[row] = rstd; rs[wave * 8 + q] = rstd; }
        }
        asm volatile("s_waitcnt vmcnt(0)" ::: "memory");
        __syncthreads();
        rowgemm64(X2, row0, (const float*)(ws + WS_WF), part, ssp);
        __syncthreads();
        for (int i = tid; i < 64 * 16; i += NTHREADS) {
            const int r = i >> 4, j = i & 15, rgrp = r >> 5, mloc = r & 31;
            float d = 0.f;
#pragma unroll
            for (int kq = 0; kq < 4; ++kq) d += part[(kq * 2 + rgrp) * (32 * 33) + mloc * 33 + j];
            const float z = d * rs[r] + P.in[11][j];
            ((float*)(ws + WS_LOGF))[(size_t)(row0 + r) * 16 + j] = fminf(z, 0.f) - log1pf(__expf(-fabsf(z)));
        }
        __syncthreads();
    }
}
__device__ __forceinline__ void phase_final(const Params& P) {
    unsigned char* ws = P.ws;
    const int tid = threadIdx.x, wave = tid >> 6, lane = tid & 63;
    const float* X3 = (const float*)(ws + WS_X1); const bf16_t* Y = (const bf16_t*)(ws + WS_Y); const float* ew = (const float*)(ws + WS_EW) + (size_t)NTOK * 2;
    const float* gain = P.in[21];
    for (int row = blockIdx.x * 8 + wave; row < NTOK; row += gridDim.x * 8) {
        const float w0 = ew[(size_t)row * 2], w1 = ew[(size_t)row * 2 + 1];
        f32x4 v[8]; float ss = 0.f;
#pragma unroll
        for (int j = 0; j < 8; ++j) {
            const size_t off = (size_t)row * DM + j * 256 + lane * 4;
            v[j] = *(const f32x4*)(X3 + off);
            const u32x2 y0 = *(const u32x2*)(Y + (size_t)(2 * row) * DM + j * 256 + lane * 4), y1 = *(const u32x2*)(Y + (size_t)(2 * row + 1) * DM + j * 256 + lane * 4);
            v[j][0] += w0 * bflo(y0[0]) + w1 * bflo(y1[0]); v[j][1] += w0 * bfhi(y0[0]) + w1 * bfhi(y1[0]);
            v[j][2] += w0 * bflo(y0[1]) + w1 * bflo(y1[1]); v[j][3] += w0 * bfhi(y0[1]) + w1 * bfhi(y1[1]);
            ss += v[j][0] * v[j][0] + v[j][1] * v[j][1] + v[j][2] * v[j][2] + v[j][3] * v[j][3];
        }
        ss = wave_sum(ss);
        const float rstd = rsqrtf(ss * (1.f / DM) + RMS_EPS);
#pragma unroll
        for (int j = 0; j < 8; ++j) {
            const f32x4 gv = *(const f32x4*)(gain + j * 256 + lane * 4);
            *(f32x4*)(P.out + (size_t)row * DM + j * 256 + lane * 4) = v[j] * rstd * gv;
        }
    }
}

__global__ void __launch_bounds__(NTHREADS, 2) yoco_fwd(Params P) {
    extern __shared__ __attribute__((aligned(16))) unsigned char lds[];
    unsigned char* ws = P.ws;
    const int lo = P.ph_lo, hi = P.ph_hi;
    XcdBarrier bar; bar.bar = (unsigned*)(ws + WS_CTL) + CW_BAR; bar.x = 0; bar.st = nullptr;
    const bool one = (hi - lo) > 1;
    if (one) {
        if (threadIdx.x < 4) ((unsigned*)(lds + LDS_BYTES - 16))[threadIdx.x] = 0u;
        __syncthreads();
        bar = xcd_barrier_post((unsigned*)(ws + WS_CTL) + CW_BAR, (volatile LAS unsigned*)(lds + LDS_BYTES - 16));
    }
#ifdef ONLY_PHASE
#define IN(k) ((k) == ONLY_PHASE && lo <= (k) && (k) < hi)
#else
#define IN(k) (lo <= (k) && (k) < hi)
#endif
#define SEAM(k) do { if (IN(k) && IN((k) + 1)) xcd_barrier(bar); } while (0)
#ifndef REP_MASK
#define REP_MASK 0
#endif
#define RUN(k, ...) do { if (IN(k)) { __VA_ARGS__; if ((REP_MASK >> (k)) & 1) { xcd_barrier(bar); __VA_ARGS__; } } SEAM(k); } while (0)
    RUN(0, { phase_convert(P, lds, 0, NJOBS); phase0_misc(P, lds); });
    RUN(1, phase_proj0(P, lds));
    RUN(2, phase_cmp1(P, lds));
    RUN(3, phase_cmp2(P, lds));
    RUN(4, { for (int u = blockIdx.x; u < 1024; u += gridDim.x) { int b, g, qt; attn_unit_decode(u, b, g, qt); nsa_unit(P, (char*)lds, b, g, qt); } });
    RUN(5, phase_outproj(P, lds, WS_WOUT, P.in[0], (float*)(ws + WS_X1), (bf16_t*)(ws + WS_XBB)));
    RUN(6, phase_router(P, lds, 0));
    RUN(7, phase_moe_gu(P, lds, 0));
    RUN(8, phase_moe_dn(P, lds, 0));
    RUN(9, phase_combine0(P, lds));
    RUN(10, phase_kvq(P, lds));
    RUN(11, { for (int u = blockIdx.x; u < 1024; u += gridDim.x) { int b, g, qt; attn_unit_decode(u, b, g, qt); fox_unit(P, (char*)lds, b, g, qt); } });
    RUN(12, phase_outproj(P, lds, WS_WFO, (const float*)(ws + WS_X2), (float*)(ws + WS_X1), (bf16_t*)(ws + WS_XBB)));
    RUN(13, phase_router(P, lds, 1));
    RUN(14, phase_moe_gu(P, lds, 1));
    RUN(15, phase_moe_dn(P, lds, 1));
    RUN(16, phase_final(P));
#undef RUN
#undef IN
#undef SEAM
}

}

extern "C" void kernel_launch(void* const* d_in, const int* in_sizes, int n_in, void* d_out, int out_size, void* d_ws, size_t ws_size, hipStream_t stream) {
    static int grid = 0;
    if (grid == 0) {
        if (n_in != 22 || in_sizes[0] != NTOK * DM || out_size != NTOK * DM || ws_size < WS_END) {
            fprintf(stderr, "kernel_launch: unexpected shapes (n_in %d, in0 %d, out %d, ws %zu < %zu)\n", n_in, n_in > 0 ? in_sizes[0] : -1, out_size, ws_size, (size_t)WS_END); grid = -1; return; }
        int dev = 0, cus = 0, per_cu = 0;
        (void)hipGetDevice(&dev); (void)hipDeviceGetAttribute(&cus, hipDeviceAttributeMultiprocessorCount, dev);
        if (hipFuncSetAttribute((const void*)yoco_fwd, hipFuncAttributeMaxDynamicSharedMemorySize, LDS_BYTES) != hipSuccess) { fprintf(stderr, "kernel_launch: hipFuncSetAttribute failed\n"); grid = -1; return; }
        if (hipOccupancyMaxActiveBlocksPerMultiprocessor(&per_cu, (const void*)yoco_fwd, NTHREADS, LDS_BYTES) != hipSuccess || per_cu < 1) { fprintf(stderr, "kernel_launch: occupancy query says %d\n", per_cu); }
        (void)hipGetLastError();
        grid = cus > 0 ? cus : 256;
    }
    if (grid < 0) return;
    (void)hipMemsetAsync((char*)d_ws + WS_CTL, 0, CTL_BYTES, stream);
    Params p{};
    for (int i = 0; i < 22; ++i) p.in[i] = (const float*)d_in[i];
    p.out = (float*)d_out; p.ws = (unsigned char*)d_ws;
#if MK_LAUNCHES == 1
    p.ph_lo = 0; p.ph_hi = NPHASES;
    hipLaunchKernelGGL(yoco_fwd, dim3(grid), dim3(NTHREADS), LDS_BYTES, stream, p);
#else
    for (int k = 0; k < NPHASES; ++k) { p.ph_lo = k; p.ph_hi = k + 1; hipLaunchKernelGGL(yoco_fwd, dim3(grid), dim3(NTHREADS), LDS_BYTES, stream, p); }
#endif
}
```

```cpp
#include <hip/hip_runtime.h>
#include <cstdint>
#include <cstdio>

#ifndef MK_LAUNCHES
#define MK_LAUNCHES 1
#endif

#ifndef FP8_L1
#define FP8_L1 1
#endif
#ifndef FP8_L0
#define FP8_L0 0
#endif

namespace {

typedef unsigned short bf16_t;
typedef int v8i __attribute__((ext_vector_type(8)));
typedef int v4i __attribute__((ext_vector_type(4)));
typedef short bf16x8 __attribute__((ext_vector_type(8)));
typedef short s16x4 __attribute__((ext_vector_type(4)));
typedef float f32x4 __attribute__((ext_vector_type(4)));
typedef float f32x16 __attribute__((ext_vector_type(16)));
typedef unsigned u32x4 __attribute__((ext_vector_type(4)));
typedef unsigned u32x2 __attribute__((ext_vector_type(2)));

constexpr int NTOK = 16384, DM = 2048, SEQ = 2048, NBATCH = 8, NH = 16, HD = 128;
constexpr int NSA_IN_W = 5168, KV6_W = 3072, NEXP = 32, DEXP = 1024, LISTCAP = 32768;
constexpr int NTHREADS = 512;
constexpr float LOG2E = 1.4426950408889634f;
constexpr float QSCALE = 0.08838834764831845f;
constexpr float RMS_EPS = 1e-6f;
constexpr int LDS_BYTES = 147456;
constexpr int NPHASES = 17;
constexpr bool kFp8[2] = {FP8_L0 != 0, FP8_L1 != 0};
constexpr float W8_SCALE = 64.f, W8_INV = 1.f / 64.f;

constexpr size_t al256(size_t x) { return (x + 255) & ~(size_t)255; }
constexpr size_t WS_CTL   = 0;
constexpr size_t CTL_BYTES = 65536;
constexpr size_t WS_WIN   = WS_CTL + CTL_BYTES;
constexpr size_t WS_CW1   = WS_WIN + (size_t)5376 * 2048 * 2;
constexpr size_t WS_WOUT  = WS_CW1 + (size_t)2 * 256 * 4096 * 2;
constexpr size_t WS_WKVQ  = WS_WOUT + (size_t)2048 * 2048 * 2;
constexpr size_t WS_WFO   = WS_WKVQ + (size_t)3072 * 2048 * 2;
constexpr size_t WS_GU    = WS_WFO + (size_t)2048 * 2048 * 2;
constexpr size_t WS_DN    = WS_GU + (size_t)2 * 32 * 2048 * 2048 * 2;
constexpr size_t WS_BIAS1 = WS_DN + (size_t)2 * 32 * 2048 * 1024 * 2;
constexpr size_t WS_RW    = WS_BIAS1 + 2 * 32 * 256 * 4;
constexpr size_t WS_WF    = WS_RW + (size_t)2 * 2048 * 32 * 4;
constexpr size_t WS_XBA   = al256(WS_WF + (size_t)2048 * 32 * 4);
constexpr size_t WS_XBB   = WS_XBA + (size_t)NTOK * DM * 2;
constexpr size_t WS_Q     = WS_XBB + (size_t)NTOK * DM * 2;
constexpr size_t WS_KV6   = WS_Q + (size_t)NTOK * DM * 2;
constexpr size_t WS_GATES = WS_KV6 + (size_t)NTOK * KV6_W * 2;
constexpr size_t WS_CPART = WS_GATES + (size_t)NTOK * 48 * 4;
constexpr size_t WS_KVCMP = WS_CPART + (size_t)2 * 8 * 4096 * 256 * 4;
constexpr size_t WS_OATT  = WS_KVCMP + (size_t)2 * 8 * 128 * 512 * 2;
constexpr size_t WS_X1    = WS_OATT + (size_t)NTOK * DM * 2;
constexpr size_t WS_X2    = WS_X1 + (size_t)NTOK * DM * 4;
constexpr size_t WS_H     = WS_X2 + (size_t)NTOK * DM * 4;
constexpr size_t WS_Y     = WS_H + (size_t)40960 * 1024 * 2;
constexpr size_t WS_LIST  = WS_Y + (size_t)32768 * 2048 * 2;
constexpr size_t WS_EW    = WS_LIST + (size_t)2 * 32 * LISTCAP * 4;
constexpr size_t WS_RSTD  = WS_EW + (size_t)2 * NTOK * 2 * 4;
constexpr size_t WS_KV2   = WS_RSTD + (size_t)3 * NTOK * 4;
constexpr size_t WS_LOGF  = WS_KV2 + (size_t)NTOK * 1024 * 2;
constexpr size_t WS_C2    = WS_LOGF + (size_t)NTOK * 16 * 4;
constexpr size_t WS_XB8   = WS_C2 + (size_t)8 * 16 * 2048 * 4;
constexpr size_t WS_END   = WS_XB8 + (size_t)NTOK * DM;
constexpr int CW_BAR = 0;
constexpr int CW_CNT = 4096;
constexpr int CW_END = CW_CNT + 2 * 32 * 64;
static_assert(CW_END * 4 <= (int)CTL_BYTES, "ctl");

struct Params {
    const float* in[22];
    float* out;
    unsigned char* ws;
    int ph_lo, ph_hi;
};

__device__ __forceinline__ unsigned cvtpk(float lo, float hi) {
    unsigned r; asm volatile("v_cvt_pk_bf16_f32 %0, %1, %2" : "=v"(r) : "v"(lo), "v"(hi)); return r;
}
__device__ __forceinline__ float bflo(unsigned w) { return __uint_as_float(w << 16); }
__device__ __forceinline__ float bfhi(unsigned w) { return __uint_as_float(w & 0xffff0000u); }
__device__ __forceinline__ bf16x8 pack8(f32x4 a, f32x4 b) {
    u32x4 w = {cvtpk(a[0], a[1]), cvtpk(a[2], a[3]), cvtpk(b[0], b[1]), cvtpk(b[2], b[3])};
    return *reinterpret_cast<bf16x8*>(&w);
}
__device__ __forceinline__ float wave_sum(float v) {
#pragma unroll
    for (int o = 32; o >= 1; o >>= 1) v += __shfl_xor(v, o);
    return v;
}
__device__ __forceinline__ float fast_exp2(float x) { return __builtin_amdgcn_exp2f(x); }
__device__ __forceinline__ float fast_rcp(float x) { return __builtin_amdgcn_rcpf(x); }

__device__ __forceinline__ const void* uniform_ptr(const void* p) {
    const unsigned long long a = (unsigned long long)p;
    const unsigned lo = __builtin_amdgcn_readfirstlane((unsigned)a), hi = __builtin_amdgcn_readfirstlane((unsigned)(a >> 32));
    return (const void*)(((unsigned long long)hi << 32) | lo);
}
__device__ __forceinline__ void glds16(unsigned voff, const void* sbase, unsigned ldsaddr) {
    unsigned keep; sbase = uniform_ptr(sbase); ldsaddr = __builtin_amdgcn_readfirstlane(ldsaddr);
    asm volatile("s_mov_b32 %0, m0\n\ts_mov_b32 m0, %3\n\ts_nop 0\n\tglobal_load_lds_dwordx4 %1, %2\n\ts_mov_b32 m0, %0"
                 : "=&s"(keep) : "v"(voff), "s"(sbase), "s"(ldsaddr) : "memory");
}
__device__ __forceinline__ void glds4(unsigned voff, const void* sbase, unsigned ldsaddr) {
    unsigned keep; sbase = uniform_ptr(sbase); ldsaddr = __builtin_amdgcn_readfirstlane(ldsaddr);
    asm volatile("s_mov_b32 %0, m0\n\ts_mov_b32 m0, %3\n\ts_nop 0\n\tglobal_load_lds_dword %1, %2\n\ts_mov_b32 m0, %0"
                 : "=&s"(keep) : "v"(voff), "s"(sbase), "s"(ldsaddr) : "memory");
}
__device__ __forceinline__ unsigned lds_addr(const void* p) { return (unsigned)(size_t)(__attribute__((address_space(3))) const char*)p; }

#define XB_TMO      128
#define XB_XCNT(j)  (256  + 64 * (j))
#define XB_XSUB(j)  (1280 + 64 * (j))
#define XB_XGEN(j)  (2304 + 64 * (j))
#define XB_TOP      3328
#define XB_TOPGEN   3392
#define XCD_BAR_WORDS 3456
#define XB_SPIN_CAP (1u << 20)
#define LAS __attribute__((address_space(3)))

__device__ __forceinline__ unsigned xb_ld(unsigned* p)              { return __hip_atomic_load(p, __ATOMIC_RELAXED, __HIP_MEMORY_SCOPE_AGENT); }
__device__ __forceinline__ unsigned xb_add(unsigned* p, unsigned v) { return __hip_atomic_fetch_add(p, v, __ATOMIC_RELAXED, __HIP_MEMORY_SCOPE_AGENT); }
__device__ __forceinline__ unsigned xb_xcc_id() { return (unsigned)__builtin_amdgcn_s_getreg((3 << 11) | 20) & 0xFu; }
#define XB_SPIN(cond, bar) do { unsigned _sp = 0; while (cond) { __builtin_amdgcn_s_sleep(1); \
    if ((++_sp & 255u) == 0u) { if (xb_ld(&(bar)[XB_TMO])) break; if (_sp > XB_SPIN_CAP) { atomicAdd(&(bar)[XB_TMO], 1u); break; } } } } while (0)

struct XcdBarrier { unsigned* bar; unsigned x; volatile LAS unsigned* st; };

__device__ __forceinline__ XcdBarrier xcd_barrier_post(unsigned* bar, volatile LAS unsigned* st) {
    XcdBarrier b; b.bar = bar; b.x = xb_xcc_id(); b.st = st;
    if (threadIdx.x == 0) (void)xb_add(&bar[XB_XCNT(b.x)], 1u);
    return b;
}
__device__ __forceinline__ void xcd_barrier_complete(unsigned* bar, unsigned x, unsigned& nloc, unsigned& nx) {
    const unsigned G = gridDim.x * gridDim.y * gridDim.z;
    unsigned sum, cnt, mine, sp = 0u;
    for (;;) {
        sum = 0u; cnt = 0u; mine = 0u;
#pragma unroll
        for (unsigned j = 0; j < 16; ++j) { const unsigned c = xb_ld(&bar[XB_XCNT(j)]); sum += c; cnt += (c > 0u) ? 1u : 0u; mine = (j == x) ? c : mine; }
        if (sum == G) break;
        __builtin_amdgcn_s_sleep(1);
        if ((++sp & 255u) == 0u) { if (xb_ld(&bar[XB_TMO])) break; if (sp > XB_SPIN_CAP) { atomicAdd(&bar[XB_TMO], 1u); break; } }
    }
    nloc = mine > 0u ? mine : 1u; nx = cnt > 0u ? cnt : 1u;
}
__device__ __forceinline__ void xcd_barrier(const XcdBarrier& b) {
    asm volatile("s_waitcnt vmcnt(0)" ::: "memory");
    __syncthreads();
    if (threadIdx.x == 0) {
        unsigned* bar = b.bar;
        __builtin_amdgcn_s_waitcnt(0);
        unsigned nloc = b.st[0], nx = b.st[1];
        if (nloc == 0u) { xcd_barrier_complete(bar, b.x, nloc, nx); b.st[0] = nloc; b.st[1] = nx; }
        const unsigned old = xb_add(&bar[XB_XSUB(b.x)], 1u);
        const unsigned gen = old / nloc;
        if (old + 1u == (gen + 1u) * nloc) {
            __builtin_amdgcn_fence(__ATOMIC_RELEASE, "agent");
            asm volatile("s_waitcnt vmcnt(0)" ::: "memory");
            const unsigned og = xb_add(&bar[XB_TOP], 1u);
            const unsigned tg = og / nx;
            if (og + 1u == (tg + 1u) * nx) xb_add(&bar[XB_TOPGEN], 1u);
            else XB_SPIN(xb_ld(&bar[XB_TOPGEN]) == tg, bar);
            __builtin_amdgcn_fence(__ATOMIC_ACQUIRE, "agent");
            xb_add(&bar[XB_XGEN(b.x)], 1u);
            asm volatile("s_waitcnt vmcnt(0)" ::: "memory");
        } else {
            XB_SPIN(xb_ld(&bar[XB_XGEN(b.x)]) == gen, bar);
            __builtin_amdgcn_fence(__ATOMIC_ACQUIRE, "agent");
            asm volatile("s_waitcnt vmcnt(0)" ::: "memory");
        }
    }
    __syncthreads();
}

__device__ __forceinline__ int lds_byte(int r, int c) { const int st = (r >> 4) * 2 + (c >> 5), rr = r & 15, cc = c & 31, ob = rr * 64 + cc * 2; return st * 1024 + (ob ^ (((ob >> 9) & 1) << 5)); }
__device__ __forceinline__ void stage_rc(int b, int& R, int& C) { const int st = b / 1024, sb = b % 1024, swz = sb ^ (((sb >> 9) & 1) << 5); R = (st >> 1) * 16 + swz / 64; C = (st & 1) * 32 + (swz % 64) / 2; }
__device__ __forceinline__ int perm32(int rho) { const int n = rho >> 4, i = rho & 15; return 8 * (i >> 2) + 4 * n + (i & 3); }

typedef f32x4 AccT[2][2][4][2];

#define G_SA(b, h) (ldsb + (((b) * 2 + (h)) * 16384))
#define G_SB(b, h) (ldsb + ((4 + (b) * 2 + (h)) * 16384))
#define AKOFF(t) ((size_t)((unsigned)((t) >> 1) * astep2 + (unsigned)((t) & 1) * 128u))
#define STAGE_A(buf, h, t) do { const char* _p = Ab + AKOFF(t); \
    glds16((h) ? ao2 : ao0, _p, ldsw + ((buf) * 2 + (h)) * 16384); glds16((h) ? ao3 : ao1, _p, ldsw + ((buf) * 2 + (h)) * 16384 + 8192); } while (0)
#define STAGE_B(buf, h, t) do { const char* _p = Bb + (size_t)(h) * 128 * ldb + (size_t)(t) * 128u; \
    glds16(bo, _p, ldsw + (4 + (buf) * 2 + (h)) * 16384); glds16(bo, _p + (size_t)64 * ldb, ldsw + (4 + (buf) * 2 + (h)) * 16384 + 8192); } while (0)
#define LDA(dst, b, h) for (int m = 0; m < 4; ++m) for (int k = 0; k < 2; ++k) \
    dst[m][k] = *reinterpret_cast<const bf16x8*>(G_SA(b, h) + lds_byte(wr * 64 + m * 16 + fr, k * 32 + fq * 8))
#define LDB(dst, b, h) for (int n = 0; n < 2; ++n) for (int k = 0; k < 2; ++k) \
    dst[n][k] = *reinterpret_cast<const bf16x8*>(G_SB(b, h) + lds_byte(wc * 32 + n * 16 + fr, k * 32 + fq * 8))
#define MMA(ai, bj, At_, Bt_) do { __builtin_amdgcn_s_setprio(1); \
    for (int m = 0; m < 4; ++m) for (int n = 0; n < 2; ++n) for (int k = 0; k < 2; ++k) \
      acc[ai][bj][m][n] = __builtin_amdgcn_mfma_f32_16x16x32_bf16(Bt_[n][k], At_[m][k], acc[ai][bj][m][n], 0, 0, 0); \
    __builtin_amdgcn_s_setprio(0); } while (0)
typedef short s16x16 __attribute__((ext_vector_type(16)));
__device__ __forceinline__ v8i cat8(bf16x8 a, bf16x8 b) { const s16x16 t = __builtin_shufflevector(a, b, 0, 1, 2, 3, 4, 5, 6, 7, 8, 9, 10, 11, 12, 13, 14, 15); return __builtin_bit_cast(v8i, t); }
#define CAT8(x, y) cat8(x, y)
__device__ __forceinline__ void mfma8(f32x4& acc, v8i a, v8i b, unsigned sc) {
    asm volatile("v_mfma_scale_f32_16x16x128_f8f6f4 %0, %1, %2, %0, %3, %3 op_sel_hi:[0,0,0]" : "+v"(acc) : "v"(a), "v"(b), "v"(sc));
}
#define MMA8(ai, bj, At_, Bt_) do { __builtin_amdgcn_s_setprio(1); \
    _Pragma("unroll") for (int m = 0; m < 4; ++m) _Pragma("unroll") for (int n = 0; n < 2; ++n) \
      mfma8(acc[ai][bj][m][n], CAT8(Bt_[n][0], Bt_[n][1]), CAT8(At_[m][0], At_[m][1]), sc127); \
    __builtin_amdgcn_s_setprio(0); } while (0)
#define MMAX(ai, bj, At_, Bt_) do { if (FP8) MMA8(ai, bj, At_, Bt_); else MMA(ai, bj, At_, Bt_); } while (0)
#define WAIT_V(n) asm volatile("s_waitcnt vmcnt(" #n ")" ::: "memory")
#define WAIT_L(n) asm volatile("s_waitcnt lgkmcnt(" #n ")" ::: "memory")
#define BAR __builtin_amdgcn_s_barrier()
#define SCHED __builtin_amdgcn_sched_barrier(0)

template <bool PERM, bool FP8, class Epi>
__device__ __forceinline__ void gemm256(unsigned char* lds, const char* __restrict__ Ab, const char* __restrict__ Bb, const unsigned ldb,
                                        const unsigned astep2, const int nt, const unsigned ao0, const unsigned ao1, const unsigned ao2,
                                        const unsigned ao3, const Epi& epi) {
    char* ldsb = (char*)lds;
    int tid = threadIdx.x;
    const unsigned ldsw = lds_addr(lds) + (unsigned)__builtin_amdgcn_readfirstlane(tid >> 6) * 1024u;
    int wid = tid >> 6, lane = tid & 63, wr = wid >> 2, wc = wid & 3, fr = lane & 15, fq = lane >> 4;
    unsigned bo; { int R, C; stage_rc(tid * 16, R, C); const int pr = PERM ? ((R & ~31) | perm32(R & 31)) : R; bo = (unsigned)pr * ldb + (unsigned)C * 2u; }
    AccT acc = {};
    bf16x8 At[4][2], B0[2][2], B1[2][2];
    unsigned sc127 = 127u; if (FP8) asm volatile("" : "+v"(sc127));
    STAGE_B(0, 0, 0); STAGE_A(0, 0, 0);
    STAGE_B(0, 1, 0); STAGE_A(0, 1, 0);
    if (wr == 1) BAR;
    WAIT_V(4); BAR;
    STAGE_B(1, 0, 1); STAGE_A(1, 0, 1); STAGE_B(1, 1, 1);
    WAIT_V(6); BAR;
    for (int t = 0; t < nt - 2; t += 2) {
        LDB(B0, 0, 0); SCHED; LDA(At, 0, 0); STAGE_A(1, 1, t + 1);
        WAIT_L(8); BAR; WAIT_L(0); MMAX(0, 0, At, B0); BAR; SCHED;
        LDB(B1, 0, 1); STAGE_B(0, 0, t + 2);
        BAR; WAIT_L(0); MMAX(0, 1, At, B1); BAR;
        LDA(At, 0, 1); STAGE_A(0, 0, t + 2);
        BAR; WAIT_L(0); MMAX(1, 0, At, B0); BAR; SCHED;
        STAGE_B(0, 1, t + 2);
        WAIT_V(6); BAR; MMAX(1, 1, At, B1); BAR;
        LDB(B0, 1, 0); SCHED; LDA(At, 1, 0); STAGE_A(0, 1, t + 2);
        WAIT_L(8); BAR; WAIT_L(0); MMAX(0, 0, At, B0); BAR; SCHED;
        LDB(B1, 1, 1); STAGE_B(1, 0, t + 3);
        BAR; WAIT_L(0); MMAX(0, 1, At, B1); BAR;
        LDA(At, 1, 1); STAGE_A(1, 0, t + 3);
        BAR; WAIT_L(0); MMAX(1, 0, At, B0); BAR; SCHED;
        STAGE_B(1, 1, t + 3);
        WAIT_V(6); BAR; MMAX(1, 1, At, B1); BAR;
    }
    { int tz = threadIdx.x; asm volatile("" : "+v"(tz)); tid = tz; wid = tz >> 6; lane = tz & 63; wr = wid >> 2; wc = wid & 3; fr = lane & 15; fq = lane >> 4; }
    { LDB(B0, 0, 0); WAIT_V(0); LDA(At, 0, 0); STAGE_A(1, 1, nt - 1);
      BAR; WAIT_L(0); MMAX(0, 0, At, B0); BAR;
      LDB(B1, 0, 1); BAR; WAIT_L(0); MMAX(0, 1, At, B1); BAR;
      LDA(At, 0, 1); WAIT_V(4); BAR; WAIT_L(0); MMAX(1, 0, At, B0); MMAX(1, 1, At, B1); BAR; }
    { LDB(B0, 1, 0); LDA(At, 1, 0); WAIT_V(2); BAR; WAIT_L(0); MMAX(0, 0, At, B0); BAR;
      LDB(B1, 1, 1); WAIT_V(0); BAR; WAIT_L(0); MMAX(0, 1, At, B1); BAR;
      LDA(At, 1, 1); BAR; WAIT_L(0); MMAX(1, 0, At, B0); MMAX(1, 1, At, B1); BAR; }
    if (wr == 0) BAR;
    epi(acc, wr, wc, fr, fq);
    __syncthreads();
}

__device__ __forceinline__ void tile_order(int L, int nM, int nN, int& pm, int& pn) {
    const int nwg = nM * nN; int wgid = L;
    { const int q = nwg / 8, r = nwg % 8, xcd = wgid % 8, off = wgid / 8; wgid = (xcd < r ? xcd * (q + 1) : r * (q + 1) + (xcd - r) * q) + off; }
    const int nig = 8 * nN, gid = wgid / nig, fm = gid * 8, gsz = (nM - fm) < 8 ? (nM - fm) : 8;
    pm = fm + ((wgid % nig) % gsz); pn = (wgid % nig) / gsz;
}
__device__ __forceinline__ void stage_row_col(int tid, int& R0, int& C) { stage_rc(tid * 16, R0, C); }


__device__ __forceinline__ u32x4 pack8v(f32x4 a, f32x4 b) { u32x4 w = {cvtpk(a[0], a[1]), cvtpk(a[2], a[3]), cvtpk(b[0], b[1]), cvtpk(b[2], b[3])}; return w; }
__device__ __forceinline__ u32x2 pack8_fp8(f32x4 a, f32x4 b) {
    unsigned w0 = 0, w1 = 0;
    w0 = __builtin_amdgcn_cvt_pk_fp8_f32(a[0], a[1], w0, false); w0 = __builtin_amdgcn_cvt_pk_fp8_f32(a[2], a[3], w0, true);
    w1 = __builtin_amdgcn_cvt_pk_fp8_f32(b[0], b[1], w1, false); w1 = __builtin_amdgcn_cvt_pk_fp8_f32(b[2], b[3], w1, true);
    return (u32x2){w0, w1};
}
__device__ __forceinline__ float sigmoidf_(float x) { return fast_rcp(1.f + fast_exp2(-x * LOG2E)); }

struct EpiProj0 {
    bf16_t* Q; bf16_t* KV6; float* gates; int row0, pn;
    __device__ __forceinline__ void operator()(const AccT& acc, int wr, int wc, int fr, int fq) const {
#pragma unroll
        for (int ai = 0; ai < 2; ++ai)
#pragma unroll
            for (int m = 0; m < 4; ++m) {
                const size_t row = (size_t)(row0 + ai * 128 + wr * 64 + m * 16 + fr);
#pragma unroll
                for (int bj = 0; bj < 2; ++bj) {
                    const int col8 = bj * 128 + wc * 32 + 8 * fq;
                    f32x4 v0 = acc[ai][bj][m][0], v1 = acc[ai][bj][m][1];
                    if (pn < 8) { v0 *= QSCALE; v1 *= QSCALE; *(u32x4*)(Q + row * DM + pn * 256 + col8) = pack8v(v0, v1); }
                    else if (pn < 20) { *(u32x4*)(KV6 + row * KV6_W + (pn - 8) * 256 + col8) = pack8v(v0, v1); }
                    else if (col8 < 48) {
                        f32x4 s0, s1;
#pragma unroll
                        for (int j = 0; j < 4; ++j) { s0[j] = sigmoidf_(v0[j]); s1[j] = sigmoidf_(v1[j]); }
                        *(f32x4*)(gates + row * 48 + col8) = s0; *(f32x4*)(gates + row * 48 + col8 + 4) = s1;
                    }
                }
            }
    }
};
struct EpiF32 {
    float* C;
    __device__ __forceinline__ void operator()(const AccT& acc, int wr, int wc, int fr, int fq) const {
#pragma unroll
        for (int ai = 0; ai < 2; ++ai)
#pragma unroll
            for (int m = 0; m < 4; ++m) {
                float* rowp = C + (size_t)(ai * 128 + wr * 64 + m * 16 + fr) * 256 + wc * 32 + 4 * fq;
#pragma unroll
                for (int bj = 0; bj < 2; ++bj)
#pragma unroll
                    for (int n = 0; n < 2; ++n) *(f32x4*)(rowp + bj * 128 + n * 16) = acc[ai][bj][m][n];
            }
    }
};
struct EpiOut {
    const float* xold; float* xnew; bf16_t* xb; unsigned char* xb8; int row0, col0;
    __device__ __forceinline__ void operator()(const AccT& acc, int wr, int wc, int fr, int fq) const {
#pragma unroll
        for (int ai = 0; ai < 2; ++ai)
#pragma unroll
            for (int m = 0; m < 4; ++m) {
                const size_t row = (size_t)(row0 + ai * 128 + wr * 64 + m * 16 + fr);
#pragma unroll
                for (int bj = 0; bj < 2; ++bj) {
                    const size_t off = row * DM + col0 + bj * 128 + wc * 32 + 8 * fq;
                    f32x4 v0 = acc[ai][bj][m][0] + *(const f32x4*)(xold + off), v1 = acc[ai][bj][m][1] + *(const f32x4*)(xold + off + 4);
                    *(f32x4*)(xnew + off) = v0; *(f32x4*)(xnew + off + 4) = v1;
                    *(u32x4*)(xb + off) = pack8v(v0, v1);
                    if (xb8) *(u32x2*)(xb8 + off) = pack8_fp8(v0, v1);
                }
            }
    }
};
struct EpiKVQ {
    bf16_t* KV2; bf16_t* Q; const float* rstd; int row0, pn;
    __device__ __forceinline__ void operator()(const AccT& acc, int wr, int wc, int fr, int fq) const {
#pragma unroll
        for (int ai = 0; ai < 2; ++ai)
#pragma unroll
            for (int m = 0; m < 4; ++m) {
                const size_t row = (size_t)(row0 + ai * 128 + wr * 64 + m * 16 + fr);
                float rs = rstd[row]; if (pn >= 4) rs *= QSCALE;
#pragma unroll
                for (int bj = 0; bj < 2; ++bj) {
                    const int col8 = bj * 128 + wc * 32 + 8 * fq;
                    const f32x4 v0 = acc[ai][bj][m][0] * rs, v1 = acc[ai][bj][m][1] * rs;
                    if (pn < 4) *(u32x4*)(KV2 + row * 1024 + pn * 256 + col8) = pack8v(v0, v1);
                    else *(u32x4*)(Q + row * DM + (pn - 4) * 256 + col8) = pack8v(v0, v1);
                }
            }
    }
};
template <bool FP8> struct EpiGU {
    void* H; const int* list; const float* rstd; int hrow0, pn, nvalid;
    __device__ __forceinline__ void operator()(const AccT& acc, int wr, int wc, int fr, int fq) const {
#pragma unroll
        for (int ai = 0; ai < 2; ++ai)
#pragma unroll
            for (int m = 0; m < 4; ++m) {
                const int lr = ai * 128 + wr * 64 + m * 16 + fr;
                if (lr < nvalid) {
                    const float rs = rstd[list[lr] >> 1] * (FP8 ? W8_INV : 1.f);
                    f32x4 h0, h1;
#pragma unroll
                    for (int j = 0; j < 4; ++j) {
                        const float g0 = acc[ai][0][m][0][j] * rs, u0 = acc[ai][1][m][0][j] * rs, g1 = acc[ai][0][m][1][j] * rs, u1 = acc[ai][1][m][1][j] * rs;
                        h0[j] = g0 * sigmoidf_(g0) * u0; h1[j] = g1 * sigmoidf_(g1) * u1;
                    }
                    const size_t off = (size_t)(hrow0 + lr) * DEXP + pn * 128 + wc * 32 + 8 * fq;
                    if (FP8) *(u32x2*)((unsigned char*)H + off) = pack8_fp8(h0, h1);
                    else *(u32x4*)((bf16_t*)H + off) = pack8v(h0, h1);
                }
            }
    }
};
struct EpiDN {
    bf16_t* Y; const int* list; int pn, nvalid; float oscale;
    __device__ __forceinline__ void operator()(const AccT& acc, int wr, int wc, int fr, int fq) const {
#pragma unroll
        for (int ai = 0; ai < 2; ++ai)
#pragma unroll
            for (int m = 0; m < 4; ++m) {
                const int lr = ai * 128 + wr * 64 + m * 16 + fr;
                if (lr < nvalid) {
                    bf16_t* rowp = Y + (size_t)list[lr] * DM + pn * 256 + wc * 32 + 8 * fq;
#pragma unroll
                    for (int bj = 0; bj < 2; ++bj) *(u32x4*)(rowp + bj * 128) = pack8v(acc[ai][bj][m][0] * oscale, acc[ai][bj][m][1] * oscale);
                }
            }
    }
};

struct CvtJob { const float* src; bf16_t* dst; const float* gain; int K, ld, ncols, tilesN, tilesKN; size_t srcE, dstE; int pA, pB, pC; bool f8; };
constexpr int NJOBS = 13;
__device__ __forceinline__ int job_tiles(int j) {
    switch (j) { case 0: return 16 * 41; case 1: case 2: return 32 * 2; case 3: return 16 * 16; case 4: return 16 * 8; case 5: case 6: return 16 * 16; default: return 4096; }
}
__device__ __forceinline__ void get_job(const Params& P, int j, CvtJob& J) {
    unsigned char* ws = P.ws;
    J.gain = nullptr; J.srcE = 0; J.dstE = 0; J.pA = 1 << 30; J.pB = 0; J.pC = 0; J.f8 = (j >= 7) && kFp8[(j >= 10) ? 1 : 0];
    const int l = (j >= 10) ? 1 : 0;
    switch (j) {
    case 0: J.src = P.in[1]; J.dst = (bf16_t*)(ws + WS_WIN); J.K = 2048; J.ld = 5168; J.ncols = 5168; break;
    case 1: J.src = P.in[4]; J.dst = (bf16_t*)(ws + WS_CW1); J.K = 4096; J.ld = 256; J.ncols = 256; break;
    case 2: J.src = P.in[6]; J.dst = (bf16_t*)(ws + WS_CW1) + (size_t)256 * 4096; J.K = 4096; J.ld = 256; J.ncols = 256; break;
    case 3: J.src = P.in[8]; J.dst = (bf16_t*)(ws + WS_WOUT); J.K = 2048; J.ld = 2048; J.ncols = 2048; break;
    case 4: J.src = P.in[10]; J.dst = (bf16_t*)(ws + WS_WKVQ); J.K = 2048; J.ld = 1040; J.ncols = 1024; J.gain = P.in[9]; break;
    case 5: J.src = P.in[12]; J.dst = (bf16_t*)(ws + WS_WKVQ) + (size_t)1024 * 2048; J.K = 2048; J.ld = 2048; J.ncols = 2048; J.gain = P.in[14] + DM; break;
    case 6: J.src = P.in[13]; J.dst = (bf16_t*)(ws + WS_WFO); J.K = 2048; J.ld = 2048; J.ncols = 2048; break;
    case 7: case 10: J.src = P.in[18] + (size_t)l * 32 * 2048 * 1024; J.dst = (bf16_t*)(ws + WS_GU) + (size_t)l * 32 * 2048 * 2048; J.K = 2048; J.ld = 1024; J.ncols = 1024;
        J.gain = P.in[15] + l * DM; J.srcE = (size_t)2048 * 1024; J.dstE = (size_t)2048 * 2048; J.pA = 128; J.pB = 256; J.pC = 0; break;
    case 8: case 11: J.src = P.in[19] + (size_t)l * 32 * 2048 * 1024; J.dst = (bf16_t*)(ws + WS_GU) + (size_t)l * 32 * 2048 * 2048; J.K = 2048; J.ld = 1024; J.ncols = 1024;
        J.gain = P.in[15] + l * DM; J.srcE = (size_t)2048 * 1024; J.dstE = (size_t)2048 * 2048; J.pA = 128; J.pB = 256; J.pC = 128; break;
    default: J.src = P.in[20] + (size_t)l * 32 * 1024 * 2048; J.dst = (bf16_t*)(ws + WS_DN) + (size_t)l * 32 * 2048 * 1024; J.K = 1024; J.ld = 2048; J.ncols = 2048;
        J.srcE = (size_t)1024 * 2048; J.dstE = (size_t)2048 * 1024; break;
    }
    J.tilesN = (J.ncols + 127) / 128; J.tilesKN = J.tilesN * (J.K / 128);
}
struct CvtRegs { f32x4 v[8]; float gn[8]; };
__device__ __forceinline__ void cvt_load(const CvtJob& J, int idx, CvtRegs& R) {
    const int tid = threadIdx.x;
    const int e = idx / J.tilesKN, rem = idx - e * J.tilesKN, ktile = rem / J.tilesN, ntile = rem - ktile * J.tilesN;
    const float* src = J.src + (size_t)e * J.srcE;
    const int k0 = ktile * 128, n0 = ntile * 128, nn = (tid & 31) * 4;
    const bool okc = (n0 + nn) < J.ncols;
#pragma unroll
    for (int p = 0; p < 8; ++p) {
        const int kk = (tid >> 5) + 16 * p;
        R.v[p] = (f32x4){0.f, 0.f, 0.f, 0.f};
        if (okc) R.v[p] = __builtin_nontemporal_load((const f32x4*)(src + (size_t)(k0 + kk) * J.ld + n0 + nn));
        R.gn[p] = J.gain ? J.gain[k0 + kk] : 1.f;
    }
}
__device__ __forceinline__ void cvt_store(const CvtJob& J, int idx, const CvtRegs& R, float* T  ) {
    const int tid = threadIdx.x;
    const int e = idx / J.tilesKN, rem = idx - e * J.tilesKN, ktile = rem / J.tilesN, ntile = rem - ktile * J.tilesN;
    bf16_t* dst = J.dst + (size_t)e * J.dstE;
    const int k0 = ktile * 128, n0 = ntile * 128, nn = (tid & 31) * 4;
#pragma unroll
    for (int p = 0; p < 8; ++p) {
        const int kk = (tid >> 5) + 16 * p;
        float* t = T + kk * 129 + nn; const f32x4 v = R.v[p] * R.gn[p];
        t[0] = v[0]; t[1] = v[1]; t[2] = v[2]; t[3] = v[3];
    }
    __syncthreads();
    if (!J.f8) {
        const int kc = (tid & 15) * 8;
#pragma unroll
        for (int p = 0; p < 4; ++p) {
            const int n = (tid >> 4) + 32 * p, ng = n0 + n;
            if (ng < J.ncols) {
                const float* t = T + kc * 129 + n;
                f32x4 a = {t[0], t[129], t[258], t[387]}, b = {t[516], t[645], t[774], t[903]};
                const int drow = (ng / J.pA) * J.pB + J.pC + (ng % J.pA);
                *(u32x4*)(dst + (size_t)drow * J.K + k0 + kc) = pack8v(a, b);
            }
        }
    } else {
        const int kc = (tid & 7) * 16;
        unsigned char* dst8 = (unsigned char*)J.dst + (size_t)e * J.dstE;
#pragma unroll
        for (int p = 0; p < 2; ++p) {
            const int n = (tid >> 3) + 64 * p, ng = n0 + n;
            if (ng < J.ncols) {
                const float* t = T + kc * 129 + n;
                f32x4 a = {t[0], t[129], t[258], t[387]}, b = {t[516], t[645], t[774], t[903]}, c = {t[1032], t[1161], t[1290], t[1419]}, d = {t[1548], t[1677], t[1806], t[1935]};
                const u32x2 lo = pack8_fp8(a * W8_SCALE, b * W8_SCALE), hi = pack8_fp8(c * W8_SCALE, d * W8_SCALE);
                const int drow = (ng / J.pA) * J.pB + J.pC + (ng % J.pA);
                *(u32x4*)(dst8 + (size_t)drow * J.K + k0 + kc) = (u32x4){lo[0], lo[1], hi[0], hi[1]};
            }
        }
    }
    __syncthreads();
}
__device__ __forceinline__ int find_job(int g, int& jbase) { int b2 = 0, j = 0; for (; j < NJOBS - 1; ++j) { const int n = job_tiles(j); if (g < b2 + n) break; b2 += n; } jbase = b2; return j; }
__device__ __forceinline__ void phase_convert(const Params& P, unsigned char* lds, int jlo, int jhi) {
    float* T = (float*)lds;
    int base = 0;
    for (int j = 0; j < jlo; ++j) base += job_tiles(j);
    int total = base;
    for (int j = jlo; j < jhi; ++j) total += job_tiles(j);
    int g = base + blockIdx.x;
    if (g >= total) return;
    CvtJob Jc, Jn; CvtRegs Rc, Rn;
    int jbc, jbn, jc = find_job(g, jbc); get_job(P, jc, Jc);
    cvt_load(Jc, g - jbc, Rc);
    for (;;) {
        const int gn = g + gridDim.x; const bool more = gn < total;
        if (more) { const int jn = find_job(gn, jbn); get_job(P, jn, Jn); cvt_load(Jn, gn - jbn, Rn); }
        cvt_store(Jc, g - jbc, Rc, T);
        if (!more) break;
        Jc = Jn; Rc = Rn; jbc = jbn; g = gn;
    }
}
__device__ __forceinline__ void phase0_misc(const Params& P, unsigned char* lds) {
    unsigned char* ws = P.ws;
    const int tid = threadIdx.x, lane = tid & 63, wave = tid >> 6;
    {
        const float* x = P.in[0]; const float* gain = P.in[14]; bf16_t* h0 = (bf16_t*)(ws + WS_XBA);
        for (int row = blockIdx.x * 8 + wave; row < NTOK; row += gridDim.x * 8) {
            const float* xr = x + (size_t)row * DM + lane * 4;
            f32x4 v[8]; float ss = 0.f;
#pragma unroll
            for (int j = 0; j < 8; ++j) { v[j] = *(const f32x4*)(xr + j * 256); ss += v[j][0] * v[j][0] + v[j][1] * v[j][1] + v[j][2] * v[j][2] + v[j][3] * v[j][3]; }
            ss = wave_sum(ss);
            const float rstd = rsqrtf(ss * (1.f / DM) + RMS_EPS);
#pragma unroll
            for (int j = 0; j < 8; ++j) {
                const f32x4 gv = *(const f32x4*)(gain + j * 256 + lane * 4);
                const f32x4 o = v[j] * rstd * gv;
                u32x2 w = {cvtpk(o[0], o[1]), cvtpk(o[2], o[3])};
                *(u32x2*)(h0 + (size_t)row * DM + j * 256 + lane * 4) = w;
            }
        }
    }
    {
        float* rw = (float*)(ws + WS_RW); float* wf = (float*)(ws + WS_WF);
        const int gtid = blockIdx.x * NTHREADS + tid, gsz = gridDim.x * NTHREADS;
        for (int i = gtid; i < 2 * 2048 * 32; i += gsz) { const int l = i >> 16, k = (i >> 5) & 2047, e = i & 31; rw[i] = P.in[15][l * DM + k] * P.in[16][k * 32 + e]; }
        for (int i = gtid; i < 2048 * 32; i += gsz) { const int k = i >> 5, j = i & 31; wf[i] = (j < 16) ? P.in[9][k] * P.in[10][(size_t)k * 1040 + 1024 + j] : 0.f; }
    }
    for (int w = blockIdx.x; w < 64; w += gridDim.x) {
        const int kv = w >> 5, ch = w & 31; const float* pe = P.in[kv ? 3 : 2]; const float* w1 = P.in[kv ? 6 : 4];
        float* red = (float*)lds;
        const int j = tid & 255, half = tid >> 8; float s = 0.f;
        const int i0 = ch * 128 + half * 64;
#pragma unroll 16
        for (int i = i0; i < i0 + 64; ++i) s += pe[i] * w1[(size_t)i * 256 + j];
        __syncthreads();
        red[tid] = s; __syncthreads();
        if (tid < 256) ((float*)(ws + WS_BIAS1))[(kv * 32 + ch) * 256 + tid] = red[tid] + red[tid + 256];
        __syncthreads();
    }
}

__device__ __forceinline__ void lin_offsets(int tid, unsigned lda, unsigned& a0, unsigned& a1, unsigned& a2, unsigned& a3) {
    int R0, C; stage_rc(tid * 16, R0, C);
    a0 = (unsigned)R0 * lda + C * 2; a1 = (unsigned)(R0 + 64) * lda + C * 2; a2 = (unsigned)(R0 + 128) * lda + C * 2; a3 = (unsigned)(R0 + 192) * lda + C * 2;
}
__device__ __forceinline__ void phase_proj0(const Params& P, unsigned char* lds) {
    unsigned char* ws = P.ws;
    unsigned a0, a1, a2, a3; lin_offsets(threadIdx.x, DM * 2, a0, a1, a2, a3);
    for (int L = blockIdx.x; L < 64 * 21; L += gridDim.x) {
        int pm, pn; tile_order(L, 64, 21, pm, pn);
        EpiProj0 E{(bf16_t*)(ws + WS_Q), (bf16_t*)(ws + WS_KV6), (float*)(ws + WS_GATES), pm * 256, pn};
        gemm256<true, false>(lds, (const char*)(ws + WS_XBA) + (size_t)pm * 256 * DM * 2, (const char*)(ws + WS_WIN) + (size_t)pn * 256 * DM * 2, DM * 2, 256u, DM / 64, a0, a1, a2, a3, E);
    }
}
__device__ __forceinline__ void phase_cmp1(const Params& P, unsigned char* lds) {
    unsigned char* ws = P.ws;
    int R0, C; stage_rc(threadIdx.x * 16, R0, C);
    for (int u = blockIdx.x; u < 256; u += gridDim.x) {
        const int kv = u >> 7, mt = (u >> 3) & 15, ks = u & 7;
        unsigned ao[4];
#pragma unroll
        for (int q = 0; q < 4; ++q) {
            int r = mt * 256 + R0 + 64 * q; if (r > 4063) r = 4063;
            const int b = r / 508, rem = r - b * 508, n = rem >> 2, g = rem & 3;
            ao[q] = (unsigned)(((b * SEQ + n * 16) * KV6_W + kv * 512 + g * 128 + C) * 2);
        }
        EpiF32 E{(float*)(ws + WS_CPART) + ((size_t)(kv * 8 + ks) * 4096 + mt * 256) * 256};
        gemm256<false, false>(lds, (const char*)(ws + WS_KV6) + (size_t)ks * 4 * KV6_W * 2, (const char*)(ws + WS_CW1) + ((size_t)kv * 256 * 4096 + ks * 512) * 2, 4096 * 2,
                       (unsigned)(KV6_W * 2), 8, ao[0], ao[1], ao[2], ao[3], E);
    }
}
__device__ __forceinline__ float gelu_tanh(float x) {
    const float u = 0.7978845608028654f * (x + 0.044715f * x * x * x);
    const float t = 1.f - 2.f * fast_rcp(1.f + fast_exp2(2.f * LOG2E * u));
    return 0.5f * x * (1.f + t);
}
__device__ __forceinline__ void phase_cmp2(const Params& P, unsigned char* lds) {
    unsigned char* ws = P.ws;
    const int tid = threadIdx.x;
    float* hid = (float*)lds;
    const float* part = (const float*)(ws + WS_CPART);
    bf16_t* kvc = (bf16_t*)(ws + WS_KVCMP);
    for (int grp = blockIdx.x; grp < 256; grp += gridDim.x) {
        const int kv = grp >> 7, r0 = (grp & 127) * 32;
        {
            const int col = tid & 255, i0 = tid >> 8;
            float bias = 0.f;
#pragma unroll 8
            for (int ch = 0; ch < 32; ++ch) bias += ((const float*)(ws + WS_BIAS1))[(kv * 32 + ch) * 256 + col];
#pragma unroll 4
            for (int ii = 0; ii < 16; ++ii) {
                const int i = i0 + 2 * ii, r = r0 + i;
                float s = bias;
#pragma unroll
                for (int ks = 0; ks < 8; ++ks) s += part[((size_t)(kv * 8 + ks) * 4096 + r) * 256 + col];
                hid[i * 256 + col] = gelu_tanh(s);
            }
        }
        __syncthreads();
        {
            const float* w2 = P.in[kv ? 7 : 5];
            const int j = tid & 127, i0 = tid >> 7;
            float acc[8];
#pragma unroll
            for (int ii = 0; ii < 8; ++ii) acc[ii] = 0.f;
            for (int k = 0; k < 256; k += 4) {
                const float w0 = w2[(k + 0) * 128 + j], w1 = w2[(k + 1) * 128 + j], w2v = w2[(k + 2) * 128 + j], w3 = w2[(k + 3) * 128 + j];
#pragma unroll
                for (int ii = 0; ii < 8; ++ii) {
                    const f32x4 h = *(const f32x4*)(hid + (i0 + 4 * ii) * 256 + k);
                    acc[ii] += h[0] * w0 + h[1] * w1 + h[2] * w2v + h[3] * w3;
                }
            }
#pragma unroll
            for (int ii = 0; ii < 8; ++ii) {
                const int r = r0 + i0 + 4 * ii;
                if (r < 4064) {
                    const int b = r / 508, rem = r - b * 508, n = rem >> 2, g = rem & 3;
                    const float v = acc[ii], vn = __shfl_xor(v, 1);
                    if ((j & 1) == 0) *(unsigned*)(kvc + (size_t)kv * (8 * 128 * 512) + ((size_t)(b * 128 + n) * 4 + g) * 128 + j) = cvtpk(v, vn);
                }
            }
        }
        __syncthreads();
    }
    if (blockIdx.x == 0) {
        for (int i = tid; i < 2 * 8 * 512 / 2; i += NTHREADS) { const int kv = i >> 11, b = (i >> 8) & 7, c2 = i & 255;
            *(unsigned*)(kvc + (size_t)kv * (8 * 128 * 512) + ((size_t)(b * 128 + 127) * 512) + c2 * 2) = 0u; }
    }
}
__device__ __forceinline__ void phase_outproj(const Params& P, unsigned char* lds, size_t wsW, const float* xold, float* xnew, bf16_t* xb, unsigned char* xb8) {
    unsigned char* ws = P.ws;
    unsigned a0, a1, a2, a3; lin_offsets(threadIdx.x, DM * 2, a0, a1, a2, a3);
    for (int L = blockIdx.x; L < 64 * 8; L += gridDim.x) {
        int pm, pn; tile_order(L, 64, 8, pm, pn);
        EpiOut E{xold, xnew, xb, xb8, pm * 256, pn * 256};
        gemm256<true, false>(lds, (const char*)(ws + WS_OATT) + (size_t)pm * 256 * DM * 2, (const char*)(ws + wsW) + (size_t)pn * 256 * DM * 2, DM * 2, 256u, DM / 64, a0, a1, a2, a3, E);
    }
}
__device__ __forceinline__ void phase_kvq(const Params& P, unsigned char* lds) {
    unsigned char* ws = P.ws;
    unsigned a0, a1, a2, a3; lin_offsets(threadIdx.x, DM * 2, a0, a1, a2, a3);
    for (int L = blockIdx.x; L < 64 * 12; L += gridDim.x) {
        int pm, pn; tile_order(L, 64, 12, pm, pn);
        EpiKVQ E{(bf16_t*)(ws + WS_KV2), (bf16_t*)(ws + WS_Q), (const float*)(ws + WS_RSTD) + NTOK, pm * 256, pn};
        gemm256<true, false>(lds, (const char*)(ws + WS_XBA) + (size_t)pm * 256 * DM * 2, (const char*)(ws + WS_WKVQ) + (size_t)pn * 256 * DM * 2, DM * 2, 256u, DM / 64, a0, a1, a2, a3, E);
    }
    const int wave = threadIdx.x >> 6, lane = threadIdx.x & 63;
    for (int gw = blockIdx.x * 8 + wave; gw < 128; gw += gridDim.x * 8) {
        const int b = gw >> 4, h = gw & 15;
        const float* lf = (const float*)(ws + WS_LOGF) + ((size_t)b * SEQ + lane * 32) * 16 + h;
        float v[32]; float s = 0.f;
#pragma unroll
        for (int i = 0; i < 32; ++i) { s += lf[i * 16]; v[i] = s; }
        float incl = s;
#pragma unroll
        for (int o = 1; o < 64; o <<= 1) { const float t = __shfl_up(incl, o); if (lane >= o) incl += t; }
        const float excl = incl - s;
        float* c2 = (float*)(ws + WS_C2) + ((size_t)b * 16 + h) * SEQ + lane * 32;
#pragma unroll
        for (int i = 0; i < 32; ++i) c2[i] = (excl + v[i]) * LOG2E;
    }
}
__device__ __forceinline__ void moe_table(const unsigned* gcnt, int* tl  ) {
    if (threadIdx.x == 0) { int s = 0; for (int e = 0; e < 32; ++e) { const int c = (int)__hip_atomic_load(gcnt + e * 64, __ATOMIC_RELAXED, __HIP_MEMORY_SCOPE_AGENT); tl[40 + e] = c; tl[e] = s; s += (c + 255) >> 8; } tl[32] = s; }
    __syncthreads();
}
template <bool FP8>
__device__ __forceinline__ void phase_moe_gu(const Params& P, unsigned char* lds, int layer) {
    unsigned char* ws = P.ws;
    int* tl = (int*)(lds + 131072);
    moe_table((const unsigned*)(ws + WS_CTL) + CW_CNT + layer * 32 * 64, tl);
    const int ntiles = tl[32];
    int R0, C; stage_rc(threadIdx.x * 16, R0, C);
    const float* rstd = (const float*)(ws + WS_RSTD) + (layer ? 2 * NTOK : 0);
    constexpr unsigned EB = FP8 ? 1u : 2u;
    const char* xb = FP8 ? (const char*)(ws + WS_XB8) : (const char*)(ws + WS_XBB);
    for (int u = blockIdx.x; u < ntiles * 8; u += gridDim.x) {
        const int ti = u >> 3, pn = u & 7;
        int e = 0;
        for (int q = 1; q < 32; ++q) if (tl[q] <= ti) e = q;
        e = __builtin_amdgcn_readfirstlane(e);
        const int mt = __builtin_amdgcn_readfirstlane(ti - tl[e]), nvalid = __builtin_amdgcn_readfirstlane(min(256, tl[40 + e] - mt * 256));
        const int* list = (const int*)(ws + WS_LIST) + ((size_t)(layer * 32 + e) * LISTCAP + mt * 256);
        unsigned ao[4];
#pragma unroll
        for (int q = 0; q < 4; ++q) { const int lr = R0 + 64 * q; const int tok = (lr < nvalid) ? (list[lr] >> 1) : 0; ao[q] = (unsigned)tok * (DM * EB) + C * 2; }
        EpiGU<FP8> E{(void*)(ws + WS_H), list, rstd, ti * 256, pn, nvalid};
        gemm256<true, FP8>(lds, xb, (const char*)(ws + WS_GU) + (size_t)layer * 32 * 2048 * 2048 * 2 + ((size_t)e * 2048 + pn * 256) * DM * EB, DM * EB, 256u, DM * EB / 128, ao[0], ao[1], ao[2], ao[3], E);
    }
}
template <bool FP8>
__device__ __forceinline__ void phase_moe_dn(const Params& P, unsigned char* lds, int layer) {
    unsigned char* ws = P.ws;
    int* tl = (int*)(lds + 131072);
    moe_table((const unsigned*)(ws + WS_CTL) + CW_CNT + layer * 32 * 64, tl);
    const int ntiles = tl[32];
    constexpr unsigned EB = FP8 ? 1u : 2u;
    unsigned a0, a1, a2, a3; lin_offsets(threadIdx.x, DEXP * EB, a0, a1, a2, a3);
    for (int u = blockIdx.x; u < ntiles * 8; u += gridDim.x) {
        const int ti = u >> 3, pn = u & 7;
        int e = 0;
        for (int q = 1; q < 32; ++q) if (tl[q] <= ti) e = q;
        e = __builtin_amdgcn_readfirstlane(e);
        const int mt = __builtin_amdgcn_readfirstlane(ti - tl[e]), nvalid = __builtin_amdgcn_readfirstlane(min(256, tl[40 + e] - mt * 256));
        const int* list = (const int*)(ws + WS_LIST) + ((size_t)(layer * 32 + e) * LISTCAP + mt * 256);
        EpiDN E{(bf16_t*)(ws + WS_Y), list, pn, nvalid, FP8 ? W8_INV : 1.f};
        gemm256<true, FP8>(lds, (const char*)(ws + WS_H) + (size_t)ti * 256 * DEXP * EB, (const char*)(ws + WS_DN) + (size_t)layer * 32 * 2048 * 1024 * 2 + ((size_t)e * 2048 + pn * 256) * DEXP * EB,
                           DEXP * EB, 256u, DEXP * EB / 128, a0, a1, a2, a3, E);
    }
}


constexpr int AT_V = 0, AT_K = 32768, AT_KB = 65536, AT_WS = 67584, AT_IMP = 69632, AT_VALS = 136192, AT_SEL = 144640;
#define KSWZ(row, colB) ((row) * 256 + ((colB) ^ (((row) & 7) << 4)))
__device__ __forceinline__ int v_st(int k, int c) { const int kk = (k & ~0xC) | ((k & 4) << 1) | ((k & 8) >> 1); return ((kk >> 3) * 4 + (c >> 5)) * 512 + ((kk & 7) * 32 + (c & 31)) * 2; }
__device__ __forceinline__ int v_rd_base(int lane) { return ((lane & 3) << 3) | (((lane >> 2) & 3) << 6) | (((lane >> 4) & 1) << 5) | (((lane >> 5) & 1) << 8); }
constexpr int v_rd_off(int d0, int ks, int half) { return d0 * 512 + ks * 4096 + half * 2048; }
__device__ __forceinline__ int crow(int r, int hi) { return (r & 3) + 8 * (r >> 2) + 4 * hi; }

template <int KB>
__device__ __forceinline__ void attn_qkt(f32x16& p0, f32x16& p1, const char* K_lds, int r32, int hi, const bf16x8 (&qr)[8]) {
    p0 = f32x16{}; p1 = f32x16{};
    const char* kb[4];
#pragma unroll
    for (int dd = 0; dd < 4; ++dd) kb[dd] = K_lds + KB * 16384 + KSWZ(r32, (dd * 16 + hi * 8) * 2);
#pragma unroll
    for (int d0 = 0; d0 < 8; ++d0) { const char* a = kb[d0 & 3] + (d0 >> 2) * 128;
        bf16x8 b0 = *reinterpret_cast<const bf16x8*>(a);
        bf16x8 b1 = *reinterpret_cast<const bf16x8*>(a + 32 * 256);
        p0 = __builtin_amdgcn_mfma_f32_32x32x16_bf16(b0, qr[d0], p0, 0, 0, 0);
        p1 = __builtin_amdgcn_mfma_f32_32x32x16_bf16(b1, qr[d0], p1, 0, 0, 0); }
}
template <int VB>
__device__ __forceinline__ void attn_pv(f32x16 (&o)[4], int vb0, bf16x8 pa0, bf16x8 pa1, bf16x8 pa2, bf16x8 pa3) {
#define TRRD(dst, off) asm volatile("ds_read_b64_tr_b16 %0, %1 offset:%2" : "=&v"(dst) : "v"(vb0), "i"(off) : "memory")
#define PV_D0(d0) do { s16x4 l0, l1, l2, l3, h0, h1, h2, h3; constexpr int b_ = VB * 16384 + v_rd_off(d0, 0, 0); \
        TRRD(l0, b_); TRRD(h0, b_ + 2048); TRRD(l1, b_ + 4096); TRRD(h1, b_ + 6144); TRRD(l2, b_ + 8192); TRRD(h2, b_ + 10240); TRRD(l3, b_ + 12288); TRRD(h3, b_ + 14336); \
        asm volatile("s_waitcnt lgkmcnt(0)" ::: "memory"); __builtin_amdgcn_sched_barrier(0); \
        o[d0] = __builtin_amdgcn_mfma_f32_32x32x16_bf16(pa0, (bf16x8){l0[0], l0[1], l0[2], l0[3], h0[0], h0[1], h0[2], h0[3]}, o[d0], 0, 0, 0); \
        o[d0] = __builtin_amdgcn_mfma_f32_32x32x16_bf16(pa1, (bf16x8){l1[0], l1[1], l1[2], l1[3], h1[0], h1[1], h1[2], h1[3]}, o[d0], 0, 0, 0); \
        o[d0] = __builtin_amdgcn_mfma_f32_32x32x16_bf16(pa2, (bf16x8){l2[0], l2[1], l2[2], l2[3], h2[0], h2[1], h2[2], h2[3]}, o[d0], 0, 0, 0); \
        o[d0] = __builtin_amdgcn_mfma_f32_32x32x16_bf16(pa3, (bf16x8){l3[0], l3[1], l3[2], l3[3], h3[0], h3[1], h3[2], h3[3]}, o[d0], 0, 0, 0); } while (0)
    PV_D0(0); PV_D0(1); PV_D0(2); PV_D0(3);
#undef PV_D0
#undef TRRD
}
#define PK4(P, B_, OUT) do { unsigned a0 = cvtpk(P[B_+0], P[B_+1]), a1 = cvtpk(P[B_+2], P[B_+3]); \
        unsigned b0 = cvtpk(P[B_+4], P[B_+5]), b1 = cvtpk(P[B_+6], P[B_+7]); \
        auto r0 = __builtin_amdgcn_permlane32_swap(a0, b0, false, false); auto r1 = __builtin_amdgcn_permlane32_swap(a1, b1, false, false); \
        u32x4 w = {r0[0], r1[0], r0[1], r1[1]}; OUT = *reinterpret_cast<bf16x8*>(&w); } while (0)
__device__ __forceinline__ float row_max2(float v) { auto rr = __builtin_amdgcn_permlane32_swap(__float_as_uint(v), __float_as_uint(v), false, false); return fmaxf(__uint_as_float(rr[0]), __uint_as_float(rr[1])); }
__device__ __forceinline__ float row_sum2(float v) { auto rr = __builtin_amdgcn_permlane32_swap(__float_as_uint(v), __float_as_uint(v), false, false); return __uint_as_float(rr[0]) + __uint_as_float(rr[1]); }

struct KVAddr { unsigned ldsw, ldsb, voffK, voffV, ldb; };
__device__ __forceinline__ KVAddr kv_addr(const char* lds, int tid, int wave, unsigned ldb) {
    KVAddr A; A.ldsb = lds_addr(lds); A.ldsw = A.ldsb + (unsigned)wave * 1024u; A.ldb = ldb;
    const int row = tid >> 4, cp = tid & 15;
    A.voffK = (unsigned)row * ldb + (unsigned)((cp ^ (row & 7)) * 16);
    const int k = ((tid >> 2) & 3) | (((tid >> 7) & 1) << 2) | (((tid >> 4) & 1) << 3) | (((tid >> 8) & 1) << 4);
    const int c = ((tid >> 5) & 3) * 32 + (tid & 3) * 8;
    A.voffV = (unsigned)k * ldb + (unsigned)c * 2u;
    return A;
}
template <int BUF>
__device__ __forceinline__ void kv_issue(const KVAddr& A, const bf16_t* Kp, const bf16_t* Vp, int key0, const float* ctab, int wave, int lane) {
    const char* kb = (const char*)Kp + (size_t)key0 * A.ldb; const char* vb = (const char*)Vp + (size_t)key0 * A.ldb;
    glds16(A.voffK, kb, A.ldsw + AT_K + BUF * 16384); glds16(A.voffK, kb + (size_t)32 * A.ldb, A.ldsw + AT_K + BUF * 16384 + 8192);
    glds16(A.voffV, vb, A.ldsw + AT_V + BUF * 16384); glds16(A.voffV, vb + (size_t)32 * A.ldb, A.ldsw + AT_V + BUF * 16384 + 8192);
    if (ctab != nullptr && wave < 4) glds4((unsigned)lane * 4u, ctab + (size_t)wave * SEQ + key0, A.ldsb + AT_KB + BUF * 1024 + (unsigned)wave * 256u);
}
template <int BUF>
__device__ __forceinline__ void kb_alibi(char* lds, int tid, float sl2_t, int key0) {
    if (tid < 256) ((float*)(lds + AT_KB))[BUF * 256 + tid] = -sl2_t * (float)(key0 + (tid & 63));
}
template <int BUF>
__device__ __forceinline__ void attn_tile(char* lds, const bf16x8 (&qr)[8], f32x16 (&o)[4], float& m_reg, float& l_reg, float rb, int dq, unsigned W,
                                          bool needmask, int wave, int r32, int hi, int vb0) {
    f32x16 p0, p1;
    attn_qkt<BUF>(p0, p1, lds + AT_K, r32, hi, qr);
    const float NEG = -__builtin_inff();
    {
        const float* kbp = (const float*)(lds + AT_KB) + BUF * 256 + (wave & 3) * 64 + 4 * hi;
#pragma unroll
        for (int g2 = 0; g2 < 4; ++g2) {
            const f32x4 ka = *(const f32x4*)(kbp + 8 * g2), kc = *(const f32x4*)(kbp + 32 + 8 * g2);
#pragma unroll
            for (int i = 0; i < 4; ++i) { p0[4 * g2 + i] = fmaf(p0[4 * g2 + i], LOG2E, rb - ka[i]); p1[4 * g2 + i] = fmaf(p1[4 * g2 + i], LOG2E, rb - kc[i]); }
        }
    }
    if (needmask) {
#pragma unroll
        for (int r = 0; r < 16; ++r) { const int c = (r & 3) + 8 * (r >> 2);
            if ((unsigned)(dq - c) >= W) p0[r] = NEG;
            if ((unsigned)(dq - c - 32) >= W) p1[r] = NEG; }
    }
    float pmax = p0[0];
#pragma unroll
    for (int r = 1; r < 16; ++r) pmax = fmaxf(pmax, p0[r]);
#pragma unroll
    for (int r = 0; r < 16; ++r) pmax = fmaxf(pmax, p1[r]);
    pmax = row_max2(pmax);
    const float mn = fmaxf(m_reg, pmax), alpha = fast_exp2(m_reg - mn);
    m_reg = mn;
    float ps = 0.f;
#pragma unroll
    for (int r = 0; r < 16; ++r) { p0[r] = fast_exp2(p0[r] - mn); ps += p0[r]; }
#pragma unroll
    for (int r = 0; r < 16; ++r) { p1[r] = fast_exp2(p1[r] - mn); ps += p1[r]; }
    ps = row_sum2(ps);
    l_reg = l_reg * alpha + ps;
    if (__any(alpha < 1.f)) {
        float* al = (float*)(lds + AT_WS) + wave * 64;
        if (hi == 0) al[r32] = alpha;
        asm volatile("s_waitcnt lgkmcnt(0)" ::: "memory");
#pragma unroll
        for (int g2 = 0; g2 < 4; ++g2) { const f32x4 a4 = *(const f32x4*)(al + 8 * g2 + 4 * hi);
#pragma unroll
            for (int d0 = 0; d0 < 4; ++d0)
#pragma unroll
                for (int i = 0; i < 4; ++i) o[d0][4 * g2 + i] *= a4[i]; }
    }
    bf16x8 pa0, pa1, pa2, pa3;
    PK4(p0, 0, pa0); PK4(p0, 8, pa1); PK4(p1, 0, pa2); PK4(p1, 8, pa3);
    attn_pv<BUF>(o, vb0, pa0, pa1, pa2, pa3);
}
template <bool SELB>
__device__ __forceinline__ void attn_branch(char* lds, const KVAddr& A, const bf16x8 (&qr)[8], f32x16 (&o)[4], float& m_reg, float& l_reg, unsigned tilemask,
                                            const bf16_t* Kp, const bf16_t* Vp, const float* ctab, float sl2_t, float rowb, unsigned selw,
                                            int tq, int tq0w, unsigned W, int wave, int lane, int r32, int hi, int vb0) {
    const int tid = wave * 64 + lane;
    unsigned tm = tilemask;
    int j = 31 - __builtin_clz(tm); tm &= ~(1u << j);
    kv_issue<0>(A, Kp, Vp, j * 64, ctab, wave, lane);
    if (ctab == nullptr) kb_alibi<0>(lds, tid, sl2_t, j * 64);
    const float NEG = -__builtin_inff();
#define ATT_STEP(BUF, NBUF) { \
        asm volatile("s_waitcnt vmcnt(0)" ::: "memory"); \
        __syncthreads(); \
        int jn = -1; if (tm) { jn = 31 - __builtin_clz(tm); tm &= ~(1u << jn); kv_issue<NBUF>(A, Kp, Vp, jn * 64, ctab, wave, lane); if (ctab == nullptr) kb_alibi<NBUF>(lds, tid, sl2_t, jn * 64); } \
        { const int key0 = j * 64; \
          const bool rsel = SELB ? (((selw >> j) & 1u) != 0u) : true; \
          bool active = (key0 <= tq0w + 31) && ((tq0w - key0 - 63) < (int)W); \
          if (SELB) active = active && __any(rsel); \
          if (active) { \
              const bool needmask = (key0 + 63 > tq0w) || ((unsigned)(tq0w + 31 - key0) >= W); \
              attn_tile<BUF>(lds, qr, o, m_reg, l_reg, rsel ? rowb : NEG, tq - key0 - 4 * hi, W, needmask, wave, r32, hi, vb0); } } \
        if (jn < 0) break; \
        j = jn; }
    for (;;) { ATT_STEP(0, 1) ATT_STEP(1, 0) }
#undef ATT_STEP
    __syncthreads();
}
template <bool ADD>
__device__ __forceinline__ void attn_store(bf16_t* Obase  , const f32x16 (&o)[4], char* lds, float srow, int wave, int r32, int hi) {
    float* sc = (float*)(lds + AT_WS) + wave * 64 + 32;
    if (hi == 0) sc[r32] = srow;
    asm volatile("s_waitcnt lgkmcnt(0)" ::: "memory");
#pragma unroll
    for (int g2 = 0; g2 < 4; ++g2) { const f32x4 s4 = *(const f32x4*)(sc + 8 * g2 + 4 * hi);
#pragma unroll
        for (int i = 0; i < 4; ++i) { const int r = 4 * g2 + i; const int orow = crow(r, hi);
#pragma unroll
            for (int d0 = 0; d0 < 4; ++d0) {
                float v = o[d0][r] * s4[i];
                float vn = __shfl_xor(v, 1);
                if ((r32 & 1) == 0) { unsigned* p = (unsigned*)(Obase + (size_t)orow * DM + d0 * 32 + r32);
                    if (ADD) { const unsigned old = *p; v += bflo(old); vn += bfhi(old); }
                    *p = cvtpk(v, vn); } } } }
}

__device__ __forceinline__ void nsa_unit(const Params& P, char* lds, int b, int g, int qt) {
    unsigned char* ws = P.ws;
    int tid = threadIdx.x; asm volatile("" : "+v"(tid));
    const int wave = __builtin_amdgcn_readfirstlane(tid >> 6), lane = tid & 63, r32 = lane & 31, hi = lane >> 5;
    const int head = wave & 3, h = g * 4 + head, tq0w = qt * 64 + (wave >> 2) * 32, tq = tq0w + r32;
    const int vb0 = (int)lds_addr(lds + AT_V) + v_rd_base(lane);
    const bf16_t* Qg = (const bf16_t*)(ws + WS_Q); const bf16_t* KV6 = (const bf16_t*)(ws + WS_KV6);
    const size_t tokrow = (size_t)b * SEQ + tq;
    bf16x8 qr[8];
#pragma unroll
    for (int d0 = 0; d0 < 8; ++d0) qr[d0] = *(const bf16x8*)(Qg + tokrow * DM + h * 128 + d0 * 16 + hi * 8);
    const float* gp = (const float*)(ws + WS_GATES) + tokrow * 48 + h * 3;
    const float sl2 = fast_exp2(-0.5f * (float)(h + 1)) * LOG2E;
    const float sl2_t = fast_exp2(-0.5f * (float)(g * 4 + ((tid >> 6) & 3) + 1)) * LOG2E;
    const float rowb = -sl2 * (float)tq;
    const float NEG = -__builtin_inff();
    bf16_t* Ob = (bf16_t*)(ws + WS_OATT) + ((size_t)b * SEQ + tq0w) * DM + h * 128;
    f32x16 o[4];
    {
        const KVAddr A = kv_addr(lds, tid, wave, 512 * 2);
        const bf16_t* Kc = (const bf16_t*)(ws + WS_KVCMP) + (size_t)b * 128 * 512 + g * 128;
        const bf16_t* Vc = Kc + (size_t)8 * 128 * 512;
        kv_issue<0>(A, Kc, Vc, 0, nullptr, wave, lane);
        kv_issue<1>(A, Kc, Vc, 64, nullptr, wave, lane);
        asm volatile("s_waitcnt vmcnt(0)" ::: "memory");
        __syncthreads();
        f32x16 p0, p1, p2, p3;
        attn_qkt<0>(p0, p1, lds + AT_K, r32, hi, qr);
        attn_qkt<1>(p2, p3, lds + AT_K, r32, hi, qr);
        const int lim = tq - 64 * hi; const float sb = -sl2 * (float)lim;
        float pmax = NEG;
#define CMP_BIAS(PX, N0) _Pragma("unroll") for (int r = 0; r < 16; ++r) { const int kc_ = 16 * ((N0) + (r & 3) + 8 * (r >> 2)) + 31; \
            const float v = fmaf(PX[r], LOG2E, fmaf(sl2, (float)kc_, sb)); PX[r] = (kc_ <= lim) ? v : NEG; pmax = fmaxf(pmax, PX[r]); }
        CMP_BIAS(p0, 0) CMP_BIAS(p1, 32) CMP_BIAS(p2, 64) CMP_BIAS(p3, 96)
#undef CMP_BIAS
        pmax = row_max2(pmax);
        const float mn = fmaxf(pmax, -1e30f);
        float ps = 0.f;
#pragma unroll
        for (int r = 0; r < 16; ++r) { p0[r] = fast_exp2(p0[r] - mn); p1[r] = fast_exp2(p1[r] - mn); p2[r] = fast_exp2(p2[r] - mn); p3[r] = fast_exp2(p3[r] - mn); ps += (p0[r] + p1[r]) + (p2[r] + p3[r]); }
        ps = row_sum2(ps);
        const float invl = ps > 0.f ? 1.f / ps : 0.f;
        {
            float* ia = (float*)(lds + AT_IMP) + (head * 64 + (wave >> 2) * 32 + r32) * 65;
#define IMP_W(PX, J0) _Pragma("unroll") for (int g2 = 0; g2 < 4; ++g2) { const int jj = (J0) + 2 * g2 + hi; const float hb = 0.5f * PX[4 * g2 + 3] * invl; \
            ia[jj] = (PX[4 * g2] + PX[4 * g2 + 1] + PX[4 * g2 + 2]) * invl + hb; ia[32 + jj + 1] = hb; }
            IMP_W(p0, 0) IMP_W(p1, 8) IMP_W(p2, 16) IMP_W(p3, 24)
#undef IMP_W
            if (hi == 0) ia[32] = 0.f;
        }
#pragma unroll
        for (int d0 = 0; d0 < 4; ++d0) o[d0] = f32x16{};
        bf16x8 pa0, pa1, pa2, pa3;
        PK4(p0, 0, pa0); PK4(p0, 8, pa1); PK4(p1, 0, pa2); PK4(p1, 8, pa3);
        attn_pv<0>(o, vb0, pa0, pa1, pa2, pa3);
        PK4(p2, 0, pa0); PK4(p2, 8, pa1); PK4(p3, 0, pa2); PK4(p3, 8, pa3);
        attn_pv<1>(o, vb0, pa0, pa1, pa2, pa3);
        attn_store<false>(Ob, o, lds, gp[0] * invl, wave, r32, hi);
    }
    __syncthreads();
    {
        const float* ia = (const float*)(lds + AT_IMP);
        float* vals = (float*)(lds + AT_VALS);
        unsigned* selm = (unsigned*)(lds + AT_SEL);
        const int jb = tid & 31;
        float myv[4];
#pragma unroll
        for (int pass = 0; pass < 4; ++pass) {
            const int tokl = (tid >> 5) + 16 * pass;
            float v = 0.f;
#pragma unroll
            for (int hh = 0; hh < 4; ++hh) { const float* q = ia + (hh * 64 + tokl) * 65; v += q[jb] + q[32 + jb]; }
            const bool forced = (jb == 0) || (jb == qt) || (jb == qt - 1);
            v = (jb > qt) ? NEG : (forced ? __builtin_inff() : v);
            vals[tokl * 33 + jb] = v; myv[pass] = v;
        }
        __syncthreads();
#pragma unroll
        for (int pass = 0; pass < 4; ++pass) {
            const int tokl = (tid >> 5) + 16 * pass;
            const float v = myv[pass]; int rank = 0;
#pragma unroll 8
            for (int i = 0; i < 32; ++i) { const float vi = vals[tokl * 33 + i]; rank += (vi > v || (vi == v && i < jb)) ? 1 : 0; }
            const unsigned long long bal = __ballot(rank < 16);
            if ((lane & 31) == 0) selm[tokl] = (lane < 32) ? (unsigned)bal : (unsigned)(bal >> 32);
        }
        __syncthreads();
        if (tid < 64) { unsigned mk = selm[tid];
#pragma unroll
            for (int of = 32; of >= 1; of >>= 1) mk |= __shfl_xor(mk, of);
            if (tid == 0) selm[64] = mk; }
        __syncthreads();
    }
    const unsigned causal_bits = (qt >= 31) ? 0xffffffffu : ((2u << qt) - 1u);
    const unsigned selw = ((const unsigned*)(lds + AT_SEL))[(wave >> 2) * 32 + r32];
    const unsigned um = ((const unsigned*)(lds + AT_SEL))[64] & causal_bits;
    const KVAddr A = kv_addr(lds, tid, wave, KV6_W * 2);
    {
#pragma unroll
        for (int d0 = 0; d0 < 4; ++d0) o[d0] = f32x16{};
        float m_reg = -1e30f, l_reg = 0.f;
        const bf16_t* Kp = KV6 + (size_t)b * SEQ * KV6_W + 2 * 512 + g * 128;
        attn_branch<true>(lds, A, qr, o, m_reg, l_reg, um, Kp, Kp + 512, nullptr, sl2_t, rowb, selw, tq, tq0w, 1u << 30, wave, lane, r32, hi, vb0);
        attn_store<true>(Ob, o, lds, l_reg > 0.f ? gp[1] / l_reg : 0.f, wave, r32, hi);
    }
    {
#pragma unroll
        for (int d0 = 0; d0 < 4; ++d0) o[d0] = f32x16{};
        float m_reg = -1e30f, l_reg = 0.f;
        const bf16_t* Kp = KV6 + (size_t)b * SEQ * KV6_W + 4 * 512 + g * 128;
        const unsigned wmask = causal_bits & ~((qt > 8) ? ((1u << (qt - 8)) - 1u) : 0u);
        attn_branch<false>(lds, A, qr, o, m_reg, l_reg, wmask, Kp, Kp + 512, nullptr, sl2_t, rowb, 0u, tq, tq0w, 512u, wave, lane, r32, hi, vb0);
        attn_store<true>(Ob, o, lds, l_reg > 0.f ? gp[2] / l_reg : 0.f, wave, r32, hi);
    }
}
__device__ __forceinline__ void fox_unit(const Params& P, char* lds, int b, int kvh, int qt) {
    unsigned char* ws = P.ws;
    int tid = threadIdx.x; asm volatile("" : "+v"(tid));
    const int wave = __builtin_amdgcn_readfirstlane(tid >> 6), lane = tid & 63, r32 = lane & 31, hi = lane >> 5;
    const int head = wave & 3, h = kvh * 4 + head, tq0w = qt * 64 + (wave >> 2) * 32, tq = tq0w + r32;
    const int vb0 = (int)lds_addr(lds + AT_V) + v_rd_base(lane);
    const bf16_t* Qg = (const bf16_t*)(ws + WS_Q);
    const size_t tokrow = (size_t)b * SEQ + tq;
    bf16x8 qr[8];
#pragma unroll
    for (int d0 = 0; d0 < 8; ++d0) qr[d0] = *(const bf16x8*)(Qg + tokrow * DM + h * 128 + d0 * 16 + hi * 8);
    const float* ctab = (const float*)(ws + WS_C2) + ((size_t)b * 16 + kvh * 4) * SEQ;
    const float rowb = ctab[head * SEQ + tq];
    f32x16 o[4];
#pragma unroll
    for (int d0 = 0; d0 < 4; ++d0) o[d0] = f32x16{};
    float m_reg = -1e30f, l_reg = 0.f;
    const bf16_t* Kp = (const bf16_t*)(ws + WS_KV2) + (size_t)b * SEQ * 1024 + kvh * 128;
    const unsigned causal_bits = (qt >= 31) ? 0xffffffffu : ((2u << qt) - 1u);
    const KVAddr A = kv_addr(lds, tid, wave, 1024 * 2);
    attn_branch<false>(lds, A, qr, o, m_reg, l_reg, causal_bits, Kp, Kp + 512, ctab, 0.f, rowb, 0u, tq, tq0w, 1u << 30, wave, lane, r32, hi, vb0);
    bf16_t* Ob = (bf16_t*)(ws + WS_OATT) + ((size_t)b * SEQ + tq0w) * DM + h * 128;
    attn_store<false>(Ob, o, lds, l_reg > 0.f ? 1.f / l_reg : 0.f, wave, r32, hi);
}
__device__ __forceinline__ void attn_unit_decode(int u, int& b, int& g, int& qt) {
    const int rnd = u >> 8, c = u & 255, k = c >> 5, j = c & 31;
    b = j >> 2; g = j & 3;
    qt = (rnd == 0) ? 31 - k : (rnd == 1) ? 16 + k : (rnd == 2) ? 15 - k : k;
}

__device__ __forceinline__ void rowgemm64(const float* X, int row0, const float* W, float* part, float* ssp) {
    const int tid = threadIdx.x, wave = tid >> 6, lane = tid & 63, m = lane & 31, jh = lane >> 5;
    const int rgrp = wave & 1, kq = wave >> 1;
    const float* xr = X + (size_t)(row0 + rgrp * 32 + m) * DM + kq * 512 + 4 * jh;
    const float* wp = W + (size_t)(kq * 512 + 4 * jh) * 32 + m;
    f32x16 acc = {};
    float ss = 0.f;
#pragma unroll 4
    for (int i = 0; i < 64; ++i) {
        const f32x4 xv = *(const f32x4*)(xr + 8 * i);
        const float w0 = wp[(8 * i + 0) * 32], w1 = wp[(8 * i + 1) * 32], w2 = wp[(8 * i + 2) * 32], w3 = wp[(8 * i + 3) * 32];
        acc = __builtin_amdgcn_mfma_f32_32x32x2f32(xv[0], w0, acc, 0, 0, 0);
        acc = __builtin_amdgcn_mfma_f32_32x32x2f32(xv[1], w1, acc, 0, 0, 0);
        acc = __builtin_amdgcn_mfma_f32_32x32x2f32(xv[2], w2, acc, 0, 0, 0);
        acc = __builtin_amdgcn_mfma_f32_32x32x2f32(xv[3], w3, acc, 0, 0, 0);
        ss += xv[0] * xv[0] + xv[1] * xv[1] + xv[2] * xv[2] + xv[3] * xv[3];
    }
    float* pw = part + wave * (32 * 33);
#pragma unroll
    for (int r = 0; r < 16; ++r) pw[crow(r, jh) * 33 + m] = acc[r];
    ss += __shfl_xor(ss, 32);
    if (jh == 0) ssp[wave * 32 + m] = ss;
}
__device__ __forceinline__ void phase_router(const Params& P, unsigned char* lds, int layer) {
    unsigned char* ws = P.ws;
    const int tid = threadIdx.x;
    float* part = (float*)lds;
    float* ssp = (float*)(lds + 34816);
    float* lg = (float*)(lds + 36864);
    float* sl = (float*)(lds + 36864 + 8448);
    int* lcnt = (int*)(lds + 36864 + 2 * 8448);
    int* asg = lcnt + 64;
    const float* X = (const float*)(ws + WS_X1);
    const float* W = (const float*)(ws + WS_RW) + (size_t)layer * 2048 * 32;
    float* rstd_out = (float*)(ws + WS_RSTD) + (layer ? 2 * NTOK : 0);
    float* ew = (float*)(ws + WS_EW) + (size_t)layer * NTOK * 2;
    unsigned* gcnt = (unsigned*)(ws + WS_CTL) + CW_CNT + layer * 32 * 64;
    int* lists = (int*)(ws + WS_LIST) + (size_t)layer * 32 * LISTCAP;
    for (int rg = blockIdx.x; rg < NTOK / 64; rg += gridDim.x) {
        const int row0 = rg * 64;
        if (tid < 32) lcnt[tid] = 0;
        rowgemm64(X, row0, W, part, ssp);
        __syncthreads();
        if (tid < 64) {
            const int rgrp = tid >> 5, mloc = tid & 31;
            float ss = 0.f;
#pragma unroll
            for (int kq = 0; kq < 4; ++kq) ss += ssp[(kq * 2 + rgrp) * 32 + mloc];
            const float rstd = rsqrtf(ss * (1.f / DM) + RMS_EPS);
            rstd_out[row0 + tid] = rstd;
            float mx = -__builtin_inff();
            for (int e = 0; e < 32; ++e) {
                float d = 0.f;
#pragma unroll
                for (int kq = 0; kq < 4; ++kq) d += part[(kq * 2 + rgrp) * (32 * 33) + mloc * 33 + e];
                d *= rstd; lg[tid * 33 + e] = d; mx = fmaxf(mx, d);
            }
            float sum = 0.f;
            for (int e = 0; e < 32; ++e) { const float p = __expf(lg[tid * 33 + e] - mx); lg[tid * 33 + e] = p; sum += p; }
            const float inv = 1.f / sum;
            for (int e = 0; e < 32; ++e) { const float p = lg[tid * 33 + e] * inv; lg[tid * 33 + e] = p; sl[tid * 33 + e] = p + P.in[17][e]; }
            int bestg = 0; float bests = -__builtin_inff();
            for (int gq = 0; gq < 4; ++gq) {
                float t1 = -__builtin_inff(), t2 = -__builtin_inff();
                for (int i = 0; i < 8; ++i) { const float v = sl[tid * 33 + gq * 8 + i]; if (v > t1) { t2 = t1; t1 = v; } else if (v > t2) t2 = v; }
                const float sc = t1 + t2;
                if (sc > bests) { bests = sc; bestg = gq; }
            }
            int i1 = 0, i2 = 0; float v1 = -__builtin_inff(), v2 = -__builtin_inff();
            for (int i = 0; i < 8; ++i) { const float v = sl[tid * 33 + bestg * 8 + i]; if (v > v1) { v2 = v1; i2 = i1; v1 = v; i1 = i; } else if (v > v2) { v2 = v; i2 = i; } }
            const int e1 = bestg * 8 + i1, e2 = bestg * 8 + i2;
            const float p1 = lg[tid * 33 + e1], p2 = lg[tid * 33 + e2], ip = 1.f / (p1 + p2);
            ew[(size_t)(row0 + tid) * 2 + 0] = p1 * ip; ew[(size_t)(row0 + tid) * 2 + 1] = p2 * ip;
            asg[tid * 2 + 0] = e1; asg[tid * 2 + 1] = e2;
            asg[128 + tid * 2 + 0] = atomicAdd(&lcnt[e1], 1); asg[128 + tid * 2 + 1] = atomicAdd(&lcnt[e2], 1);
        }
        __syncthreads();
        if (tid < 32) { const int c = lcnt[tid]; lcnt[32 + tid] = c ? (int)__hip_atomic_fetch_add(gcnt + tid * 64, (unsigned)c, __ATOMIC_RELAXED, __HIP_MEMORY_SCOPE_AGENT) : 0; }
        __syncthreads();
        if (tid < 128) { const int e = asg[tid], pos = lcnt[32 + e] + asg[128 + tid]; if (pos < LISTCAP) lists[(size_t)e * LISTCAP + pos] = (row0 + (tid >> 1)) * 2 + (tid & 1); }
        __syncthreads();
    }
}
__device__ __forceinline__ void phase_combine0(const Params& P, unsigned char* lds) {
    unsigned char* ws = P.ws;
    const int tid = threadIdx.x, wave = tid >> 6, lane = tid & 63;
    float* part = (float*)lds; float* ssp = (float*)(lds + 34816); float* rs = (float*)(lds + 36864);
    const float* X1 = (const float*)(ws + WS_X1); float* X2 = (float*)(ws + WS_X2); bf16_t* XB = (bf16_t*)(ws + WS_XBA);
    const bf16_t* Y = (const bf16_t*)(ws + WS_Y); const float* ew = (const float*)(ws + WS_EW);
    float* rstd_out = (float*)(ws + WS_RSTD) + NTOK;
    for (int rg = blockIdx.x; rg < NTOK / 64; rg += gridDim.x) {
        const int row0 = rg * 64;
        for (int q = 0; q < 8; ++q) {
            const int row = row0 + wave * 8 + q;
            const float w0 = ew[(size_t)row * 2], w1 = ew[(size_t)row * 2 + 1];
            float ss = 0.f;
#pragma unroll
            for (int j = 0; j < 8; ++j) {
                const size_t off = (size_t)row * DM + j * 256 + lane * 4;
                f32x4 v = *(const f32x4*)(X1 + off);
                const u32x2 y0 = *(const u32x2*)(Y + (size_t)(2 * row) * DM + j * 256 + lane * 4), y1 = *(const u32x2*)(Y + (size_t)(2 * row + 1) * DM + j * 256 + lane * 4);
                v[0] += w0 * bflo(y0[0]) + w1 * bflo(y1[0]); v[1] += w0 * bfhi(y0[0]) + w1 * bfhi(y1[0]);
                v[2] += w0 * bflo(y0[1]) + w1 * bflo(y1[1]); v[3] += w0 * bfhi(y0[1]) + w1 * bfhi(y1[1]);
                *(f32x4*)(X2 + off) = v;
                u32x2 w = {cvtpk(v[0], v[1]), cvtpk(v[2], v[3])};
                *(u32x2*)(XB + off) = w;
                ss += v[0] * v[0] + v[1] * v[1] + v[2] * v[2] + v[3] * v[3];
            }
            ss = wave_sum(ss);
            const float rstd = rsqrtf(ss * (1.f / DM) + RMS_EPS);
            if (lane == 0) { rstd_out[row] = rstd; rs[wave * 8 + q] = rstd; }
        }
        asm volatile("s_waitcnt vmcnt(0)" ::: "memory");
        __syncthreads();
        rowgemm64(X2, row0, (const float*)(ws + WS_WF), part, ssp);
        __syncthreads();
        for (int i = tid; i < 64 * 16; i += NTHREADS) {
            const int r = i >> 4, j = i & 15, rgrp = r >> 5, mloc = r & 31;
            float d = 0.f;
#pragma unroll
            for (int kq = 0; kq < 4; ++kq) d += part[(kq * 2 + rgrp) * (32 * 33) + mloc * 33 + j];
            const float z = d * rs[r] + P.in[11][j];
            ((float*)(ws + WS_LOGF))[(size_t)(row0 + r) * 16 + j] = fminf(z, 0.f) - log1pf(__expf(-fabsf(z)));
        }
        __syncthreads();
    }
}
__device__ __forceinline__ void phase_final(const Params& P) {
    unsigned char* ws = P.ws;
    const int tid = threadIdx.x, wave = tid >> 6, lane = tid & 63;
    const float* X3 = (const float*)(ws + WS_X1); const bf16_t* Y = (const bf16_t*)(ws + WS_Y); const float* ew = (const float*)(ws + WS_EW) + (size_t)NTOK * 2;
    const float* gain = P.in[21];
    for (int row = blockIdx.x * 8 + wave; row < NTOK; row += gridDim.x * 8) {
        const float w0 = ew[(size_t)row * 2], w1 = ew[(size_t)row * 2 + 1];
        f32x4 v[8]; float ss = 0.f;
#pragma unroll
        for (int j = 0; j < 8; ++j) {
            const size_t off = (size_t)row * DM + j * 256 + lane * 4;
            v[j] = *(const f32x4*)(X3 + off);
            const u32x2 y0 = *(const u32x2*)(Y + (size_t)(2 * row) * DM + j * 256 + lane * 4), y1 = *(const u32x2*)(Y + (size_t)(2 * row + 1) * DM + j * 256 + lane * 4);
            v[j][0] += w0 * bflo(y0[0]) + w1 * bflo(y1[0]); v[j][1] += w0 * bfhi(y0[0]) + w1 * bfhi(y1[0]);
            v[j][2] += w0 * bflo(y0[1]) + w1 * bflo(y1[1]); v[j][3] += w0 * bfhi(y0[1]) + w1 * bfhi(y1[1]);
            ss += v[j][0] * v[j][0] + v[j][1] * v[j][1] + v[j][2] * v[j][2] + v[j][3] * v[j][3];
        }
        ss = wave_sum(ss);
        const float rstd = rsqrtf(ss * (1.f / DM) + RMS_EPS);
#pragma unroll
        for (int j = 0; j < 8; ++j) {
            const f32x4 gv = *(const f32x4*)(gain + j * 256 + lane * 4);
            *(f32x4*)(P.out + (size_t)row * DM + j * 256 + lane * 4) = v[j] * rstd * gv;
        }
    }
}

__global__ void __launch_bounds__(NTHREADS, 2) yoco_fwd(Params P) {
    extern __shared__ __attribute__((aligned(16))) unsigned char lds[];
    unsigned char* ws = P.ws;
    const int lo = P.ph_lo, hi = P.ph_hi;
    XcdBarrier bar; bar.bar = (unsigned*)(ws + WS_CTL) + CW_BAR; bar.x = 0; bar.st = nullptr;
    const bool one = (hi - lo) > 1;
    if (one) {
        if (threadIdx.x < 4) ((unsigned*)(lds + LDS_BYTES - 16))[threadIdx.x] = 0u;
        __syncthreads();
        bar = xcd_barrier_post((unsigned*)(ws + WS_CTL) + CW_BAR, (volatile LAS unsigned*)(lds + LDS_BYTES - 16));
    }
#ifdef ONLY_PHASE
#define IN(k) ((k) == ONLY_PHASE && lo <= (k) && (k) < hi)
#else
#define IN(k) (lo <= (k) && (k) < hi)
#endif
#define SEAM(k) do { if (IN(k) && IN((k) + 1)) xcd_barrier(bar); } while (0)
#ifndef REP_MASK
#define REP_MASK 0
#endif
#define RUN(k, ...) do { if (IN(k)) { __VA_ARGS__; if ((REP_MASK >> (k)) & 1) { xcd_barrier(bar); __VA_ARGS__; } } SEAM(k); } while (0)
    RUN(0, { phase_convert(P, lds, 0, NJOBS); phase0_misc(P, lds); });
    RUN(1, phase_proj0(P, lds));
    RUN(2, phase_cmp1(P, lds));
    RUN(3, phase_cmp2(P, lds));
    RUN(4, { for (int u = blockIdx.x; u < 1024; u += gridDim.x) { int b, g, qt; attn_unit_decode(u, b, g, qt); nsa_unit(P, (char*)lds, b, g, qt); } });
    RUN(5, phase_outproj(P, lds, WS_WOUT, P.in[0], (float*)(ws + WS_X1), (bf16_t*)(ws + WS_XBB), kFp8[0] ? (unsigned char*)(ws + WS_XB8) : nullptr));
    RUN(6, phase_router(P, lds, 0));
    RUN(7, phase_moe_gu<kFp8[0]>(P, lds, 0));
    RUN(8, phase_moe_dn<kFp8[0]>(P, lds, 0));
    RUN(9, phase_combine0(P, lds));
    RUN(10, phase_kvq(P, lds));
    RUN(11, { for (int u = blockIdx.x; u < 1024; u += gridDim.x) { int b, g, qt; attn_unit_decode(u, b, g, qt); fox_unit(P, (char*)lds, b, g, qt); } });
    RUN(12, phase_outproj(P, lds, WS_WFO, (const float*)(ws + WS_X2), (float*)(ws + WS_X1), (bf16_t*)(ws + WS_XBB), kFp8[1] ? (unsigned char*)(ws + WS_XB8) : nullptr));
    RUN(13, phase_router(P, lds, 1));
    RUN(14, phase_moe_gu<kFp8[1]>(P, lds, 1));
    RUN(15, phase_moe_dn<kFp8[1]>(P, lds, 1));
    RUN(16, phase_final(P));
#undef RUN
#undef IN
#undef SEAM
}

}

extern "C" void kernel_launch(void* const* d_in, const int* in_sizes, int n_in, void* d_out, int out_size, void* d_ws, size_t ws_size, hipStream_t stream) {
    static int grid = 0;
    if (grid == 0) {
        if (n_in != 22 || in_sizes[0] != NTOK * DM || out_size != NTOK * DM || ws_size < WS_END) {
            fprintf(stderr, "kernel_launch: unexpected shapes (n_in %d, in0 %d, out %d, ws %zu < %zu)\n", n_in, n_in > 0 ? in_sizes[0] : -1, out_size, ws_size, (size_t)WS_END); grid = -1; return; }
        int dev = 0, cus = 0, per_cu = 0;
        (void)hipGetDevice(&dev); (void)hipDeviceGetAttribute(&cus, hipDeviceAttributeMultiprocessorCount, dev);
        if (hipFuncSetAttribute((const void*)yoco_fwd, hipFuncAttributeMaxDynamicSharedMemorySize, LDS_BYTES) != hipSuccess) { fprintf(stderr, "kernel_launch: hipFuncSetAttribute failed\n"); grid = -1; return; }
        if (hipOccupancyMaxActiveBlocksPerMultiprocessor(&per_cu, (const void*)yoco_fwd, NTHREADS, LDS_BYTES) != hipSuccess || per_cu < 1) { fprintf(stderr, "kernel_launch: occupancy query says %d\n", per_cu); }
        (void)hipGetLastError();
        grid = cus > 0 ? cus : 256;
    }
    if (grid < 0) return;
    (void)hipMemsetAsync((char*)d_ws + WS_CTL, 0, CTL_BYTES, stream);
    Params p{};
    for (int i = 0; i < 22; ++i) p.in[i] = (const float*)d_in[i];
    p.out = (float*)d_out; p.ws = (unsigned char*)d_ws;
#if MK_LAUNCHES == 1
    p.ph_lo = 0; p.ph_hi = NPHASES;
    hipLaunchKernelGGL(yoco_fwd, dim3(grid), dim3(NTHREADS), LDS_BYTES, stream, p);
#else
    for (int k = 0; k < NPHASES; ++k) { p.ph_lo = k; p.ph_hi = k + 1; hipLaunchKernelGGL(yoco_fwd, dim3(grid), dim3(NTHREADS), LDS_BYTES, stream, p); }
#endif
}
```

```cpp
#include <hip/hip_runtime.h>
#include <cstdint>
#include <cstdio>

#ifndef MK_LAUNCHES
#define MK_LAUNCHES 1
#endif

#ifndef FP8_L1
#define FP8_L1 1
#endif
#ifndef FP8_L0
#define FP8_L0 1
#endif

namespace {

typedef unsigned short bf16_t;
typedef int v8i __attribute__((ext_vector_type(8)));
typedef int v4i __attribute__((ext_vector_type(4)));
typedef short bf16x8 __attribute__((ext_vector_type(8)));
typedef short s16x4 __attribute__((ext_vector_type(4)));
typedef float f32x4 __attribute__((ext_vector_type(4)));
typedef float f32x16 __attribute__((ext_vector_type(16)));
typedef unsigned u32x4 __attribute__((ext_vector_type(4)));
typedef unsigned u32x2 __attribute__((ext_vector_type(2)));

constexpr int NTOK = 16384, DM = 2048, SEQ = 2048, NBATCH = 8, NH = 16, HD = 128;
constexpr int NSA_IN_W = 5168, KV6_W = 3072, NEXP = 32, DEXP = 1024, LISTCAP = 32768;
constexpr int NTHREADS = 512;
constexpr float LOG2E = 1.4426950408889634f;
constexpr float QSCALE = 0.08838834764831845f;
constexpr float RMS_EPS = 1e-6f;
constexpr int LDS_BYTES = 147456;
constexpr int NPHASES = 17;
constexpr bool kFp8[2] = {FP8_L0 != 0, FP8_L1 != 0};
constexpr float W8_SCALE = 64.f, W8_INV = 1.f / 64.f;

constexpr size_t al256(size_t x) { return (x + 255) & ~(size_t)255; }
constexpr size_t WS_CTL   = 0;
constexpr size_t CTL_BYTES = 65536;
constexpr size_t WS_WIN   = WS_CTL + CTL_BYTES;
constexpr size_t WS_CW1   = WS_WIN + (size_t)5376 * 2048 * 2;
constexpr size_t WS_WOUT  = WS_CW1 + (size_t)2 * 256 * 4096 * 2;
constexpr size_t WS_WKVQ  = WS_WOUT + (size_t)2048 * 2048 * 2;
constexpr size_t WS_WFO   = WS_WKVQ + (size_t)3072 * 2048 * 2;
constexpr size_t WS_GU    = WS_WFO + (size_t)2048 * 2048 * 2;
constexpr size_t WS_DN    = WS_GU + (size_t)2 * 32 * 2048 * 2048 * 2;
constexpr size_t WS_BIAS1 = WS_DN + (size_t)2 * 32 * 2048 * 1024 * 2;
constexpr size_t WS_RW    = WS_BIAS1 + 2 * 32 * 256 * 4;
constexpr size_t WS_WF    = WS_RW + (size_t)2 * 2048 * 32 * 4;
constexpr size_t WS_XBA   = al256(WS_WF + (size_t)2048 * 32 * 4);
constexpr size_t WS_XBB   = WS_XBA + (size_t)NTOK * DM * 2;
constexpr size_t WS_Q     = WS_XBB + (size_t)NTOK * DM * 2;
constexpr size_t WS_KV6   = WS_Q + (size_t)NTOK * DM * 2;
constexpr size_t WS_GATES = WS_KV6 + (size_t)NTOK * KV6_W * 2;
constexpr size_t WS_CPART = WS_GATES + (size_t)NTOK * 48 * 4;
constexpr size_t WS_KVCMP = WS_CPART + (size_t)2 * 8 * 4096 * 256 * 4;
constexpr size_t WS_OATT  = WS_KVCMP + (size_t)2 * 8 * 128 * 512 * 2;
constexpr size_t WS_X1    = WS_OATT + (size_t)NTOK * DM * 2;
constexpr size_t WS_X2    = WS_X1 + (size_t)NTOK * DM * 4;
constexpr size_t WS_H     = WS_X2 + (size_t)NTOK * DM * 4;
constexpr size_t WS_Y     = WS_H + (size_t)40960 * 1024 * 2;
constexpr size_t WS_LIST  = WS_Y + (size_t)32768 * 2048 * 2;
constexpr size_t WS_EW    = WS_LIST + (size_t)2 * 32 * LISTCAP * 4;
constexpr size_t WS_RSTD  = WS_EW + (size_t)2 * NTOK * 2 * 4;
constexpr size_t WS_KV2   = WS_RSTD + (size_t)3 * NTOK * 4;
constexpr size_t WS_LOGF  = WS_KV2 + (size_t)NTOK * 1024 * 2;
constexpr size_t WS_C2    = WS_LOGF + (size_t)NTOK * 16 * 4;
constexpr size_t WS_XB8   = WS_C2 + (size_t)8 * 16 * 2048 * 4;
constexpr size_t WS_END   = WS_XB8 + (size_t)NTOK * DM;
constexpr int CW_BAR = 0;
constexpr int CW_CNT = 4096;
constexpr int CW_END = CW_CNT + 2 * 32 * 64;
static_assert(CW_END * 4 <= (int)CTL_BYTES, "ctl");

struct Params {
    const float* in[22];
    float* out;
    unsigned char* ws;
    int ph_lo, ph_hi;
};

__device__ __forceinline__ unsigned cvtpk(float lo, float hi) {
    unsigned r; asm volatile("v_cvt_pk_bf16_f32 %0, %1, %2" : "=v"(r) : "v"(lo), "v"(hi)); return r;
}
__device__ __forceinline__ float bflo(unsigned w) { return __uint_as_float(w << 16); }
__device__ __forceinline__ float bfhi(unsigned w) { return __uint_as_float(w & 0xffff0000u); }
__device__ __forceinline__ bf16x8 pack8(f32x4 a, f32x4 b) {
    u32x4 w = {cvtpk(a[0], a[1]), cvtpk(a[2], a[3]), cvtpk(b[0], b[1]), cvtpk(b[2], b[3])};
    return *reinterpret_cast<bf16x8*>(&w);
}
__device__ __forceinline__ float wave_sum(float v) {
#pragma unroll
    for (int o = 32; o >= 1; o >>= 1) v += __shfl_xor(v, o);
    return v;
}
__device__ __forceinline__ float fast_exp2(float x) { return __builtin_amdgcn_exp2f(x); }
__device__ __forceinline__ float fast_rcp(float x) { return __builtin_amdgcn_rcpf(x); }

__device__ __forceinline__ const void* uniform_ptr(const void* p) {
    const unsigned long long a = (unsigned long long)p;
    const unsigned lo = __builtin_amdgcn_readfirstlane((unsigned)a), hi = __builtin_amdgcn_readfirstlane((unsigned)(a >> 32));
    return (const void*)(((unsigned long long)hi << 32) | lo);
}
__device__ __forceinline__ void glds16(unsigned voff, const void* sbase, unsigned ldsaddr) {
    unsigned keep; sbase = uniform_ptr(sbase); ldsaddr = __builtin_amdgcn_readfirstlane(ldsaddr);
    asm volatile("s_mov_b32 %0, m0\n\ts_mov_b32 m0, %3\n\ts_nop 0\n\tglobal_load_lds_dwordx4 %1, %2\n\ts_mov_b32 m0, %0"
                 : "=&s"(keep) : "v"(voff), "s"(sbase), "s"(ldsaddr) : "memory");
}
__device__ __forceinline__ void glds4(unsigned voff, const void* sbase, unsigned ldsaddr) {
    unsigned keep; sbase = uniform_ptr(sbase); ldsaddr = __builtin_amdgcn_readfirstlane(ldsaddr);
    asm volatile("s_mov_b32 %0, m0\n\ts_mov_b32 m0, %3\n\ts_nop 0\n\tglobal_load_lds_dword %1, %2\n\ts_mov_b32 m0, %0"
                 : "=&s"(keep) : "v"(voff), "s"(sbase), "s"(ldsaddr) : "memory");
}
__device__ __forceinline__ unsigned lds_addr(const void* p) { return (unsigned)(size_t)(__attribute__((address_space(3))) const char*)p; }

#define XB_TMO      128
#define XB_XCNT(j)  (256  + 64 * (j))
#define XB_XSUB(j)  (1280 + 64 * (j))
#define XB_XGEN(j)  (2304 + 64 * (j))
#define XB_TOP      3328
#define XB_TOPGEN   3392
#define XCD_BAR_WORDS 3456
#define XB_SPIN_CAP (1u << 20)
#define LAS __attribute__((address_space(3)))

__device__ __forceinline__ unsigned xb_ld(unsigned* p)              { return __hip_atomic_load(p, __ATOMIC_RELAXED, __HIP_MEMORY_SCOPE_AGENT); }
__device__ __forceinline__ unsigned xb_add(unsigned* p, unsigned v) { return __hip_atomic_fetch_add(p, v, __ATOMIC_RELAXED, __HIP_MEMORY_SCOPE_AGENT); }
__device__ __forceinline__ unsigned xb_xcc_id() { return (unsigned)__builtin_amdgcn_s_getreg((3 << 11) | 20) & 0xFu; }
#define XB_SPIN(cond, bar) do { unsigned _sp = 0; while (cond) { __builtin_amdgcn_s_sleep(1); \
    if ((++_sp & 255u) == 0u) { if (xb_ld(&(bar)[XB_TMO])) break; if (_sp > XB_SPIN_CAP) { atomicAdd(&(bar)[XB_TMO], 1u); break; } } } } while (0)

struct XcdBarrier { unsigned* bar; unsigned x; volatile LAS unsigned* st; };

__device__ __forceinline__ XcdBarrier xcd_barrier_post(unsigned* bar, volatile LAS unsigned* st) {
    XcdBarrier b; b.bar = bar; b.x = xb_xcc_id(); b.st = st;
    if (threadIdx.x == 0) (void)xb_add(&bar[XB_XCNT(b.x)], 1u);
    return b;
}
__device__ __forceinline__ void xcd_barrier_complete(unsigned* bar, unsigned x, unsigned& nloc, unsigned& nx) {
    const unsigned G = gridDim.x * gridDim.y * gridDim.z;
    unsigned sum, cnt, mine, sp = 0u;
    for (;;) {
        sum = 0u; cnt = 0u; mine = 0u;
#pragma unroll
        for (unsigned j = 0; j < 16; ++j) { const unsigned c = xb_ld(&bar[XB_XCNT(j)]); sum += c; cnt += (c > 0u) ? 1u : 0u; mine = (j == x) ? c : mine; }
        if (sum == G) break;
        __builtin_amdgcn_s_sleep(1);
        if ((++sp & 255u) == 0u) { if (xb_ld(&bar[XB_TMO])) break; if (sp > XB_SPIN_CAP) { atomicAdd(&bar[XB_TMO], 1u); break; } }
    }
    nloc = mine > 0u ? mine : 1u; nx = cnt > 0u ? cnt : 1u;
}
__device__ __forceinline__ void xcd_barrier(const XcdBarrier& b) {
    asm volatile("s_waitcnt vmcnt(0)" ::: "memory");
    __syncthreads();
    if (threadIdx.x == 0) {
        unsigned* bar = b.bar;
        __builtin_amdgcn_s_waitcnt(0);
        unsigned nloc = b.st[0], nx = b.st[1];
        if (nloc == 0u) { xcd_barrier_complete(bar, b.x, nloc, nx); b.st[0] = nloc; b.st[1] = nx; }
        const unsigned old = xb_add(&bar[XB_XSUB(b.x)], 1u);
        const unsigned gen = old / nloc;
        if (old + 1u == (gen + 1u) * nloc) {
            __builtin_amdgcn_fence(__ATOMIC_RELEASE, "agent");
            asm volatile("s_waitcnt vmcnt(0)" ::: "memory");
            const unsigned og = xb_add(&bar[XB_TOP], 1u);
            const unsigned tg = og / nx;
            if (og + 1u == (tg + 1u) * nx) xb_add(&bar[XB_TOPGEN], 1u);
            else XB_SPIN(xb_ld(&bar[XB_TOPGEN]) == tg, bar);
            __builtin_amdgcn_fence(__ATOMIC_ACQUIRE, "agent");
            xb_add(&bar[XB_XGEN(b.x)], 1u);
            asm volatile("s_waitcnt vmcnt(0)" ::: "memory");
        } else {
            XB_SPIN(xb_ld(&bar[XB_XGEN(b.x)]) == gen, bar);
            __builtin_amdgcn_fence(__ATOMIC_ACQUIRE, "agent");
            asm volatile("s_waitcnt vmcnt(0)" ::: "memory");
        }
    }
    __syncthreads();
}

__device__ __forceinline__ int lds_byte(int r, int c) { const int st = (r >> 4) * 2 + (c >> 5), rr = r & 15, cc = c & 31, ob = rr * 64 + cc * 2; return st * 1024 + (ob ^ (((ob >> 9) & 1) << 5)); }
__device__ __forceinline__ void stage_rc(int b, int& R, int& C) { const int st = b / 1024, sb = b % 1024, swz = sb ^ (((sb >> 9) & 1) << 5); R = (st >> 1) * 16 + swz / 64; C = (st & 1) * 32 + (swz % 64) / 2; }
__device__ __forceinline__ int perm32(int rho) { const int n = rho >> 4, i = rho & 15; return 8 * (i >> 2) + 4 * n + (i & 3); }

typedef f32x4 AccT[2][2][4][2];

#define G_SA(b, h) (ldsb + (((b) * 2 + (h)) * 16384))
#define G_SB(b, h) (ldsb + ((4 + (b) * 2 + (h)) * 16384))
#define AKOFF(t) ((size_t)((unsigned)((t) >> 1) * astep2 + (unsigned)((t) & 1) * 128u))
#define STAGE_A(buf, h, t) do { const char* _p = Ab + AKOFF(t); \
    glds16((h) ? ao2 : ao0, _p, ldsw + ((buf) * 2 + (h)) * 16384); glds16((h) ? ao3 : ao1, _p, ldsw + ((buf) * 2 + (h)) * 16384 + 8192); } while (0)
#define STAGE_B(buf, h, t) do { const char* _p = Bb + (size_t)(h) * 128 * ldb + (size_t)(t) * 128u; \
    glds16(bo, _p, ldsw + (4 + (buf) * 2 + (h)) * 16384); glds16(bo, _p + (size_t)64 * ldb, ldsw + (4 + (buf) * 2 + (h)) * 16384 + 8192); } while (0)
#define LDA(dst, b, h) for (int m = 0; m < 4; ++m) for (int k = 0; k < 2; ++k) \
    dst[m][k] = *reinterpret_cast<const bf16x8*>(G_SA(b, h) + lds_byte(wr * 64 + m * 16 + fr, k * 32 + fq * 8))
#define LDB(dst, b, h) for (int n = 0; n < 2; ++n) for (int k = 0; k < 2; ++k) \
    dst[n][k] = *reinterpret_cast<const bf16x8*>(G_SB(b, h) + lds_byte(wc * 32 + n * 16 + fr, k * 32 + fq * 8))
#define MMA(ai, bj, At_, Bt_) do { __builtin_amdgcn_s_setprio(1); \
    for (int m = 0; m < 4; ++m) for (int n = 0; n < 2; ++n) for (int k = 0; k < 2; ++k) \
      acc[ai][bj][m][n] = __builtin_amdgcn_mfma_f32_16x16x32_bf16(Bt_[n][k], At_[m][k], acc[ai][bj][m][n], 0, 0, 0); \
    __builtin_amdgcn_s_setprio(0); } while (0)
typedef short s16x16 __attribute__((ext_vector_type(16)));
__device__ __forceinline__ v8i cat8(bf16x8 a, bf16x8 b) { const s16x16 t = __builtin_shufflevector(a, b, 0, 1, 2, 3, 4, 5, 6, 7, 8, 9, 10, 11, 12, 13, 14, 15); return __builtin_bit_cast(v8i, t); }
#define CAT8(x, y) cat8(x, y)
__device__ __forceinline__ void mfma8(f32x4& acc, v8i a, v8i b, unsigned sc) {
    asm volatile("v_mfma_scale_f32_16x16x128_f8f6f4 %0, %1, %2, %0, %3, %3 op_sel_hi:[0,0,0]" : "+v"(acc) : "v"(a), "v"(b), "v"(sc));
}
#define MMA8(ai, bj, At_, Bt_) do { __builtin_amdgcn_s_setprio(1); \
    _Pragma("unroll") for (int m = 0; m < 4; ++m) _Pragma("unroll") for (int n = 0; n < 2; ++n) \
      mfma8(acc[ai][bj][m][n], CAT8(Bt_[n][0], Bt_[n][1]), CAT8(At_[m][0], At_[m][1]), sc127); \
    __builtin_amdgcn_s_setprio(0); } while (0)
#define MMAX(ai, bj, At_, Bt_) do { if (FP8) MMA8(ai, bj, At_, Bt_); else MMA(ai, bj, At_, Bt_); } while (0)
#define WAIT_V(n) asm volatile("s_waitcnt vmcnt(" #n ")" ::: "memory")
#define WAIT_L(n) asm volatile("s_waitcnt lgkmcnt(" #n ")" ::: "memory")
#define BAR __builtin_amdgcn_s_barrier()
#define SCHED __builtin_amdgcn_sched_barrier(0)

template <bool PERM, bool FP8, class Epi>
__device__ __forceinline__ void gemm256(unsigned char* lds, const char* __restrict__ Ab, const char* __restrict__ Bb, const unsigned ldb,
                                        const unsigned astep2, const int nt, const unsigned ao0, const unsigned ao1, const unsigned ao2,
                                        const unsigned ao3, const Epi& epi) {
    char* ldsb = (char*)lds;
    int tid = threadIdx.x;
    const unsigned ldsw = lds_addr(lds) + (unsigned)__builtin_amdgcn_readfirstlane(tid >> 6) * 1024u;
    int wid = tid >> 6, lane = tid & 63, wr = wid >> 2, wc = wid & 3, fr = lane & 15, fq = lane >> 4;
    unsigned bo; { int R, C; stage_rc(tid * 16, R, C); const int pr = PERM ? ((R & ~31) | perm32(R & 31)) : R; bo = (unsigned)pr * ldb + (unsigned)C * 2u; }
    AccT acc = {};
    bf16x8 At[4][2], B0[2][2], B1[2][2];
    unsigned sc127 = 127u; if (FP8) asm volatile("" : "+v"(sc127));
    STAGE_B(0, 0, 0); STAGE_A(0, 0, 0);
    STAGE_B(0, 1, 0); STAGE_A(0, 1, 0);
    if (wr == 1) BAR;
    WAIT_V(4); BAR;
    STAGE_B(1, 0, 1); STAGE_A(1, 0, 1); STAGE_B(1, 1, 1);
    WAIT_V(6); BAR;
    for (int t = 0; t < nt - 2; t += 2) {
        LDB(B0, 0, 0); SCHED; LDA(At, 0, 0); STAGE_A(1, 1, t + 1);
        WAIT_L(8); BAR; WAIT_L(0); MMAX(0, 0, At, B0); BAR; SCHED;
        LDB(B1, 0, 1); STAGE_B(0, 0, t + 2);
        BAR; WAIT_L(0); MMAX(0, 1, At, B1); BAR;
        LDA(At, 0, 1); STAGE_A(0, 0, t + 2);
        BAR; WAIT_L(0); MMAX(1, 0, At, B0); BAR; SCHED;
        STAGE_B(0, 1, t + 2);
        WAIT_V(6); BAR; MMAX(1, 1, At, B1); BAR;
        LDB(B0, 1, 0); SCHED; LDA(At, 1, 0); STAGE_A(0, 1, t + 2);
        WAIT_L(8); BAR; WAIT_L(0); MMAX(0, 0, At, B0); BAR; SCHED;
        LDB(B1, 1, 1); STAGE_B(1, 0, t + 3);
        BAR; WAIT_L(0); MMAX(0, 1, At, B1); BAR;
        LDA(At, 1, 1); STAGE_A(1, 0, t + 3);
        BAR; WAIT_L(0); MMAX(1, 0, At, B0); BAR; SCHED;
        STAGE_B(1, 1, t + 3);
        WAIT_V(6); BAR; MMAX(1, 1, At, B1); BAR;
    }
    { int tz = threadIdx.x; asm volatile("" : "+v"(tz)); tid = tz; wid = tz >> 6; lane = tz & 63; wr = wid >> 2; wc = wid & 3; fr = lane & 15; fq = lane >> 4; }
    { LDB(B0, 0, 0); WAIT_V(0); LDA(At, 0, 0); STAGE_A(1, 1, nt - 1);
      BAR; WAIT_L(0); MMAX(0, 0, At, B0); BAR;
      LDB(B1, 0, 1); BAR; WAIT_L(0); MMAX(0, 1, At, B1); BAR;
      LDA(At, 0, 1); WAIT_V(4); BAR; WAIT_L(0); MMAX(1, 0, At, B0); MMAX(1, 1, At, B1); BAR; }
    { LDB(B0, 1, 0); LDA(At, 1, 0); WAIT_V(2); BAR; WAIT_L(0); MMAX(0, 0, At, B0); BAR;
      LDB(B1, 1, 1); WAIT_V(0); BAR; WAIT_L(0); MMAX(0, 1, At, B1); BAR;
      LDA(At, 1, 1); BAR; WAIT_L(0); MMAX(1, 0, At, B0); MMAX(1, 1, At, B1); BAR; }
    if (wr == 0) BAR;
    epi(acc, wr, wc, fr, fq);
    __syncthreads();
}

__device__ __forceinline__ void tile_order(int L, int nM, int nN, int& pm, int& pn) {
    const int nwg = nM * nN; int wgid = L;
    { const int q = nwg / 8, r = nwg % 8, xcd = wgid % 8, off = wgid / 8; wgid = (xcd < r ? xcd * (q + 1) : r * (q + 1) + (xcd - r) * q) + off; }
    const int nig = 8 * nN, gid = wgid / nig, fm = gid * 8, gsz = (nM - fm) < 8 ? (nM - fm) : 8;
    pm = fm + ((wgid % nig) % gsz); pn = (wgid % nig) / gsz;
}
__device__ __forceinline__ void stage_row_col(int tid, int& R0, int& C) { stage_rc(tid * 16, R0, C); }


__device__ __forceinline__ u32x4 pack8v(f32x4 a, f32x4 b) { u32x4 w = {cvtpk(a[0], a[1]), cvtpk(a[2], a[3]), cvtpk(b[0], b[1]), cvtpk(b[2], b[3])}; return w; }
__device__ __forceinline__ u32x2 pack8_fp8(f32x4 a, f32x4 b) {
    unsigned w0 = 0, w1 = 0;
    w0 = __builtin_amdgcn_cvt_pk_fp8_f32(a[0], a[1], w0, false); w0 = __builtin_amdgcn_cvt_pk_fp8_f32(a[2], a[3], w0, true);
    w1 = __builtin_amdgcn_cvt_pk_fp8_f32(b[0], b[1], w1, false); w1 = __builtin_amdgcn_cvt_pk_fp8_f32(b[2], b[3], w1, true);
    return (u32x2){w0, w1};
}
__device__ __forceinline__ float sigmoidf_(float x) { return fast_rcp(1.f + fast_exp2(-x * LOG2E)); }

struct EpiProj0 {
    bf16_t* Q; bf16_t* KV6; float* gates; int row0, pn;
    __device__ __forceinline__ void operator()(const AccT& acc, int wr, int wc, int fr, int fq) const {
#pragma unroll
        for (int ai = 0; ai < 2; ++ai)
#pragma unroll
            for (int m = 0; m < 4; ++m) {
                const size_t row = (size_t)(row0 + ai * 128 + wr * 64 + m * 16 + fr);
#pragma unroll
                for (int bj = 0; bj < 2; ++bj) {
                    const int col8 = bj * 128 + wc * 32 + 8 * fq;
                    f32x4 v0 = acc[ai][bj][m][0], v1 = acc[ai][bj][m][1];
                    if (pn < 8) { v0 *= QSCALE; v1 *= QSCALE; *(u32x4*)(Q + row * DM + pn * 256 + col8) = pack8v(v0, v1); }
                    else if (pn < 20) { *(u32x4*)(KV6 + row * KV6_W + (pn - 8) * 256 + col8) = pack8v(v0, v1); }
                    else if (col8 < 48) {
                        f32x4 s0, s1;
#pragma unroll
                        for (int j = 0; j < 4; ++j) { s0[j] = sigmoidf_(v0[j]); s1[j] = sigmoidf_(v1[j]); }
                        *(f32x4*)(gates + row * 48 + col8) = s0; *(f32x4*)(gates + row * 48 + col8 + 4) = s1;
                    }
                }
            }
    }
};
struct EpiF32 {
    float* C;
    __device__ __forceinline__ void operator()(const AccT& acc, int wr, int wc, int fr, int fq) const {
#pragma unroll
        for (int ai = 0; ai < 2; ++ai)
#pragma unroll
            for (int m = 0; m < 4; ++m) {
                float* rowp = C + (size_t)(ai * 128 + wr * 64 + m * 16 + fr) * 256 + wc * 32 + 4 * fq;
#pragma unroll
                for (int bj = 0; bj < 2; ++bj)
#pragma unroll
                    for (int n = 0; n < 2; ++n) *(f32x4*)(rowp + bj * 128 + n * 16) = acc[ai][bj][m][n];
            }
    }
};
struct EpiOut {
    const float* xold; float* xnew; bf16_t* xb; unsigned char* xb8; int row0, col0;
    __device__ __forceinline__ void operator()(const AccT& acc, int wr, int wc, int fr, int fq) const {
#pragma unroll
        for (int ai = 0; ai < 2; ++ai)
#pragma unroll
            for (int m = 0; m < 4; ++m) {
                const size_t row = (size_t)(row0 + ai * 128 + wr * 64 + m * 16 + fr);
#pragma unroll
                for (int bj = 0; bj < 2; ++bj) {
                    const size_t off = row * DM + col0 + bj * 128 + wc * 32 + 8 * fq;
                    f32x4 v0 = acc[ai][bj][m][0] + *(const f32x4*)(xold + off), v1 = acc[ai][bj][m][1] + *(const f32x4*)(xold + off + 4);
                    *(f32x4*)(xnew + off) = v0; *(f32x4*)(xnew + off + 4) = v1;
                    *(u32x4*)(xb + off) = pack8v(v0, v1);
                    if (xb8) *(u32x2*)(xb8 + off) = pack8_fp8(v0, v1);
                }
            }
    }
};
struct EpiKVQ {
    bf16_t* KV2; bf16_t* Q; const float* rstd; int row0, pn;
    __device__ __forceinline__ void operator()(const AccT& acc, int wr, int wc, int fr, int fq) const {
#pragma unroll
        for (int ai = 0; ai < 2; ++ai)
#pragma unroll
            for (int m = 0; m < 4; ++m) {
                const size_t row = (size_t)(row0 + ai * 128 + wr * 64 + m * 16 + fr);
                float rs = rstd[row]; if (pn >= 4) rs *= QSCALE;
#pragma unroll
                for (int bj = 0; bj < 2; ++bj) {
                    const int col8 = bj * 128 + wc * 32 + 8 * fq;
                    const f32x4 v0 = acc[ai][bj][m][0] * rs, v1 = acc[ai][bj][m][1] * rs;
                    if (pn < 4) *(u32x4*)(KV2 + row * 1024 + pn * 256 + col8) = pack8v(v0, v1);
                    else *(u32x4*)(Q + row * DM + (pn - 4) * 256 + col8) = pack8v(v0, v1);
                }
            }
    }
};
template <bool FP8> struct EpiGU {
    void* H; const int* list; const float* rstd; int hrow0, pn, nvalid;
    __device__ __forceinline__ void operator()(const AccT& acc, int wr, int wc, int fr, int fq) const {
#pragma unroll
        for (int ai = 0; ai < 2; ++ai)
#pragma unroll
            for (int m = 0; m < 4; ++m) {
                const int lr = ai * 128 + wr * 64 + m * 16 + fr;
                if (lr < nvalid) {
                    const float rs = rstd[list[lr] >> 1] * (FP8 ? W8_INV : 1.f);
                    f32x4 h0, h1;
#pragma unroll
                    for (int j = 0; j < 4; ++j) {
                        const float g0 = acc[ai][0][m][0][j] * rs, u0 = acc[ai][1][m][0][j] * rs, g1 = acc[ai][0][m][1][j] * rs, u1 = acc[ai][1][m][1][j] * rs;
                        h0[j] = g0 * sigmoidf_(g0) * u0; h1[j] = g1 * sigmoidf_(g1) * u1;
                    }
                    const size_t off = (size_t)(hrow0 + lr) * DEXP + pn * 128 + wc * 32 + 8 * fq;
                    if (FP8) *(u32x2*)((unsigned char*)H + off) = pack8_fp8(h0, h1);
                    else *(u32x4*)((bf16_t*)H + off) = pack8v(h0, h1);
                }
            }
    }
};
struct EpiDN {
    bf16_t* Y; const int* list; int pn, nvalid; float oscale;
    __device__ __forceinline__ void operator()(const AccT& acc, int wr, int wc, int fr, int fq) const {
#pragma unroll
        for (int ai = 0; ai < 2; ++ai)
#pragma unroll
            for (int m = 0; m < 4; ++m) {
                const int lr = ai * 128 + wr * 64 + m * 16 + fr;
                if (lr < nvalid) {
                    bf16_t* rowp = Y + (size_t)list[lr] * DM + pn * 256 + wc * 32 + 8 * fq;
#pragma unroll
                    for (int bj = 0; bj < 2; ++bj) *(u32x4*)(rowp + bj * 128) = pack8v(acc[ai][bj][m][0] * oscale, acc[ai][bj][m][1] * oscale);
                }
            }
    }
};

struct CvtJob { const float* src; bf16_t* dst; const float* gain; int K, ld, ncols, tilesN, tilesKN; size_t srcE, dstE; int pA, pB, pC; bool f8; };
constexpr int NJOBS = 13;
__device__ __forceinline__ int job_tiles(int j) {
    switch (j) { case 0: return 16 * 41; case 1: case 2: return 32 * 2; case 3: return 16 * 16; case 4: return 16 * 8; case 5: case 6: return 16 * 16; default: return 4096; }
}
__device__ __forceinline__ void get_job(const Params& P, int j, CvtJob& J) {
    unsigned char* ws = P.ws;
    J.gain = nullptr; J.srcE = 0; J.dstE = 0; J.pA = 1 << 30; J.pB = 0; J.pC = 0; J.f8 = (j >= 7) && kFp8[(j >= 10) ? 1 : 0];
    const int l = (j >= 10) ? 1 : 0;
    switch (j) {
    case 0: J.src = P.in[1]; J.dst = (bf16_t*)(ws + WS_WIN); J.K = 2048; J.ld = 5168; J.ncols = 5168; break;
    case 1: J.src = P.in[4]; J.dst = (bf16_t*)(ws + WS_CW1); J.K = 4096; J.ld = 256; J.ncols = 256; break;
    case 2: J.src = P.in[6]; J.dst = (bf16_t*)(ws + WS_CW1) + (size_t)256 * 4096; J.K = 4096; J.ld = 256; J.ncols = 256; break;
    case 3: J.src = P.in[8]; J.dst = (bf16_t*)(ws + WS_WOUT); J.K = 2048; J.ld = 2048; J.ncols = 2048; break;
    case 4: J.src = P.in[10]; J.dst = (bf16_t*)(ws + WS_WKVQ); J.K = 2048; J.ld = 1040; J.ncols = 1024; J.gain = P.in[9]; break;
    case 5: J.src = P.in[12]; J.dst = (bf16_t*)(ws + WS_WKVQ) + (size_t)1024 * 2048; J.K = 2048; J.ld = 2048; J.ncols = 2048; J.gain = P.in[14] + DM; break;
    case 6: J.src = P.in[13]; J.dst = (bf16_t*)(ws + WS_WFO); J.K = 2048; J.ld = 2048; J.ncols = 2048; break;
    case 7: case 10: J.src = P.in[18] + (size_t)l * 32 * 2048 * 1024; J.dst = (bf16_t*)(ws + WS_GU) + (size_t)l * 32 * 2048 * 2048; J.K = 2048; J.ld = 1024; J.ncols = 1024;
        J.gain = P.in[15] + l * DM; J.srcE = (size_t)2048 * 1024; J.dstE = (size_t)2048 * 2048; J.pA = 128; J.pB = 256; J.pC = 0; break;
    case 8: case 11: J.src = P.in[19] + (size_t)l * 32 * 2048 * 1024; J.dst = (bf16_t*)(ws + WS_GU) + (size_t)l * 32 * 2048 * 2048; J.K = 2048; J.ld = 1024; J.ncols = 1024;
        J.gain = P.in[15] + l * DM; J.srcE = (size_t)2048 * 1024; J.dstE = (size_t)2048 * 2048; J.pA = 128; J.pB = 256; J.pC = 128; break;
    default: J.src = P.in[20] + (size_t)l * 32 * 1024 * 2048; J.dst = (bf16_t*)(ws + WS_DN) + (size_t)l * 32 * 2048 * 1024; J.K = 1024; J.ld = 2048; J.ncols = 2048;
        J.srcE = (size_t)1024 * 2048; J.dstE = (size_t)2048 * 1024; break;
    }
    J.tilesN = (J.ncols + 127) / 128; J.tilesKN = J.tilesN * (J.K / 128);
}
struct CvtRegs { f32x4 v[8]; float gn[8]; };
__device__ __forceinline__ void cvt_load(const CvtJob& J, int idx, CvtRegs& R) {
    const int tid = threadIdx.x;
    const int e = idx / J.tilesKN, rem = idx - e * J.tilesKN, ktile = rem / J.tilesN, ntile = rem - ktile * J.tilesN;
    const float* src = J.src + (size_t)e * J.srcE;
    const int k0 = ktile * 128, n0 = ntile * 128, nn = (tid & 31) * 4;
    const bool okc = (n0 + nn) < J.ncols;
#pragma unroll
    for (int p = 0; p < 8; ++p) {
        const int kk = (tid >> 5) + 16 * p;
        R.v[p] = (f32x4){0.f, 0.f, 0.f, 0.f};
        if (okc) R.v[p] = __builtin_nontemporal_load((const f32x4*)(src + (size_t)(k0 + kk) * J.ld + n0 + nn));
        R.gn[p] = J.gain ? J.gain[k0 + kk] : 1.f;
    }
}
__device__ __forceinline__ void cvt_store(const CvtJob& J, int idx, const CvtRegs& R, float* T  ) {
    const int tid = threadIdx.x;
    const int e = idx / J.tilesKN, rem = idx - e * J.tilesKN, ktile = rem / J.tilesN, ntile = rem - ktile * J.tilesN;
    bf16_t* dst = J.dst + (size_t)e * J.dstE;
    const int k0 = ktile * 128, n0 = ntile * 128, nn = (tid & 31) * 4;
#pragma unroll
    for (int p = 0; p < 8; ++p) {
        const int kk = (tid >> 5) + 16 * p;
        float* t = T + kk * 129 + nn; const f32x4 v = R.v[p] * R.gn[p];
        t[0] = v[0]; t[1] = v[1]; t[2] = v[2]; t[3] = v[3];
    }
    __syncthreads();
    if (!J.f8) {
        const int kc = (tid & 15) * 8;
#pragma unroll
        for (int p = 0; p < 4; ++p) {
            const int n = (tid >> 4) + 32 * p, ng = n0 + n;
            if (ng < J.ncols) {
                const float* t = T + kc * 129 + n;
                f32x4 a = {t[0], t[129], t[258], t[387]}, b = {t[516], t[645], t[774], t[903]};
                const int drow = (ng / J.pA) * J.pB + J.pC + (ng % J.pA);
                *(u32x4*)(dst + (size_t)drow * J.K + k0 + kc) = pack8v(a, b);
            }
        }
    } else {
        const int kc = (tid & 7) * 16;
        unsigned char* dst8 = (unsigned char*)J.dst + (size_t)e * J.dstE;
#pragma unroll
        for (int p = 0; p < 2; ++p) {
            const int n = (tid >> 3) + 64 * p, ng = n0 + n;
            if (ng < J.ncols) {
                const float* t = T + kc * 129 + n;
                f32x4 a = {t[0], t[129], t[258], t[387]}, b = {t[516], t[645], t[774], t[903]}, c = {t[1032], t[1161], t[1290], t[1419]}, d = {t[1548], t[1677], t[1806], t[1935]};
                const u32x2 lo = pack8_fp8(a * W8_SCALE, b * W8_SCALE), hi = pack8_fp8(c * W8_SCALE, d * W8_SCALE);
                const int drow = (ng / J.pA) * J.pB + J.pC + (ng % J.pA);
                *(u32x4*)(dst8 + (size_t)drow * J.K + k0 + kc) = (u32x4){lo[0], lo[1], hi[0], hi[1]};
            }
        }
    }
    __syncthreads();
}
__device__ __forceinline__ int find_job(int g, int& jbase) { int b2 = 0, j = 0; for (; j < NJOBS - 1; ++j) { const int n = job_tiles(j); if (g < b2 + n) break; b2 += n; } jbase = b2; return j; }
__device__ __forceinline__ void phase_convert(const Params& P, unsigned char* lds, int jlo, int jhi) {
    float* T = (float*)lds;
    int base = 0;
    for (int j = 0; j < jlo; ++j) base += job_tiles(j);
    int total = base;
    for (int j = jlo; j < jhi; ++j) total += job_tiles(j);
    int g = base + blockIdx.x;
    if (g >= total) return;
    CvtJob Jc, Jn; CvtRegs Rc, Rn;
    int jbc, jbn, jc = find_job(g, jbc); get_job(P, jc, Jc);
    cvt_load(Jc, g - jbc, Rc);
    for (;;) {
        const int gn = g + gridDim.x; const bool more = gn < total;
        if (more) { const int jn = find_job(gn, jbn); get_job(P, jn, Jn); cvt_load(Jn, gn - jbn, Rn); }
        cvt_store(Jc, g - jbc, Rc, T);
        if (!more) break;
        Jc = Jn; Rc = Rn; jbc = jbn; g = gn;
    }
}
__device__ __forceinline__ void phase0_misc(const Params& P, unsigned char* lds) {
    unsigned char* ws = P.ws;
    const int tid = threadIdx.x, lane = tid & 63, wave = tid >> 6;
    {
        const float* x = P.in[0]; const float* gain = P.in[14]; bf16_t* h0 = (bf16_t*)(ws + WS_XBA);
        for (int row = blockIdx.x * 8 + wave; row < NTOK; row += gridDim.x * 8) {
            const float* xr = x + (size_t)row * DM + lane * 4;
            f32x4 v[8]; float ss = 0.f;
#pragma unroll
            for (int j = 0; j < 8; ++j) { v[j] = *(const f32x4*)(xr + j * 256); ss += v[j][0] * v[j][0] + v[j][1] * v[j][1] + v[j][2] * v[j][2] + v[j][3] * v[j][3]; }
            ss = wave_sum(ss);
            const float rstd = rsqrtf(ss * (1.f / DM) + RMS_EPS);
#pragma unroll
            for (int j = 0; j < 8; ++j) {
                const f32x4 gv = *(const f32x4*)(gain + j * 256 + lane * 4);
                const f32x4 o = v[j] * rstd * gv;
                u32x2 w = {cvtpk(o[0], o[1]), cvtpk(o[2], o[3])};
                *(u32x2*)(h0 + (size_t)row * DM + j * 256 + lane * 4) = w;
            }
        }
    }
    {
        float* rw = (float*)(ws + WS_RW); float* wf = (float*)(ws + WS_WF);
        const int gtid = blockIdx.x * NTHREADS + tid, gsz = gridDim.x * NTHREADS;
        for (int i = gtid; i < 2 * 2048 * 32; i += gsz) { const int l = i >> 16, k = (i >> 5) & 2047, e = i & 31; rw[i] = P.in[15][l * DM + k] * P.in[16][k * 32 + e]; }
        for (int i = gtid; i < 2048 * 32; i += gsz) { const int k = i >> 5, j = i & 31; wf[i] = (j < 16) ? P.in[9][k] * P.in[10][(size_t)k * 1040 + 1024 + j] : 0.f; }
    }
    for (int w = blockIdx.x; w < 64; w += gridDim.x) {
        const int kv = w >> 5, ch = w & 31; const float* pe = P.in[kv ? 3 : 2]; const float* w1 = P.in[kv ? 6 : 4];
        float* red = (float*)lds;
        const int j = tid & 255, half = tid >> 8; float s = 0.f;
        const int i0 = ch * 128 + half * 64;
#pragma unroll 16
        for (int i = i0; i < i0 + 64; ++i) s += pe[i] * w1[(size_t)i * 256 + j];
        __syncthreads();
        red[tid] = s; __syncthreads();
        if (tid < 256) ((float*)(ws + WS_BIAS1))[(kv * 32 + ch) * 256 + tid] = red[tid] + red[tid + 256];
        __syncthreads();
    }
}

__device__ __forceinline__ void lin_offsets(int tid, unsigned lda, unsigned& a0, unsigned& a1, unsigned& a2, unsigned& a3) {
    int R0, C; stage_rc(tid * 16, R0, C);
    a0 = (unsigned)R0 * lda + C * 2; a1 = (unsigned)(R0 + 64) * lda + C * 2; a2 = (unsigned)(R0 + 128) * lda + C * 2; a3 = (unsigned)(R0 + 192) * lda + C * 2;
}
__device__ __forceinline__ void phase_proj0(const Params& P, unsigned char* lds) {
    unsigned char* ws = P.ws;
    unsigned a0, a1, a2, a3; lin_offsets(threadIdx.x, DM * 2, a0, a1, a2, a3);
    for (int L = blockIdx.x; L < 64 * 21; L += gridDim.x) {
        int pm, pn; tile_order(L, 64, 21, pm, pn);
        EpiProj0 E{(bf16_t*)(ws + WS_Q), (bf16_t*)(ws + WS_KV6), (float*)(ws + WS_GATES), pm * 256, pn};
        gemm256<true, false>(lds, (const char*)(ws + WS_XBA) + (size_t)pm * 256 * DM * 2, (const char*)(ws + WS_WIN) + (size_t)pn * 256 * DM * 2, DM * 2, 256u, DM / 64, a0, a1, a2, a3, E);
    }
}
__device__ __forceinline__ void phase_cmp1(const Params& P, unsigned char* lds) {
    unsigned char* ws = P.ws;
    int R0, C; stage_rc(threadIdx.x * 16, R0, C);
    for (int u = blockIdx.x; u < 256; u += gridDim.x) {
        const int kv = u >> 7, mt = (u >> 3) & 15, ks = u & 7;
        unsigned ao[4];
#pragma unroll
        for (int q = 0; q < 4; ++q) {
            int r = mt * 256 + R0 + 64 * q; if (r > 4063) r = 4063;
            const int b = r / 508, rem = r - b * 508, n = rem >> 2, g = rem & 3;
            ao[q] = (unsigned)(((b * SEQ + n * 16) * KV6_W + kv * 512 + g * 128 + C) * 2);
        }
        EpiF32 E{(float*)(ws + WS_CPART) + ((size_t)(kv * 8 + ks) * 4096 + mt * 256) * 256};
        gemm256<false, false>(lds, (const char*)(ws + WS_KV6) + (size_t)ks * 4 * KV6_W * 2, (const char*)(ws + WS_CW1) + ((size_t)kv * 256 * 4096 + ks * 512) * 2, 4096 * 2,
                       (unsigned)(KV6_W * 2), 8, ao[0], ao[1], ao[2], ao[3], E);
    }
}
__device__ __forceinline__ float gelu_tanh(float x) {
    const float u = 0.7978845608028654f * (x + 0.044715f * x * x * x);
    const float t = 1.f - 2.f * fast_rcp(1.f + fast_exp2(2.f * LOG2E * u));
    return 0.5f * x * (1.f + t);
}
__device__ __forceinline__ void phase_cmp2(const Params& P, unsigned char* lds) {
    unsigned char* ws = P.ws;
    const int tid = threadIdx.x;
    float* hid = (float*)lds;
    const float* part = (const float*)(ws + WS_CPART);
    bf16_t* kvc = (bf16_t*)(ws + WS_KVCMP);
    for (int grp = blockIdx.x; grp < 256; grp += gridDim.x) {
        const int kv = grp >> 7, r0 = (grp & 127) * 32;
        {
            const int col = tid & 255, i0 = tid >> 8;
            float bias = 0.f;
#pragma unroll 8
            for (int ch = 0; ch < 32; ++ch) bias += ((const float*)(ws + WS_BIAS1))[(kv * 32 + ch) * 256 + col];
#pragma unroll 4
            for (int ii = 0; ii < 16; ++ii) {
                const int i = i0 + 2 * ii, r = r0 + i;
                float s = bias;
#pragma unroll
                for (int ks = 0; ks < 8; ++ks) s += part[((size_t)(kv * 8 + ks) * 4096 + r) * 256 + col];
                hid[i * 256 + col] = gelu_tanh(s);
            }
        }
        __syncthreads();
        {
            const float* w2 = P.in[kv ? 7 : 5];
            const int j = tid & 127, i0 = tid >> 7;
            float acc[8];
#pragma unroll
            for (int ii = 0; ii < 8; ++ii) acc[ii] = 0.f;
            for (int k = 0; k < 256; k += 4) {
                const float w0 = w2[(k + 0) * 128 + j], w1 = w2[(k + 1) * 128 + j], w2v = w2[(k + 2) * 128 + j], w3 = w2[(k + 3) * 128 + j];
#pragma unroll
                for (int ii = 0; ii < 8; ++ii) {
                    const f32x4 h = *(const f32x4*)(hid + (i0 + 4 * ii) * 256 + k);
                    acc[ii] += h[0] * w0 + h[1] * w1 + h[2] * w2v + h[3] * w3;
                }
            }
#pragma unroll
            for (int ii = 0; ii < 8; ++ii) {
                const int r = r0 + i0 + 4 * ii;
                if (r < 4064) {
                    const int b = r / 508, rem = r - b * 508, n = rem >> 2, g = rem & 3;
                    const float v = acc[ii], vn = __shfl_xor(v, 1);
                    if ((j & 1) == 0) *(unsigned*)(kvc + (size_t)kv * (8 * 128 * 512) + ((size_t)(b * 128 + n) * 4 + g) * 128 + j) = cvtpk(v, vn);
                }
            }
        }
        __syncthreads();
    }
    if (blockIdx.x == 0) {
        for (int i = tid; i < 2 * 8 * 512 / 2; i += NTHREADS) { const int kv = i >> 11, b = (i >> 8) & 7, c2 = i & 255;
            *(unsigned*)(kvc + (size_t)kv * (8 * 128 * 512) + ((size_t)(b * 128 + 127) * 512) + c2 * 2) = 0u; }
    }
}
__device__ __forceinline__ void phase_outproj(const Params& P, unsigned char* lds, size_t wsW, const float* xold, float* xnew, bf16_t* xb, unsigned char* xb8) {
    unsigned char* ws = P.ws;
    unsigned a0, a1, a2, a3; lin_offsets(threadIdx.x, DM * 2, a0, a1, a2, a3);
    for (int L = blockIdx.x; L < 64 * 8; L += gridDim.x) {
        int pm, pn; tile_order(L, 64, 8, pm, pn);
        EpiOut E{xold, xnew, xb, xb8, pm * 256, pn * 256};
        gemm256<true, false>(lds, (const char*)(ws + WS_OATT) + (size_t)pm * 256 * DM * 2, (const char*)(ws + wsW) + (size_t)pn * 256 * DM * 2, DM * 2, 256u, DM / 64, a0, a1, a2, a3, E);
    }
}
__device__ __forceinline__ void phase_kvq(const Params& P, unsigned char* lds) {
    unsigned char* ws = P.ws;
    unsigned a0, a1, a2, a3; lin_offsets(threadIdx.x, DM * 2, a0, a1, a2, a3);
    for (int L = blockIdx.x; L < 64 * 12; L += gridDim.x) {
        int pm, pn; tile_order(L, 64, 12, pm, pn);
        EpiKVQ E{(bf16_t*)(ws + WS_KV2), (bf16_t*)(ws + WS_Q), (const float*)(ws + WS_RSTD) + NTOK, pm * 256, pn};
        gemm256<true, false>(lds, (const char*)(ws + WS_XBA) + (size_t)pm * 256 * DM * 2, (const char*)(ws + WS_WKVQ) + (size_t)pn * 256 * DM * 2, DM * 2, 256u, DM / 64, a0, a1, a2, a3, E);
    }
    const int wave = threadIdx.x >> 6, lane = threadIdx.x & 63;
    for (int gw = blockIdx.x * 8 + wave; gw < 128; gw += gridDim.x * 8) {
        const int b = gw >> 4, h = gw & 15;
        const float* lf = (const float*)(ws + WS_LOGF) + ((size_t)b * SEQ + lane * 32) * 16 + h;
        float v[32]; float s = 0.f;
#pragma unroll
        for (int i = 0; i < 32; ++i) { s += lf[i * 16]; v[i] = s; }
        float incl = s;
#pragma unroll
        for (int o = 1; o < 64; o <<= 1) { const float t = __shfl_up(incl, o); if (lane >= o) incl += t; }
        const float excl = incl - s;
        float* c2 = (float*)(ws + WS_C2) + ((size_t)b * 16 + h) * SEQ + lane * 32;
#pragma unroll
        for (int i = 0; i < 32; ++i) c2[i] = (excl + v[i]) * LOG2E;
    }
}
__device__ __forceinline__ void moe_table(const unsigned* gcnt, int* tl  ) {
    if (threadIdx.x == 0) { int s = 0; for (int e = 0; e < 32; ++e) { const int c = (int)__hip_atomic_load(gcnt + e * 64, __ATOMIC_RELAXED, __HIP_MEMORY_SCOPE_AGENT); tl[40 + e] = c; tl[e] = s; s += (c + 255) >> 8; } tl[32] = s; }
    __syncthreads();
}
template <bool FP8>
__device__ __forceinline__ void phase_moe_gu(const Params& P, unsigned char* lds, int layer) {
    unsigned char* ws = P.ws;
    int* tl = (int*)(lds + 131072);
    moe_table((const unsigned*)(ws + WS_CTL) + CW_CNT + layer * 32 * 64, tl);
    const int ntiles = tl[32];
    int R0, C; stage_rc(threadIdx.x * 16, R0, C);
    const float* rstd = (const float*)(ws + WS_RSTD) + (layer ? 2 * NTOK : 0);
    constexpr unsigned EB = FP8 ? 1u : 2u;
    const char* xb = FP8 ? (const char*)(ws + WS_XB8) : (const char*)(ws + WS_XBB);
    for (int u = blockIdx.x; u < ntiles * 8; u += gridDim.x) {
        const int ti = u >> 3, pn = u & 7;
        int e = 0;
        for (int q = 1; q < 32; ++q) if (tl[q] <= ti) e = q;
        e = __builtin_amdgcn_readfirstlane(e);
        const int mt = __builtin_amdgcn_readfirstlane(ti - tl[e]), nvalid = __builtin_amdgcn_readfirstlane(min(256, tl[40 + e] - mt * 256));
        const int* list = (const int*)(ws + WS_LIST) + ((size_t)(layer * 32 + e) * LISTCAP + mt * 256);
        unsigned ao[4];
#pragma unroll
        for (int q = 0; q < 4; ++q) { const int lr = R0 + 64 * q; const int tok = (lr < nvalid) ? (list[lr] >> 1) : 0; ao[q] = (unsigned)tok * (DM * EB) + C * 2; }
        EpiGU<FP8> E{(void*)(ws + WS_H), list, rstd, ti * 256, pn, nvalid};
        gemm256<true, FP8>(lds, xb, (const char*)(ws + WS_GU) + (size_t)layer * 32 * 2048 * 2048 * 2 + ((size_t)e * 2048 + pn * 256) * DM * EB, DM * EB, 256u, DM * EB / 128, ao[0], ao[1], ao[2], ao[3], E);
    }
}
template <bool FP8>
__device__ __forceinline__ void phase_moe_dn(const Params& P, unsigned char* lds, int layer) {
    unsigned char* ws = P.ws;
    int* tl = (int*)(lds + 131072);
    moe_table((const unsigned*)(ws + WS_CTL) + CW_CNT + layer * 32 * 64, tl);
    const int ntiles = tl[32];
    constexpr unsigned EB = FP8 ? 1u : 2u;
    unsigned a0, a1, a2, a3; lin_offsets(threadIdx.x, DEXP * EB, a0, a1, a2, a3);
    for (int u = blockIdx.x; u < ntiles * 8; u += gridDim.x) {
        const int ti = u >> 3, pn = u & 7;
        int e = 0;
        for (int q = 1; q < 32; ++q) if (tl[q] <= ti) e = q;
        e = __builtin_amdgcn_readfirstlane(e);
        const int mt = __builtin_amdgcn_readfirstlane(ti - tl[e]), nvalid = __builtin_amdgcn_readfirstlane(min(256, tl[40 + e] - mt * 256));
        const int* list = (const int*)(ws + WS_LIST) + ((size_t)(layer * 32 + e) * LISTCAP + mt * 256);
        EpiDN E{(bf16_t*)(ws + WS_Y), list, pn, nvalid, FP8 ? W8_INV : 1.f};
        gemm256<true, FP8>(lds, (const char*)(ws + WS_H) + (size_t)ti * 256 * DEXP * EB, (const char*)(ws + WS_DN) + (size_t)layer * 32 * 2048 * 1024 * 2 + ((size_t)e * 2048 + pn * 256) * DEXP * EB,
                           DEXP * EB, 256u, DEXP * EB / 128, a0, a1, a2, a3, E);
    }
}


constexpr int AT_V = 0, AT_K = 32768, AT_KB = 65536, AT_WS = 67584, AT_IMP = 69632, AT_VALS = 136192, AT_SEL = 144640;
#define KSWZ(row, colB) ((row) * 256 + ((colB) ^ (((row) & 7) << 4)))
__device__ __forceinline__ int v_st(int k, int c) { const int kk = (k & ~0xC) | ((k & 4) << 1) | ((k & 8) >> 1); return ((kk >> 3) * 4 + (c >> 5)) * 512 + ((kk & 7) * 32 + (c & 31)) * 2; }
__device__ __forceinline__ int v_rd_base(int lane) { return ((lane & 3) << 3) | (((lane >> 2) & 3) << 6) | (((lane >> 4) & 1) << 5) | (((lane >> 5) & 1) << 8); }
constexpr int v_rd_off(int d0, int ks, int half) { return d0 * 512 + ks * 4096 + half * 2048; }
__device__ __forceinline__ int crow(int r, int hi) { return (r & 3) + 8 * (r >> 2) + 4 * hi; }

template <int KB>
__device__ __forceinline__ void attn_qkt(f32x16& p0, f32x16& p1, const char* K_lds, int r32, int hi, const bf16x8 (&qr)[8]) {
    p0 = f32x16{}; p1 = f32x16{};
    const char* kb[4];
#pragma unroll
    for (int dd = 0; dd < 4; ++dd) kb[dd] = K_lds + KB * 16384 + KSWZ(r32, (dd * 16 + hi * 8) * 2);
#pragma unroll
    for (int d0 = 0; d0 < 8; ++d0) { const char* a = kb[d0 & 3] + (d0 >> 2) * 128;
        bf16x8 b0 = *reinterpret_cast<const bf16x8*>(a);
        bf16x8 b1 = *reinterpret_cast<const bf16x8*>(a + 32 * 256);
        p0 = __builtin_amdgcn_mfma_f32_32x32x16_bf16(b0, qr[d0], p0, 0, 0, 0);
        p1 = __builtin_amdgcn_mfma_f32_32x32x16_bf16(b1, qr[d0], p1, 0, 0, 0); }
}
template <int VB>
__device__ __forceinline__ void attn_pv(f32x16 (&o)[4], int vb0, bf16x8 pa0, bf16x8 pa1, bf16x8 pa2, bf16x8 pa3) {
#define TRRD(dst, off) asm volatile("ds_read_b64_tr_b16 %0, %1 offset:%2" : "=&v"(dst) : "v"(vb0), "i"(off) : "memory")
#define PV_D0(d0) do { s16x4 l0, l1, l2, l3, h0, h1, h2, h3; constexpr int b_ = VB * 16384 + v_rd_off(d0, 0, 0); \
        TRRD(l0, b_); TRRD(h0, b_ + 2048); TRRD(l1, b_ + 4096); TRRD(h1, b_ + 6144); TRRD(l2, b_ + 8192); TRRD(h2, b_ + 10240); TRRD(l3, b_ + 12288); TRRD(h3, b_ + 14336); \
        asm volatile("s_waitcnt lgkmcnt(0)" ::: "memory"); __builtin_amdgcn_sched_barrier(0); \
        o[d0] = __builtin_amdgcn_mfma_f32_32x32x16_bf16(pa0, (bf16x8){l0[0], l0[1], l0[2], l0[3], h0[0], h0[1], h0[2], h0[3]}, o[d0], 0, 0, 0); \
        o[d0] = __builtin_amdgcn_mfma_f32_32x32x16_bf16(pa1, (bf16x8){l1[0], l1[1], l1[2], l1[3], h1[0], h1[1], h1[2], h1[3]}, o[d0], 0, 0, 0); \
        o[d0] = __builtin_amdgcn_mfma_f32_32x32x16_bf16(pa2, (bf16x8){l2[0], l2[1], l2[2], l2[3], h2[0], h2[1], h2[2], h2[3]}, o[d0], 0, 0, 0); \
        o[d0] = __builtin_amdgcn_mfma_f32_32x32x16_bf16(pa3, (bf16x8){l3[0], l3[1], l3[2], l3[3], h3[0], h3[1], h3[2], h3[3]}, o[d0], 0, 0, 0); } while (0)
    PV_D0(0); PV_D0(1); PV_D0(2); PV_D0(3);
#undef PV_D0
#undef TRRD
}
#define PK4(P, B_, OUT) do { unsigned a0 = cvtpk(P[B_+0], P[B_+1]), a1 = cvtpk(P[B_+2], P[B_+3]); \
        unsigned b0 = cvtpk(P[B_+4], P[B_+5]), b1 = cvtpk(P[B_+6], P[B_+7]); \
        auto r0 = __builtin_amdgcn_permlane32_swap(a0, b0, false, false); auto r1 = __builtin_amdgcn_permlane32_swap(a1, b1, false, false); \
        u32x4 w = {r0[0], r1[0], r0[1], r1[1]}; OUT = *reinterpret_cast<bf16x8*>(&w); } while (0)
__device__ __forceinline__ float row_max2(float v) { auto rr = __builtin_amdgcn_permlane32_swap(__float_as_uint(v), __float_as_uint(v), false, false); return fmaxf(__uint_as_float(rr[0]), __uint_as_float(rr[1])); }
__device__ __forceinline__ float row_sum2(float v) { auto rr = __builtin_amdgcn_permlane32_swap(__float_as_uint(v), __float_as_uint(v), false, false); return __uint_as_float(rr[0]) + __uint_as_float(rr[1]); }

struct KVAddr { unsigned ldsw, ldsb, voffK, voffV, ldb; };
__device__ __forceinline__ KVAddr kv_addr(const char* lds, int tid, int wave, unsigned ldb) {
    KVAddr A; A.ldsb = lds_addr(lds); A.ldsw = A.ldsb + (unsigned)wave * 1024u; A.ldb = ldb;
    const int row = tid >> 4, cp = tid & 15;
    A.voffK = (unsigned)row * ldb + (unsigned)((cp ^ (row & 7)) * 16);
    const int k = ((tid >> 2) & 3) | (((tid >> 7) & 1) << 2) | (((tid >> 4) & 1) << 3) | (((tid >> 8) & 1) << 4);
    const int c = ((tid >> 5) & 3) * 32 + (tid & 3) * 8;
    A.voffV = (unsigned)k * ldb + (unsigned)c * 2u;
    return A;
}
template <int BUF>
__device__ __forceinline__ void kv_issue(const KVAddr& A, const bf16_t* Kp, const bf16_t* Vp, int key0, const float* ctab, int wave, int lane) {
    const char* kb = (const char*)Kp + (size_t)key0 * A.ldb; const char* vb = (const char*)Vp + (size_t)key0 * A.ldb;
    glds16(A.voffK, kb, A.ldsw + AT_K + BUF * 16384); glds16(A.voffK, kb + (size_t)32 * A.ldb, A.ldsw + AT_K + BUF * 16384 + 8192);
    glds16(A.voffV, vb, A.ldsw + AT_V + BUF * 16384); glds16(A.voffV, vb + (size_t)32 * A.ldb, A.ldsw + AT_V + BUF * 16384 + 8192);
    if (ctab != nullptr && wave < 4) glds4((unsigned)lane * 4u, ctab + (size_t)wave * SEQ + key0, A.ldsb + AT_KB + BUF * 1024 + (unsigned)wave * 256u);
}
template <int BUF>
__device__ __forceinline__ void kb_alibi(char* lds, int tid, float sl2_t, int key0) {
    if (tid < 256) ((float*)(lds + AT_KB))[BUF * 256 + tid] = -sl2_t * (float)(key0 + (tid & 63));
}
template <int BUF>
__device__ __forceinline__ void attn_tile(char* lds, const bf16x8 (&qr)[8], f32x16 (&o)[4], float& m_reg, float& l_reg, float rb, int dq, unsigned W,
                                          bool needmask, int wave, int r32, int hi, int vb0) {
    f32x16 p0, p1;
    attn_qkt<BUF>(p0, p1, lds + AT_K, r32, hi, qr);
    const float NEG = -__builtin_inff();
    {
        const float* kbp = (const float*)(lds + AT_KB) + BUF * 256 + (wave & 3) * 64 + 4 * hi;
#pragma unroll
        for (int g2 = 0; g2 < 4; ++g2) {
            const f32x4 ka = *(const f32x4*)(kbp + 8 * g2), kc = *(const f32x4*)(kbp + 32 + 8 * g2);
#pragma unroll
            for (int i = 0; i < 4; ++i) { p0[4 * g2 + i] = fmaf(p0[4 * g2 + i], LOG2E, rb - ka[i]); p1[4 * g2 + i] = fmaf(p1[4 * g2 + i], LOG2E, rb - kc[i]); }
        }
    }
    if (needmask) {
#pragma unroll
        for (int r = 0; r < 16; ++r) { const int c = (r & 3) + 8 * (r >> 2);
            if ((unsigned)(dq - c) >= W) p0[r] = NEG;
            if ((unsigned)(dq - c - 32) >= W) p1[r] = NEG; }
    }
    float pmax = p0[0];
#pragma unroll
    for (int r = 1; r < 16; ++r) pmax = fmaxf(pmax, p0[r]);
#pragma unroll
    for (int r = 0; r < 16; ++r) pmax = fmaxf(pmax, p1[r]);
    pmax = row_max2(pmax);
    const float mn = fmaxf(m_reg, pmax), alpha = fast_exp2(m_reg - mn);
    m_reg = mn;
    float ps = 0.f;
#pragma unroll
    for (int r = 0; r < 16; ++r) { p0[r] = fast_exp2(p0[r] - mn); ps += p0[r]; }
#pragma unroll
    for (int r = 0; r < 16; ++r) { p1[r] = fast_exp2(p1[r] - mn); ps += p1[r]; }
    ps = row_sum2(ps);
    l_reg = l_reg * alpha + ps;
    if (__any(alpha < 1.f)) {
        float* al = (float*)(lds + AT_WS) + wave * 64;
        if (hi == 0) al[r32] = alpha;
        asm volatile("s_waitcnt lgkmcnt(0)" ::: "memory");
#pragma unroll
        for (int g2 = 0; g2 < 4; ++g2) { const f32x4 a4 = *(const f32x4*)(al + 8 * g2 + 4 * hi);
#pragma unroll
            for (int d0 = 0; d0 < 4; ++d0)
#pragma unroll
                for (int i = 0; i < 4; ++i) o[d0][4 * g2 + i] *= a4[i]; }
    }
    bf16x8 pa0, pa1, pa2, pa3;
    PK4(p0, 0, pa0); PK4(p0, 8, pa1); PK4(p1, 0, pa2); PK4(p1, 8, pa3);
    attn_pv<BUF>(o, vb0, pa0, pa1, pa2, pa3);
}
template <bool SELB>
__device__ __forceinline__ void attn_branch(char* lds, const KVAddr& A, const bf16x8 (&qr)[8], f32x16 (&o)[4], float& m_reg, float& l_reg, unsigned tilemask,
                                            const bf16_t* Kp, const bf16_t* Vp, const float* ctab, float sl2_t, float rowb, unsigned selw,
                                            int tq, int tq0w, unsigned W, int wave, int lane, int r32, int hi, int vb0) {
    const int tid = wave * 64 + lane;
    unsigned tm = tilemask;
    int j = 31 - __builtin_clz(tm); tm &= ~(1u << j);
    kv_issue<0>(A, Kp, Vp, j * 64, ctab, wave, lane);
    if (ctab == nullptr) kb_alibi<0>(lds, tid, sl2_t, j * 64);
    const float NEG = -__builtin_inff();
#define ATT_STEP(BUF, NBUF) { \
        asm volatile("s_waitcnt vmcnt(0)" ::: "memory"); \
        __syncthreads(); \
        int jn = -1; if (tm) { jn = 31 - __builtin_clz(tm); tm &= ~(1u << jn); kv_issue<NBUF>(A, Kp, Vp, jn * 64, ctab, wave, lane); if (ctab == nullptr) kb_alibi<NBUF>(lds, tid, sl2_t, jn * 64); } \
        { const int key0 = j * 64; \
          const bool rsel = SELB ? (((selw >> j) & 1u) != 0u) : true; \
          bool active = (key0 <= tq0w + 31) && ((tq0w - key0 - 63) < (int)W); \
          if (SELB) active = active && __any(rsel); \
          if (active) { \
              const bool needmask = (key0 + 63 > tq0w) || ((unsigned)(tq0w + 31 - key0) >= W); \
              attn_tile<BUF>(lds, qr, o, m_reg, l_reg, rsel ? rowb : NEG, tq - key0 - 4 * hi, W, needmask, wave, r32, hi, vb0); } } \
        if (jn < 0) break; \
        j = jn; }
    for (;;) { ATT_STEP(0, 1) ATT_STEP(1, 0) }
#undef ATT_STEP
    __syncthreads();
}
template <bool ADD>
__device__ __forceinline__ void attn_store(bf16_t* Obase  , const f32x16 (&o)[4], char* lds, float srow, int wave, int r32, int hi) {
    float* sc = (float*)(lds + AT_WS) + wave * 64 + 32;
    if (hi == 0) sc[r32] = srow;
    asm volatile("s_waitcnt lgkmcnt(0)" ::: "memory");
#pragma unroll
    for (int g2 = 0; g2 < 4; ++g2) { const f32x4 s4 = *(const f32x4*)(sc + 8 * g2 + 4 * hi);
#pragma unroll
        for (int i = 0; i < 4; ++i) { const int r = 4 * g2 + i; const int orow = crow(r, hi);
#pragma unroll
            for (int d0 = 0; d0 < 4; ++d0) {
                float v = o[d0][r] * s4[i];
                float vn = __shfl_xor(v, 1);
                if ((r32 & 1) == 0) { unsigned* p = (unsigned*)(Obase + (size_t)orow * DM + d0 * 32 + r32);
                    if (ADD) { const unsigned old = *p; v += bflo(old); vn += bfhi(old); }
                    *p = cvtpk(v, vn); } } } }
}

__device__ __forceinline__ void nsa_unit(const Params& P, char* lds, int b, int g, int qt) {
    unsigned char* ws = P.ws;
    int tid = threadIdx.x; asm volatile("" : "+v"(tid));
    const int wave = __builtin_amdgcn_readfirstlane(tid >> 6), lane = tid & 63, r32 = lane & 31, hi = lane >> 5;
    const int head = wave & 3, h = g * 4 + head, tq0w = qt * 64 + (wave >> 2) * 32, tq = tq0w + r32;
    const int vb0 = (int)lds_addr(lds + AT_V) + v_rd_base(lane);
    const bf16_t* Qg = (const bf16_t*)(ws + WS_Q); const bf16_t* KV6 = (const bf16_t*)(ws + WS_KV6);
    const size_t tokrow = (size_t)b * SEQ + tq;
    bf16x8 qr[8];
#pragma unroll
    for (int d0 = 0; d0 < 8; ++d0) qr[d0] = *(const bf16x8*)(Qg + tokrow * DM + h * 128 + d0 * 16 + hi * 8);
    const float* gp = (const float*)(ws + WS_GATES) + tokrow * 48 + h * 3;
    const float sl2 = fast_exp2(-0.5f * (float)(h + 1)) * LOG2E;
    const float sl2_t = fast_exp2(-0.5f * (float)(g * 4 + ((tid >> 6) & 3) + 1)) * LOG2E;
    const float rowb = -sl2 * (float)tq;
    const float NEG = -__builtin_inff();
    bf16_t* Ob = (bf16_t*)(ws + WS_OATT) + ((size_t)b * SEQ + tq0w) * DM + h * 128;
    f32x16 o[4];
    {
        const KVAddr A = kv_addr(lds, tid, wave, 512 * 2);
        const bf16_t* Kc = (const bf16_t*)(ws + WS_KVCMP) + (size_t)b * 128 * 512 + g * 128;
        const bf16_t* Vc = Kc + (size_t)8 * 128 * 512;
        kv_issue<0>(A, Kc, Vc, 0, nullptr, wave, lane);
        kv_issue<1>(A, Kc, Vc, 64, nullptr, wave, lane);
        asm volatile("s_waitcnt vmcnt(0)" ::: "memory");
        __syncthreads();
        f32x16 p0, p1, p2, p3;
        attn_qkt<0>(p0, p1, lds + AT_K, r32, hi, qr);
        attn_qkt<1>(p2, p3, lds + AT_K, r32, hi, qr);
        const int lim = tq - 64 * hi; const float sb = -sl2 * (float)lim;
        float pmax = NEG;
#define CMP_BIAS(PX, N0) _Pragma("unroll") for (int r = 0; r < 16; ++r) { const int kc_ = 16 * ((N0) + (r & 3) + 8 * (r >> 2)) + 31; \
            const float v = fmaf(PX[r], LOG2E, fmaf(sl2, (float)kc_, sb)); PX[r] = (kc_ <= lim) ? v : NEG; pmax = fmaxf(pmax, PX[r]); }
        CMP_BIAS(p0, 0) CMP_BIAS(p1, 32) CMP_BIAS(p2, 64) CMP_BIAS(p3, 96)
#undef CMP_BIAS
        pmax = row_max2(pmax);
        const float mn = fmaxf(pmax, -1e30f);
        float ps = 0.f;
#pragma unroll
        for (int r = 0; r < 16; ++r) { p0[r] = fast_exp2(p0[r] - mn); p1[r] = fast_exp2(p1[r] - mn); p2[r] = fast_exp2(p2[r] - mn); p3[r] = fast_exp2(p3[r] - mn); ps += (p0[r] + p1[r]) + (p2[r] + p3[r]); }
        ps = row_sum2(ps);
        const float invl = ps > 0.f ? 1.f / ps : 0.f;
        {
            float* ia = (float*)(lds + AT_IMP) + (head * 64 + (wave >> 2) * 32 + r32) * 65;
#define IMP_W(PX, J0) _Pragma("unroll") for (int g2 = 0; g2 < 4; ++g2) { const int jj = (J0) + 2 * g2 + hi; const float hb = 0.5f * PX[4 * g2 + 3] * invl; \
            ia[jj] = (PX[4 * g2] + PX[4 * g2 + 1] + PX[4 * g2 + 2]) * invl + hb; ia[32 + jj + 1] = hb; }
            IMP_W(p0, 0) IMP_W(p1, 8) IMP_W(p2, 16) IMP_W(p3, 24)
#undef IMP_W
            if (hi == 0) ia[32] = 0.f;
        }
#pragma unroll
        for (int d0 = 0; d0 < 4; ++d0) o[d0] = f32x16{};
        bf16x8 pa0, pa1, pa2, pa3;
        PK4(p0, 0, pa0); PK4(p0, 8, pa1); PK4(p1, 0, pa2); PK4(p1, 8, pa3);
        attn_pv<0>(o, vb0, pa0, pa1, pa2, pa3);
        PK4(p2, 0, pa0); PK4(p2, 8, pa1); PK4(p3, 0, pa2); PK4(p3, 8, pa3);
        attn_pv<1>(o, vb0, pa0, pa1, pa2, pa3);
        attn_store<false>(Ob, o, lds, gp[0] * invl, wave, r32, hi);
    }
    __syncthreads();
    {
        const float* ia = (const float*)(lds + AT_IMP);
        float* vals = (float*)(lds + AT_VALS);
        unsigned* selm = (unsigned*)(lds + AT_SEL);
        const int jb = tid & 31;
        float myv[4];
#pragma unroll
        for (int pass = 0; pass < 4; ++pass) {
            const int tokl = (tid >> 5) + 16 * pass;
            float v = 0.f;
#pragma unroll
            for (int hh = 0; hh < 4; ++hh) { const float* q = ia + (hh * 64 + tokl) * 65; v += q[jb] + q[32 + jb]; }
            const bool forced = (jb == 0) || (jb == qt) || (jb == qt - 1);
            v = (jb > qt) ? NEG : (forced ? __builtin_inff() : v);
            vals[tokl * 33 + jb] = v; myv[pass] = v;
        }
        __syncthreads();
#pragma unroll
        for (int pass = 0; pass < 4; ++pass) {
            const int tokl = (tid >> 5) + 16 * pass;
            const float v = myv[pass]; int rank = 0;
#pragma unroll 8
            for (int i = 0; i < 32; ++i) { const float vi = vals[tokl * 33 + i]; rank += (vi > v || (vi == v && i < jb)) ? 1 : 0; }
            const unsigned long long bal = __ballot(rank < 16);
            if ((lane & 31) == 0) selm[tokl] = (lane < 32) ? (unsigned)bal : (unsigned)(bal >> 32);
        }
        __syncthreads();
        if (tid < 64) { unsigned mk = selm[tid];
#pragma unroll
            for (int of = 32; of >= 1; of >>= 1) mk |= __shfl_xor(mk, of);
            if (tid == 0) selm[64] = mk; }
        __syncthreads();
    }
    const unsigned causal_bits = (qt >= 31) ? 0xffffffffu : ((2u << qt) - 1u);
    const unsigned selw = ((const unsigned*)(lds + AT_SEL))[(wave >> 2) * 32 + r32];
    const unsigned um = ((const unsigned*)(lds + AT_SEL))[64] & causal_bits;
    const KVAddr A = kv_addr(lds, tid, wave, KV6_W * 2);
    {
#pragma unroll
        for (int d0 = 0; d0 < 4; ++d0) o[d0] = f32x16{};
        float m_reg = -1e30f, l_reg = 0.f;
        const bf16_t* Kp = KV6 + (size_t)b * SEQ * KV6_W + 2 * 512 + g * 128;
        attn_branch<true>(lds, A, qr, o, m_reg, l_reg, um, Kp, Kp + 512, nullptr, sl2_t, rowb, selw, tq, tq0w, 1u << 30, wave, lane, r32, hi, vb0);
        attn_store<true>(Ob, o, lds, l_reg > 0.f ? gp[1] / l_reg : 0.f, wave, r32, hi);
    }
    {
#pragma unroll
        for (int d0 = 0; d0 < 4; ++d0) o[d0] = f32x16{};
        float m_reg = -1e30f, l_reg = 0.f;
        const bf16_t* Kp = KV6 + (size_t)b * SEQ * KV6_W + 4 * 512 + g * 128;
        const unsigned wmask = causal_bits & ~((qt > 8) ? ((1u << (qt - 8)) - 1u) : 0u);
        attn_branch<false>(lds, A, qr, o, m_reg, l_reg, wmask, Kp, Kp + 512, nullptr, sl2_t, rowb, 0u, tq, tq0w, 512u, wave, lane, r32, hi, vb0);
        attn_store<true>(Ob, o, lds, l_reg > 0.f ? gp[2] / l_reg : 0.f, wave, r32, hi);
    }
}
__device__ __forceinline__ void fox_unit(const Params& P, char* lds, int b, int kvh, int qt) {
    unsigned char* ws = P.ws;
    int tid = threadIdx.x; asm volatile("" : "+v"(tid));
    const int wave = __builtin_amdgcn_readfirstlane(tid >> 6), lane = tid & 63, r32 = lane & 31, hi = lane >> 5;
    const int head = wave & 3, h = kvh * 4 + head, tq0w = qt * 64 + (wave >> 2) * 32, tq = tq0w + r32;
    const int vb0 = (int)lds_addr(lds + AT_V) + v_rd_base(lane);
    const bf16_t* Qg = (const bf16_t*)(ws + WS_Q);
    const size_t tokrow = (size_t)b * SEQ + tq;
    bf16x8 qr[8];
#pragma unroll
    for (int d0 = 0; d0 < 8; ++d0) qr[d0] = *(const bf16x8*)(Qg + tokrow * DM + h * 128 + d0 * 16 + hi * 8);
    const float* ctab = (const float*)(ws + WS_C2) + ((size_t)b * 16 + kvh * 4) * SEQ;
    const float rowb = ctab[head * SEQ + tq];
    f32x16 o[4];
#pragma unroll
    for (int d0 = 0; d0 < 4; ++d0) o[d0] = f32x16{};
    float m_reg = -1e30f, l_reg = 0.f;
    const bf16_t* Kp = (const bf16_t*)(ws + WS_KV2) + (size_t)b * SEQ * 1024 + kvh * 128;
    const unsigned causal_bits = (qt >= 31) ? 0xffffffffu : ((2u << qt) - 1u);
    const KVAddr A = kv_addr(lds, tid, wave, 1024 * 2);
    attn_branch<false>(lds, A, qr, o, m_reg, l_reg, causal_bits, Kp, Kp + 512, ctab, 0.f, rowb, 0u, tq, tq0w, 1u << 30, wave, lane, r32, hi, vb0);
    bf16_t* Ob = (bf16_t*)(ws + WS_OATT) + ((size_t)b * SEQ + tq0w) * DM + h * 128;
    attn_store<false>(Ob, o, lds, l_reg > 0.f ? 1.f / l_reg : 0.f, wave, r32, hi);
}
__device__ __forceinline__ void attn_unit_decode(int u, int& b, int& g, int& qt) {
    const int rnd = u >> 8, c = u & 255, k = c >> 5, j = c & 31;
    b = j >> 2; g = j & 3;
    qt = (rnd == 0) ? 31 - k : (rnd == 1) ? 16 + k : (rnd == 2) ? 15 - k : k;
}

__device__ __forceinline__ void rowgemm64(const float* X, int row0, const float* W, float* part, float* ssp) {
    const int tid = threadIdx.x, wave = tid >> 6, lane = tid & 63, m = lane & 31, jh = lane >> 5;
    const int rgrp = wave & 1, kq = wave >> 1;
    const float* xr = X + (size_t)(row0 + rgrp * 32 + m) * DM + kq * 512 + 4 * jh;
    const float* wp = W + (size_t)(kq * 512 + 4 * jh) * 32 + m;
    f32x16 acc = {};
    float ss = 0.f;
#pragma unroll 4
    for (int i = 0; i < 64; ++i) {
        const f32x4 xv = *(const f32x4*)(xr + 8 * i);
        const float w0 = wp[(8 * i + 0) * 32], w1 = wp[(8 * i + 1) * 32], w2 = wp[(8 * i + 2) * 32], w3 = wp[(8 * i + 3) * 32];
        acc = __builtin_amdgcn_mfma_f32_32x32x2f32(xv[0], w0, acc, 0, 0, 0);
        acc = __builtin_amdgcn_mfma_f32_32x32x2f32(xv[1], w1, acc, 0, 0, 0);
        acc = __builtin_amdgcn_mfma_f32_32x32x2f32(xv[2], w2, acc, 0, 0, 0);
        acc = __builtin_amdgcn_mfma_f32_32x32x2f32(xv[3], w3, acc, 0, 0, 0);
        ss += xv[0] * xv[0] + xv[1] * xv[1] + xv[2] * xv[2] + xv[3] * xv[3];
    }
    float* pw = part + wave * (32 * 33);
#pragma unroll
    for (int r = 0; r < 16; ++r) pw[crow(r, jh) * 33 + m] = acc[r];
    ss += __shfl_xor(ss, 32);
    if (jh == 0) ssp[wave * 32 + m] = ss;
}
__device__ __forceinline__ void phase_router(const Params& P, unsigned char* lds, int layer) {
    unsigned char* ws = P.ws;
    const int tid = threadIdx.x;
    float* part = (float*)lds;
    float* ssp = (float*)(lds + 34816);
    float* lg = (float*)(lds + 36864);
    float* sl = (float*)(lds + 36864 + 8448);
    int* lcnt = (int*)(lds + 36864 + 2 * 8448);
    int* asg = lcnt + 64;
    const float* X = (const float*)(ws + WS_X1);
    const float* W = (const float*)(ws + WS_RW) + (size_t)layer * 2048 * 32;
    float* rstd_out = (float*)(ws + WS_RSTD) + (layer ? 2 * NTOK : 0);
    float* ew = (float*)(ws + WS_EW) + (size_t)layer * NTOK * 2;
    unsigned* gcnt = (unsigned*)(ws + WS_CTL) + CW_CNT + layer * 32 * 64;
    int* lists = (int*)(ws + WS_LIST) + (size_t)layer * 32 * LISTCAP;
    for (int rg = blockIdx.x; rg < NTOK / 64; rg += gridDim.x) {
        const int row0 = rg * 64;
        if (tid < 32) lcnt[tid] = 0;
        rowgemm64(X, row0, W, part, ssp);
        __syncthreads();
        if (tid < 64) {
            const int rgrp = tid >> 5, mloc = tid & 31;
            float ss = 0.f;
#pragma unroll
            for (int kq = 0; kq < 4; ++kq) ss += ssp[(kq * 2 + rgrp) * 32 + mloc];
            const float rstd = rsqrtf(ss * (1.f / DM) + RMS_EPS);
            rstd_out[row0 + tid] = rstd;
            float mx = -__builtin_inff();
            for (int e = 0; e < 32; ++e) {
                float d = 0.f;
#pragma unroll
                for (int kq = 0; kq < 4; ++kq) d += part[(kq * 2 + rgrp) * (32 * 33) + mloc * 33 + e];
                d *= rstd; lg[tid * 33 + e] = d; mx = fmaxf(mx, d);
            }
            float sum = 0.f;
            for (int e = 0; e < 32; ++e) { const float p = __expf(lg[tid * 33 + e] - mx); lg[tid * 33 + e] = p; sum += p; }
            const float inv = 1.f / sum;
            for (int e = 0; e < 32; ++e) { const float p = lg[tid * 33 + e] * inv; lg[tid * 33 + e] = p; sl[tid * 33 + e] = p + P.in[17][e]; }
            int bestg = 0; float bests = -__builtin_inff();
            for (int gq = 0; gq < 4; ++gq) {
                float t1 = -__builtin_inff(), t2 = -__builtin_inff();
                for (int i = 0; i < 8; ++i) { const float v = sl[tid * 33 + gq * 8 + i]; if (v > t1) { t2 = t1; t1 = v; } else if (v > t2) t2 = v; }
                const float sc = t1 + t2;
                if (sc > bests) { bests = sc; bestg = gq; }
            }
            int i1 = 0, i2 = 0; float v1 = -__builtin_inff(), v2 = -__builtin_inff();
            for (int i = 0; i < 8; ++i) { const float v = sl[tid * 33 + bestg * 8 + i]; if (v > v1) { v2 = v1; i2 = i1; v1 = v; i1 = i; } else if (v > v2) { v2 = v; i2 = i; } }
            const int e1 = bestg * 8 + i1, e2 = bestg * 8 + i2;
            const float p1 = lg[tid * 33 + e1], p2 = lg[tid * 33 + e2], ip = 1.f / (p1 + p2);
            ew[(size_t)(row0 + tid) * 2 + 0] = p1 * ip; ew[(size_t)(row0 + tid) * 2 + 1] = p2 * ip;
            asg[tid * 2 + 0] = e1; asg[tid * 2 + 1] = e2;
            asg[128 + tid * 2 + 0] = atomicAdd(&lcnt[e1], 1); asg[128 + tid * 2 + 1] = atomicAdd(&lcnt[e2], 1);
        }
        __syncthreads();
        if (tid < 32) { const int c = lcnt[tid]; lcnt[32 + tid] = c ? (int)__hip_atomic_fetch_add(gcnt + tid * 64, (unsigned)c, __ATOMIC_RELAXED, __HIP_MEMORY_SCOPE_AGENT) : 0; }
        __syncthreads();
        if (tid < 128) { const int e = asg[tid], pos = lcnt[32 + e] + asg[128 + tid]; if (pos < LISTCAP) lists[(size_t)e * LISTCAP + pos] = (row0 + (tid >> 1)) * 2 + (tid & 1); }
        __syncthreads();
    }
}
__device__ __forceinline__ void phase_combine0(const Params& P, unsigned char* lds) {
    unsigned char* ws = P.ws;
    const int tid = threadIdx.x, wave = tid >> 6, lane = tid & 63;
    float* part = (float*)lds; float* ssp = (float*)(lds + 34816); float* rs = (float*)(lds + 36864);
    const float* X1 = (const float*)(ws + WS_X1); float* X2 = (float*)(ws + WS_X2); bf16_t* XB = (bf16_t*)(ws + WS_XBA);
    const bf16_t* Y = (const bf16_t*)(ws + WS_Y); const float* ew = (const float*)(ws + WS_EW);
    float* rstd_out = (float*)(ws + WS_RSTD) + NTOK;
    for (int rg = blockIdx.x; rg < NTOK / 64; rg += gridDim.x) {
        const int row0 = rg * 64;
        for (int q = 0; q < 8; ++q) {
            const int row = row0 + wave * 8 + q;
            const float w0 = ew[(size_t)row * 2], w1 = ew[(size_t)row * 2 + 1];
            float ss = 0.f;
#pragma unroll
            for (int j = 0; j < 8; ++j) {
                const size_t off = (size_t)row * DM + j * 256 + lane * 4;
                f32x4 v = *(const f32x4*)(X1 + off);
                const u32x2 y0 = *(const u32x2*)(Y + (size_t)(2 * row) * DM + j * 256 + lane * 4), y1 = *(const u32x2*)(Y + (size_t)(2 * row + 1) * DM + j * 256 + lane * 4);
                v[0] += w0 * bflo(y0[0]) + w1 * bflo(y1[0]); v[1] += w0 * bfhi(y0[0]) + w1 * bfhi(y1[0]);
                v[2] += w0 * bflo(y0[1]) + w1 * bflo(y1[1]); v[3] += w0 * bfhi(y0[1]) + w1 * bfhi(y1[1]);
                *(f32x4*)(X2 + off) = v;
                u32x2 w = {cvtpk(v[0], v[1]), cvtpk(v[2], v[3])};
                *(u32x2*)(XB + off) = w;
                ss += v[0] * v[0] + v[1] * v[1] + v[2] * v[2] + v[3] * v[3];
            }
            ss = wave_sum(ss);
            const float rstd = rsqrtf(ss * (1.f / DM) + RMS_EPS);
            if (lane == 0) { rstd_out[row] = rstd; rs[wave * 8 + q] = rstd; }
        }
        asm volatile("s_waitcnt vmcnt(0)" ::: "memory");
        __syncthreads();
        rowgemm64(X2, row0, (const float*)(ws + WS_WF), part, ssp);
        __syncthreads();
        for (int i = tid; i < 64 * 16; i += NTHREADS) {
            const int r = i >> 4, j = i & 15, rgrp = r >> 5, mloc = r & 31;
            float d = 0.f;
#pragma unroll
            for (int kq = 0; kq < 4; ++kq) d += part[(kq * 2 + rgrp) * (32 * 33) + mloc * 33 + j];
            const float z = d * rs[r] + P.in[11][j];
            ((float*)(ws + WS_LOGF))[(size_t)(row0 + r) * 16 + j] = fminf(z, 0.f) - log1pf(__expf(-fabsf(z)));
        }
        __syncthreads();
    }
}
__device__ __forceinline__ void phase_final(const Params& P) {
    unsigned char* ws = P.ws;
    const int tid = threadIdx.x, wave = tid >> 6, lane = tid & 63;
    const float* X3 = (const float*)(ws + WS_X1); const bf16_t* Y = (const bf16_t*)(ws + WS_Y); const float* ew = (const float*)(ws + WS_EW) + (size_t)NTOK * 2;
    const float* gain = P.in[21];
    for (int row = blockIdx.x * 8 + wave; row < NTOK; row += gridDim.x * 8) {
        const float w0 = ew[(size_t)row * 2], w1 = ew[(size_t)row * 2 + 1];
        f32x4 v[8]; float ss = 0.f;
#pragma unroll
        for (int j = 0; j < 8; ++j) {
            const size_t off = (size_t)row * DM + j * 256 + lane * 4;
            v[j] = *(const f32x4*)(X3 + off);
            const u32x2 y0 = *(const u32x2*)(Y + (size_t)(2 * row) * DM + j * 256 + lane * 4), y1 = *(const u32x2*)(Y + (size_t)(2 * row + 1) * DM + j * 256 + lane * 4);
            v[j][0] += w0 * bflo(y0[0]) + w1 * bflo(y1[0]); v[j][1] += w0 * bfhi(y0[0]) + w1 * bfhi(y1[0]);
            v[j][2] += w0 * bflo(y0[1]) + w1 * bflo(y1[1]); v[j][3] += w0 * bfhi(y0[1]) + w1 * bfhi(y1[1]);
            ss += v[j][0] * v[j][0] + v[j][1] * v[j][1] + v[j][2] * v[j][2] + v[j][3] * v[j][3];
        }
        ss = wave_sum(ss);
        const float rstd = rsqrtf(ss * (1.f / DM) + RMS_EPS);
#pragma unroll
        for (int j = 0; j < 8; ++j) {
            const f32x4 gv = *(const f32x4*)(gain + j * 256 + lane * 4);
            *(f32x4*)(P.out + (size_t)row * DM + j * 256 + lane * 4) = v[j] * rstd * gv;
        }
    }
}

__global__ void __launch_bounds__(NTHREADS, 2) yoco_fwd(Params P) {
    extern __shared__ __attribute__((aligned(16))) unsigned char lds[];
    unsigned char* ws = P.ws;
    const int lo = P.ph_lo, hi = P.ph_hi;
    XcdBarrier bar; bar.bar = (unsigned*)(ws + WS_CTL) + CW_BAR; bar.x = 0; bar.st = nullptr;
    const bool one = (hi - lo) > 1;
    if (one) {
        if (threadIdx.x < 4) ((unsigned*)(lds + LDS_BYTES - 16))[threadIdx.x] = 0u;
        __syncthreads();
        bar = xcd_barrier_post((unsigned*)(ws + WS_CTL) + CW_BAR, (volatile LAS unsigned*)(lds + LDS_BYTES - 16));
    }
#ifdef ONLY_PHASE
#define IN(k) ((k) == ONLY_PHASE && lo <= (k) && (k) < hi)
#else
#define IN(k) (lo <= (k) && (k) < hi)
#endif
#define SEAM(k) do { if (IN(k) && IN((k) + 1)) xcd_barrier(bar); } while (0)
#ifndef REP_MASK
#define REP_MASK 0
#endif
#define RUN(k, ...) do { if (IN(k)) { __VA_ARGS__; if ((REP_MASK >> (k)) & 1) { xcd_barrier(bar); __VA_ARGS__; } } SEAM(k); } while (0)
    RUN(0, { phase_convert(P, lds, 0, NJOBS); phase0_misc(P, lds); });
    RUN(1, phase_proj0(P, lds));
    RUN(2, phase_cmp1(P, lds));
    RUN(3, phase_cmp2(P, lds));
    RUN(4, { for (int u = blockIdx.x; u < 1024; u += gridDim.x) { int b, g, qt; attn_unit_decode(u, b, g, qt); nsa_unit(P, (char*)lds, b, g, qt); } });
    RUN(5, phase_outproj(P, lds, WS_WOUT, P.in[0], (float*)(ws + WS_X1), (bf16_t*)(ws + WS_XBB), kFp8[0] ? (unsigned char*)(ws + WS_XB8) : nullptr));
    RUN(6, phase_router(P, lds, 0));
    RUN(7, phase_moe_gu<kFp8[0]>(P, lds, 0));
    RUN(8, phase_moe_dn<kFp8[0]>(P, lds, 0));
    RUN(9, phase_combine0(P, lds));
    RUN(10, phase_kvq(P, lds));
    RUN(11, { for (int u = blockIdx.x; u < 1024; u += gridDim.x) { int b, g, qt; attn_unit_decode(u, b, g, qt); fox_unit(P, (char*)lds, b, g, qt); } });
    RUN(12, phase_outproj(P, lds, WS_WFO, (const float*)(ws + WS_X2), (float*)(ws + WS_X1), (bf16_t*)(ws + WS_XBB), kFp8[1] ? (unsigned char*)(ws + WS_XB8) : nullptr));
    RUN(13, phase_router(P, lds, 1));
    RUN(14, phase_moe_gu<kFp8[1]>(P, lds, 1));
    RUN(15, phase_moe_dn<kFp8[1]>(P, lds, 1));
    RUN(16, phase_final(P));
#undef RUN
#undef IN
#undef SEAM
}

}

extern "C" void kernel_launch(void* const* d_in, const int* in_sizes, int n_in, void* d_out, int out_size, void* d_ws, size_t ws_size, hipStream_t stream) {
    static int grid = 0;
    if (grid == 0) {
        if (n_in != 22 || in_sizes[0] != NTOK * DM || out_size != NTOK * DM || ws_size < WS_END) {
            fprintf(stderr, "kernel_launch: unexpected shapes (n_in %d, in0 %d, out %d, ws %zu < %zu)\n", n_in, n_in > 0 ? in_sizes[0] : -1, out_size, ws_size, (size_t)WS_END); grid = -1; return; }
        int dev = 0, cus = 0, per_cu = 0;
        (void)hipGetDevice(&dev); (void)hipDeviceGetAttribute(&cus, hipDeviceAttributeMultiprocessorCount, dev);
        if (hipFuncSetAttribute((const void*)yoco_fwd, hipFuncAttributeMaxDynamicSharedMemorySize, LDS_BYTES) != hipSuccess) { fprintf(stderr, "kernel_launch: hipFuncSetAttribute failed\n"); grid = -1; return; }
        if (hipOccupancyMaxActiveBlocksPerMultiprocessor(&per_cu, (const void*)yoco_fwd, NTHREADS, LDS_BYTES) != hipSuccess || per_cu < 1) { fprintf(stderr, "kernel_launch: occupancy query says %d\n", per_cu); }
        (void)hipGetLastError();
        grid = cus > 0 ? cus : 256;
    }
    if (grid < 0) return;
    (void)hipMemsetAsync((char*)d_ws + WS_CTL, 0, CTL_BYTES, stream);
    Params p{};
    for (int i = 0; i < 22; ++i) p.in[i] = (const float*)d_in[i];
    p.out = (float*)d_out; p.ws = (unsigned char*)d_ws;
#if MK_LAUNCHES == 1
    p.ph_lo = 0; p.ph_hi = NPHASES;
    hipLaunchKernelGGL(yoco_fwd, dim3(grid), dim3(NTHREADS), LDS_BYTES, stream, p);
#else
    for (int k = 0; k < NPHASES; ++k) { p.ph_lo = k; p.ph_hi = k + 1; hipLaunchKernelGGL(yoco_fwd, dim3(grid), dim3(NTHREADS), LDS_BYTES, stream, p); }
#endif
}
```

```cpp
#include <hip/hip_runtime.h>
#include <cstdint>
#include <cstdio>

#ifndef MK_LAUNCHES
#define MK_LAUNCHES 1
#endif

#ifndef FP8_L1
#define FP8_L1 1
#endif
#ifndef FP8_L0
#define FP8_L0 1
#endif
#ifndef FP8_PROJ
#define FP8_PROJ 1
#endif

namespace {

typedef unsigned short bf16_t;
typedef int v8i __attribute__((ext_vector_type(8)));
typedef int v4i __attribute__((ext_vector_type(4)));
typedef short bf16x8 __attribute__((ext_vector_type(8)));
typedef short s16x4 __attribute__((ext_vector_type(4)));
typedef float f32x4 __attribute__((ext_vector_type(4)));
typedef float f32x16 __attribute__((ext_vector_type(16)));
typedef unsigned u32x4 __attribute__((ext_vector_type(4)));
typedef unsigned u32x2 __attribute__((ext_vector_type(2)));

constexpr int NTOK = 16384, DM = 2048, SEQ = 2048, NBATCH = 8, NH = 16, HD = 128;
constexpr int NSA_IN_W = 5168, KV6_W = 3072, NEXP = 32, DEXP = 1024, LISTCAP = 32768;
constexpr int NTHREADS = 512;
constexpr float LOG2E = 1.4426950408889634f;
constexpr float QSCALE = 0.08838834764831845f;
constexpr float RMS_EPS = 1e-6f;
constexpr int LDS_BYTES = 147456;
constexpr int NPHASES = 17;
constexpr bool kFp8[2] = {FP8_L0 != 0, FP8_L1 != 0};
constexpr bool kFp8P = FP8_PROJ != 0;
constexpr float W8_SCALE = 64.f, W8_INV = 1.f / 64.f;

constexpr size_t al256(size_t x) { return (x + 255) & ~(size_t)255; }
constexpr size_t WS_CTL   = 0;
constexpr size_t CTL_BYTES = 131072;
constexpr size_t WS_WIN   = WS_CTL + CTL_BYTES;
constexpr size_t WS_CW1   = WS_WIN + (size_t)5376 * 2048 * 2;
constexpr size_t WS_WOUT  = WS_CW1 + (size_t)2 * 256 * 4096 * 2;
constexpr size_t WS_WKVQ  = WS_WOUT + (size_t)2048 * 2048 * 2;
constexpr size_t WS_WFO   = WS_WKVQ + (size_t)3072 * 2048 * 2;
constexpr size_t WS_GU    = WS_WFO + (size_t)2048 * 2048 * 2;
constexpr size_t WS_DN    = WS_GU + (size_t)2 * 32 * 2048 * 2048 * 2;
constexpr size_t WS_BIAS1 = WS_DN + (size_t)2 * 32 * 2048 * 1024 * 2;
constexpr size_t WS_RW    = WS_BIAS1 + 2 * 32 * 256 * 4;
constexpr size_t WS_WF    = WS_RW + (size_t)2 * 2048 * 32 * 4;
constexpr size_t WS_XBA   = al256(WS_WF + (size_t)2048 * 32 * 4);
constexpr size_t WS_XBB   = WS_XBA + (size_t)NTOK * DM * 2;
constexpr size_t WS_Q     = WS_XBB + (size_t)NTOK * DM * 2;
constexpr size_t WS_KV6   = WS_Q + (size_t)NTOK * DM * 2;
constexpr size_t WS_GATES = WS_KV6 + (size_t)NTOK * KV6_W * 2;
constexpr size_t WS_CPART = WS_GATES + (size_t)NTOK * 48 * 4;
constexpr size_t WS_KVCMP = WS_CPART + (size_t)2 * 8 * 4096 * 256 * 4;
constexpr size_t WS_OATT  = WS_KVCMP + (size_t)2 * 8 * 128 * 512 * 2;
constexpr size_t WS_X1    = WS_OATT + (size_t)NTOK * DM * 2;
constexpr size_t WS_X2    = WS_X1 + (size_t)NTOK * DM * 4;
constexpr size_t WS_H     = WS_X2 + (size_t)NTOK * DM * 4;
constexpr size_t WS_Y     = WS_H + (size_t)40960 * 1024 * 2;
constexpr size_t WS_LIST  = WS_Y + (size_t)32768 * 2048 * 2;
constexpr size_t WS_EW    = WS_LIST + (size_t)2 * 32 * LISTCAP * 4;
constexpr size_t WS_RSTD  = WS_EW + (size_t)2 * NTOK * 2 * 4;
constexpr size_t WS_KV2   = WS_RSTD + (size_t)3 * NTOK * 4;
constexpr size_t WS_LOGF  = WS_KV2 + (size_t)NTOK * 1024 * 2;
constexpr size_t WS_C2    = WS_LOGF + (size_t)NTOK * 16 * 4;
constexpr size_t WS_XB8   = WS_C2 + (size_t)8 * 16 * 2048 * 4;
constexpr size_t WS_XA8   = WS_XB8 + (size_t)NTOK * DM;
constexpr size_t WS_END   = WS_XA8 + (size_t)NTOK * DM;
constexpr int CW_BAR = 0;
constexpr int CW_CNT = 4096;
constexpr int CW_HC  = CW_CNT + 2 * 32 * 64;
constexpr int CW_PC  = CW_HC + 2 * 160 * 16;
constexpr int CW_AC  = CW_PC + 2 * 64 * 16;
constexpr int CW_CC  = CW_AC + 2 * 64 * 16;
constexpr int CW_END = CW_CC + (64 + 8) * 16;
static_assert(CW_END * 4 <= (int)CTL_BYTES, "ctl");

struct Params {
    const float* in[22];
    float* out;
    unsigned char* ws;
    int ph_lo, ph_hi;
};

__device__ __forceinline__ unsigned cvtpk(float lo, float hi) {
    unsigned r; asm volatile("v_cvt_pk_bf16_f32 %0, %1, %2" : "=v"(r) : "v"(lo), "v"(hi)); return r;
}
__device__ __forceinline__ float bflo(unsigned w) { return __uint_as_float(w << 16); }
__device__ __forceinline__ float bfhi(unsigned w) { return __uint_as_float(w & 0xffff0000u); }
__device__ __forceinline__ bf16x8 pack8(f32x4 a, f32x4 b) {
    u32x4 w = {cvtpk(a[0], a[1]), cvtpk(a[2], a[3]), cvtpk(b[0], b[1]), cvtpk(b[2], b[3])};
    return *reinterpret_cast<bf16x8*>(&w);
}
__device__ __forceinline__ float wave_sum(float v) {
#pragma unroll
    for (int o = 32; o >= 1; o >>= 1) v += __shfl_xor(v, o);
    return v;
}
__device__ __forceinline__ float fast_exp2(float x) { return __builtin_amdgcn_exp2f(x); }
__device__ __forceinline__ float fast_rcp(float x) { return __builtin_amdgcn_rcpf(x); }

__device__ __forceinline__ const void* uniform_ptr(const void* p) {
    const unsigned long long a = (unsigned long long)p;
    const unsigned lo = __builtin_amdgcn_readfirstlane((unsigned)a), hi = __builtin_amdgcn_readfirstlane((unsigned)(a >> 32));
    return (const void*)(((unsigned long long)hi << 32) | lo);
}
__device__ __forceinline__ void glds16(unsigned voff, const void* sbase, unsigned ldsaddr) {
    unsigned keep; sbase = uniform_ptr(sbase); ldsaddr = __builtin_amdgcn_readfirstlane(ldsaddr);
    asm volatile("s_mov_b32 %0, m0\n\ts_mov_b32 m0, %3\n\ts_nop 0\n\tglobal_load_lds_dwordx4 %1, %2\n\ts_mov_b32 m0, %0"
                 : "=&s"(keep) : "v"(voff), "s"(sbase), "s"(ldsaddr) : "memory");
}
__device__ __forceinline__ void glds4(unsigned voff, const void* sbase, unsigned ldsaddr) {
    unsigned keep; sbase = uniform_ptr(sbase); ldsaddr = __builtin_amdgcn_readfirstlane(ldsaddr);
    asm volatile("s_mov_b32 %0, m0\n\ts_mov_b32 m0, %3\n\ts_nop 0\n\tglobal_load_lds_dword %1, %2\n\ts_mov_b32 m0, %0"
                 : "=&s"(keep) : "v"(voff), "s"(sbase), "s"(ldsaddr) : "memory");
}

#ifndef TIMER_MODE
#define TIMER_MODE 0
#endif
#ifndef TIMER_BLOCK
#define TIMER_BLOCK 0
#endif
#ifndef TIMER_PHASE
#define TIMER_PHASE -1
#endif
#define TIMER_LDS_OFF (LDS_BYTES - 32)
__device__ __forceinline__ unsigned long long rt_now() { return __builtin_amdgcn_s_memrealtime(); }
#define TIMER_BEGIN(mode) unsigned long long _tb##mode = 0; if (TIMER_MODE == (mode) && blockIdx.x == TIMER_BLOCK && threadIdx.x == 0) _tb##mode = rt_now();
#define TIMER_END(mode, ldsbase) if (TIMER_MODE == (mode) && blockIdx.x == TIMER_BLOCK && threadIdx.x == 0) { volatile unsigned* _w = (volatile unsigned*)((ldsbase) + TIMER_LDS_OFF); if (TIMER_PHASE < 0 || (int)_w[1] == TIMER_PHASE) _w[0] = _w[0] + (unsigned)(rt_now() - _tb##mode); }
__device__ __forceinline__ unsigned lds_addr(const void* p) { return (unsigned)(size_t)(__attribute__((address_space(3))) const char*)p; }

#define XB_TMO      128
#define XB_XCNT(j)  (256  + 64 * (j))
#define XB_XSUB(j)  (1280 + 64 * (j))
#define XB_XGEN(j)  (2304 + 64 * (j))
#define XB_TOP      3328
#define XB_TOPGEN   3392
#define XCD_BAR_WORDS 3456
#define XB_SPIN_CAP (1u << 20)
#define LAS __attribute__((address_space(3)))

__device__ __forceinline__ unsigned xb_ld(unsigned* p)              { return __hip_atomic_load(p, __ATOMIC_RELAXED, __HIP_MEMORY_SCOPE_AGENT); }
__device__ __forceinline__ unsigned xb_add(unsigned* p, unsigned v) { return __hip_atomic_fetch_add(p, v, __ATOMIC_RELAXED, __HIP_MEMORY_SCOPE_AGENT); }
__device__ __forceinline__ unsigned xb_xcc_id() { return (unsigned)__builtin_amdgcn_s_getreg((3 << 11) | 20) & 0xFu; }
#define XB_SPIN(cond, bar) do { unsigned _sp = 0; while (cond) { __builtin_amdgcn_s_sleep(1); \
    if ((++_sp & 255u) == 0u) { if (xb_ld(&(bar)[XB_TMO])) break; if (_sp > XB_SPIN_CAP) { atomicAdd(&(bar)[XB_TMO], 1u); break; } } } } while (0)

struct XcdBarrier { unsigned* bar; unsigned x; volatile LAS unsigned* st; };

__device__ __forceinline__ XcdBarrier xcd_barrier_post(unsigned* bar, volatile LAS unsigned* st) {
    XcdBarrier b; b.bar = bar; b.x = xb_xcc_id(); b.st = st;
    if (threadIdx.x == 0) (void)xb_add(&bar[XB_XCNT(b.x)], 1u);
    return b;
}
__device__ __forceinline__ void xcd_barrier_complete(unsigned* bar, unsigned x, unsigned& nloc, unsigned& nx) {
    const unsigned G = gridDim.x * gridDim.y * gridDim.z;
    unsigned sum, cnt, mine, sp = 0u;
    for (;;) {
        sum = 0u; cnt = 0u; mine = 0u;
#pragma unroll
        for (unsigned j = 0; j < 16; ++j) { const unsigned c = xb_ld(&bar[XB_XCNT(j)]); sum += c; cnt += (c > 0u) ? 1u : 0u; mine = (j == x) ? c : mine; }
        if (sum == G) break;
        __builtin_amdgcn_s_sleep(1);
        if ((++sp & 255u) == 0u) { if (xb_ld(&bar[XB_TMO])) break; if (sp > XB_SPIN_CAP) { atomicAdd(&bar[XB_TMO], 1u); break; } }
    }
    nloc = mine > 0u ? mine : 1u; nx = cnt > 0u ? cnt : 1u;
}
__device__ __forceinline__ void xcd_barrier(const XcdBarrier& b) {
    asm volatile("s_waitcnt vmcnt(0)" ::: "memory");
    __syncthreads();
    if (threadIdx.x == 0) {
        unsigned* bar = b.bar;
        __builtin_amdgcn_s_waitcnt(0);
        unsigned nloc = b.st[0], nx = b.st[1];
        if (nloc == 0u) { xcd_barrier_complete(bar, b.x, nloc, nx); b.st[0] = nloc; b.st[1] = nx; }
        const unsigned old = xb_add(&bar[XB_XSUB(b.x)], 1u);
        const unsigned gen = old / nloc;
        if (old + 1u == (gen + 1u) * nloc) {
            __builtin_amdgcn_fence(__ATOMIC_RELEASE, "agent");
            asm volatile("s_waitcnt vmcnt(0)" ::: "memory");
            const unsigned og = xb_add(&bar[XB_TOP], 1u);
            const unsigned tg = og / nx;
            if (og + 1u == (tg + 1u) * nx) xb_add(&bar[XB_TOPGEN], 1u);
            else XB_SPIN(xb_ld(&bar[XB_TOPGEN]) == tg, bar);
            __builtin_amdgcn_fence(__ATOMIC_ACQUIRE, "agent");
            xb_add(&bar[XB_XGEN(b.x)], 1u);
            asm volatile("s_waitcnt vmcnt(0)" ::: "memory");
        } else {
            XB_SPIN(xb_ld(&bar[XB_XGEN(b.x)]) == gen, bar);
            __builtin_amdgcn_fence(__ATOMIC_ACQUIRE, "agent");
            asm volatile("s_waitcnt vmcnt(0)" ::: "memory");
        }
    }
    __syncthreads();
}

__device__ __forceinline__ int lds_byte(int r, int c) { const int st = (r >> 4) * 2 + (c >> 5), rr = r & 15, cc = c & 31, ob = rr * 64 + cc * 2; return st * 1024 + (ob ^ (((ob >> 9) & 1) << 5)); }
__device__ __forceinline__ void stage_rc(int b, int& R, int& C) { const int st = b / 1024, sb = b % 1024, swz = sb ^ (((sb >> 9) & 1) << 5); R = (st >> 1) * 16 + swz / 64; C = (st & 1) * 32 + (swz % 64) / 2; }
__device__ __forceinline__ int perm32(int rho) { const int n = rho >> 4, i = rho & 15; return 8 * (i >> 2) + 4 * n + (i & 3); }

typedef f32x4 AccT[2][2][4][2];

#define G_SA(b, h) (ldsb + (((b) * 2 + (h)) * 16384))
#define G_SB(b, h) (ldsb + ((4 + (b) * 2 + (h)) * 16384))
#define AKOFF(t) ((size_t)((unsigned)((t) >> 1) * astep2 + (unsigned)((t) & 1) * 128u))
#define STAGE_A(buf, h, t) do { const char* _p = Ab + AKOFF(t); \
    glds16((h) ? ao2 : ao0, _p, ldsw + ((buf) * 2 + (h)) * 16384); glds16((h) ? ao3 : ao1, _p, ldsw + ((buf) * 2 + (h)) * 16384 + 8192); } while (0)
#define STAGE_B(buf, h, t) do { const char* _p = Bb + (size_t)(h) * 128 * ldb + (size_t)(t) * 128u; \
    glds16(bo, _p, ldsw + (4 + (buf) * 2 + (h)) * 16384); glds16(bo, _p + (size_t)64 * ldb, ldsw + (4 + (buf) * 2 + (h)) * 16384 + 8192); } while (0)
#define LDA(dst, b, h) for (int m = 0; m < 4; ++m) for (int k = 0; k < 2; ++k) \
    dst[m][k] = *reinterpret_cast<const bf16x8*>(G_SA(b, h) + lds_byte(wr * 64 + m * 16 + fr, k * 32 + fq * 8))
#define LDB(dst, b, h) for (int n = 0; n < 2; ++n) for (int k = 0; k < 2; ++k) \
    dst[n][k] = *reinterpret_cast<const bf16x8*>(G_SB(b, h) + lds_byte(wc * 32 + n * 16 + fr, k * 32 + fq * 8))
#define MMA(ai, bj, At_, Bt_) do { __builtin_amdgcn_s_setprio(1); \
    for (int m = 0; m < 4; ++m) for (int n = 0; n < 2; ++n) for (int k = 0; k < 2; ++k) \
      acc[ai][bj][m][n] = __builtin_amdgcn_mfma_f32_16x16x32_bf16(Bt_[n][k], At_[m][k], acc[ai][bj][m][n], 0, 0, 0); \
    __builtin_amdgcn_s_setprio(0); } while (0)
typedef short s16x16 __attribute__((ext_vector_type(16)));
__device__ __forceinline__ v8i cat8(bf16x8 a, bf16x8 b) { const s16x16 t = __builtin_shufflevector(a, b, 0, 1, 2, 3, 4, 5, 6, 7, 8, 9, 10, 11, 12, 13, 14, 15); return __builtin_bit_cast(v8i, t); }
#define CAT8(x, y) cat8(x, y)
__device__ __forceinline__ void mfma8(f32x4& acc, v8i a, v8i b, unsigned sc) {
    asm volatile("v_mfma_scale_f32_16x16x128_f8f6f4 %0, %1, %2, %0, %3, %3 op_sel_hi:[0,0,0]" : "+v"(acc) : "v"(a), "v"(b), "v"(sc));
}
#define MMA8(ai, bj, At_, Bt_) do { __builtin_amdgcn_s_setprio(1); \
    _Pragma("unroll") for (int m = 0; m < 4; ++m) _Pragma("unroll") for (int n = 0; n < 2; ++n) \
      mfma8(acc[ai][bj][m][n], CAT8(Bt_[n][0], Bt_[n][1]), CAT8(At_[m][0], At_[m][1]), sc127); \
    __builtin_amdgcn_s_setprio(0); } while (0)
#define MMAX(ai, bj, At_, Bt_) do { if (FP8) MMA8(ai, bj, At_, Bt_); else MMA(ai, bj, At_, Bt_); } while (0)
#define WAIT_V(n) asm volatile("s_waitcnt vmcnt(" #n ")" ::: "memory")
#define WAIT_L(n) asm volatile("s_waitcnt lgkmcnt(" #n ")" ::: "memory")
#define BAR __builtin_amdgcn_s_barrier()
#define SCHED __builtin_amdgcn_sched_barrier(0)

template <bool PERM, bool FP8, class Epi>
__device__ __forceinline__ void gemm256(unsigned char* lds, const char* __restrict__ Ab, const char* __restrict__ Bb, const unsigned ldb,
                                        const unsigned astep2, const int nt, const unsigned ao0, const unsigned ao1, const unsigned ao2,
                                        const unsigned ao3, const Epi& epi) {
    char* ldsb = (char*)lds;
    int tid = threadIdx.x;
    const unsigned ldsw = lds_addr(lds) + (unsigned)__builtin_amdgcn_readfirstlane(tid >> 6) * 1024u;
    int wid = tid >> 6, lane = tid & 63, wr = wid >> 2, wc = wid & 3, fr = lane & 15, fq = lane >> 4;
    unsigned bo; { int R, C; stage_rc(tid * 16, R, C); const int pr = PERM ? ((R & ~31) | perm32(R & 31)) : R; bo = (unsigned)pr * ldb + (unsigned)C * 2u; }
    AccT acc = {};
    bf16x8 At[4][2], B0[2][2], B1[2][2];
    unsigned sc127 = 127u; if (FP8) asm volatile("" : "+v"(sc127));
    STAGE_B(0, 0, 0); STAGE_A(0, 0, 0);
    STAGE_B(0, 1, 0); STAGE_A(0, 1, 0);
    if (wr == 1) BAR;
    WAIT_V(4); BAR;
    STAGE_B(1, 0, 1); STAGE_A(1, 0, 1); STAGE_B(1, 1, 1);
    WAIT_V(6); BAR;
    for (int t = 0; t < nt - 2; t += 2) {
        LDB(B0, 0, 0); SCHED; LDA(At, 0, 0); STAGE_A(1, 1, t + 1);
        WAIT_L(8); BAR; WAIT_L(0); MMAX(0, 0, At, B0); BAR; SCHED;
        LDB(B1, 0, 1); STAGE_B(0, 0, t + 2);
        BAR; WAIT_L(0); MMAX(0, 1, At, B1); BAR;
        LDA(At, 0, 1); STAGE_A(0, 0, t + 2);
        BAR; WAIT_L(0); MMAX(1, 0, At, B0); BAR; SCHED;
        STAGE_B(0, 1, t + 2);
        WAIT_V(6); BAR; MMAX(1, 1, At, B1); BAR;
        LDB(B0, 1, 0); SCHED; LDA(At, 1, 0); STAGE_A(0, 1, t + 2);
        WAIT_L(8); BAR; WAIT_L(0); MMAX(0, 0, At, B0); BAR; SCHED;
        LDB(B1, 1, 1); STAGE_B(1, 0, t + 3);
        BAR; WAIT_L(0); MMAX(0, 1, At, B1); BAR;
        LDA(At, 1, 1); STAGE_A(1, 0, t + 3);
        BAR; WAIT_L(0); MMAX(1, 0, At, B0); BAR; SCHED;
        STAGE_B(1, 1, t + 3);
        WAIT_V(6); BAR; MMAX(1, 1, At, B1); BAR;
    }
    { int tz = threadIdx.x; asm volatile("" : "+v"(tz)); tid = tz; wid = tz >> 6; lane = tz & 63; wr = wid >> 2; wc = wid & 3; fr = lane & 15; fq = lane >> 4; }
    { LDB(B0, 0, 0); WAIT_V(0); LDA(At, 0, 0); STAGE_A(1, 1, nt - 1);
      BAR; WAIT_L(0); MMAX(0, 0, At, B0); BAR;
      LDB(B1, 0, 1); BAR; WAIT_L(0); MMAX(0, 1, At, B1); BAR;
      LDA(At, 0, 1); WAIT_V(4); BAR; WAIT_L(0); MMAX(1, 0, At, B0); MMAX(1, 1, At, B1); BAR; }
    { LDB(B0, 1, 0); LDA(At, 1, 0); WAIT_V(2); BAR; WAIT_L(0); MMAX(0, 0, At, B0); BAR;
      LDB(B1, 1, 1); WAIT_V(0); BAR; WAIT_L(0); MMAX(0, 1, At, B1); BAR;
      LDA(At, 1, 1); BAR; WAIT_L(0); MMAX(1, 0, At, B0); MMAX(1, 1, At, B1); BAR; }
    if (wr == 0) BAR;
    epi(acc, wr, wc, fr, fq);
    __syncthreads();
}

__device__ __forceinline__ void tile_order(int L, int nM, int nN, int& pm, int& pn) {
    const int nwg = nM * nN; int wgid = L;
    { const int q = nwg / 8, r = nwg % 8, xcd = wgid % 8, off = wgid / 8; wgid = (xcd < r ? xcd * (q + 1) : r * (q + 1) + (xcd - r) * q) + off; }
    const int nig = 8 * nN, gid = wgid / nig, fm = gid * 8, gsz = (nM - fm) < 8 ? (nM - fm) : 8;
    pm = fm + ((wgid % nig) % gsz); pn = (wgid % nig) / gsz;
}
__device__ __forceinline__ void stage_row_col(int tid, int& R0, int& C) { stage_rc(tid * 16, R0, C); }


__device__ __forceinline__ u32x4 pack8v(f32x4 a, f32x4 b) { u32x4 w = {cvtpk(a[0], a[1]), cvtpk(a[2], a[3]), cvtpk(b[0], b[1]), cvtpk(b[2], b[3])}; return w; }
__device__ __forceinline__ u32x2 pack8_fp8(f32x4 a, f32x4 b) {
    unsigned w0 = 0, w1 = 0;
    w0 = __builtin_amdgcn_cvt_pk_fp8_f32(a[0], a[1], w0, false); w0 = __builtin_amdgcn_cvt_pk_fp8_f32(a[2], a[3], w0, true);
    w1 = __builtin_amdgcn_cvt_pk_fp8_f32(b[0], b[1], w1, false); w1 = __builtin_amdgcn_cvt_pk_fp8_f32(b[2], b[3], w1, true);
    return (u32x2){w0, w1};
}
__device__ __forceinline__ float sigmoidf_(float x) { return fast_rcp(1.f + fast_exp2(-x * LOG2E)); }

struct EpiProj0 {
    bf16_t* Q; bf16_t* KV6; float* gates; int row0, pn; float osc;
    __device__ __forceinline__ void operator()(const AccT& acc, int wr, int wc, int fr, int fq) const {
#pragma unroll
        for (int ai = 0; ai < 2; ++ai)
#pragma unroll
            for (int m = 0; m < 4; ++m) {
                const size_t row = (size_t)(row0 + ai * 128 + wr * 64 + m * 16 + fr);
#pragma unroll
                for (int bj = 0; bj < 2; ++bj) {
                    const int col8 = bj * 128 + wc * 32 + 8 * fq;
                    f32x4 v0 = acc[ai][bj][m][0] * osc, v1 = acc[ai][bj][m][1] * osc;
                    if (pn < 8) { v0 *= QSCALE; v1 *= QSCALE; *(u32x4*)(Q + row * DM + pn * 256 + col8) = pack8v(v0, v1); }
                    else if (pn < 20) { *(u32x4*)(KV6 + row * KV6_W + (pn - 8) * 256 + col8) = pack8v(v0, v1); }
                    else if (col8 < 48) {
                        f32x4 s0, s1;
#pragma unroll
                        for (int j = 0; j < 4; ++j) { s0[j] = sigmoidf_(v0[j]); s1[j] = sigmoidf_(v1[j]); }
                        *(f32x4*)(gates + row * 48 + col8) = s0; *(f32x4*)(gates + row * 48 + col8 + 4) = s1;
                    }
                }
            }
    }
};
struct EpiF32 {
    float* C;
    __device__ __forceinline__ void operator()(const AccT& acc, int wr, int wc, int fr, int fq) const {
#pragma unroll
        for (int ai = 0; ai < 2; ++ai)
#pragma unroll
            for (int m = 0; m < 4; ++m) {
                float* rowp = C + (size_t)(ai * 128 + wr * 64 + m * 16 + fr) * 256 + wc * 32 + 4 * fq;
#pragma unroll
                for (int bj = 0; bj < 2; ++bj)
#pragma unroll
                    for (int n = 0; n < 2; ++n) *(f32x4*)(rowp + bj * 128 + n * 16) = acc[ai][bj][m][n];
            }
    }
};
template <bool XBF> struct EpiOut {
    const void* xold; bf16_t* xb; unsigned char* xb8; int row0, col0; unsigned char* lds;
    __device__ __forceinline__ void operator()(const AccT& acc, int wr, int wc, int fr, int fq) const {
        float* T = (float*)lds;
        int tid = threadIdx.x; asm volatile("" : "+v"(tid));
        const int wave = tid >> 6, lane = tid & 63;
#pragma unroll
        for (int ai = 0; ai < 2; ++ai) {
            if (ai) __syncthreads();
#pragma unroll
            for (int m = 0; m < 4; ++m) {
                float* rp = T + (wr * 64 + m * 16 + fr) * 260 + wc * 32 + 8 * fq;
#pragma unroll
                for (int bj = 0; bj < 2; ++bj) { *(f32x4*)(rp + bj * 128) = acc[ai][bj][m][0]; *(f32x4*)(rp + bj * 128 + 4) = acc[ai][bj][m][1]; }
            }
            __syncthreads();
#pragma unroll 4
            for (int q = 0; q < 16; ++q) {
                const int r = wave * 16 + q;
                const size_t off = (size_t)(row0 + ai * 128 + r) * DM + col0 + lane * 4;
                f32x4 v = *(const f32x4*)(T + r * 260 + lane * 4);
                if (XBF) { const u32x2 xo = *(const u32x2*)((const bf16_t*)xold + off); v[0] += bflo(xo[0]); v[1] += bfhi(xo[0]); v[2] += bflo(xo[1]); v[3] += bfhi(xo[1]); }
                else v += *(const f32x4*)((const float*)xold + off);
                __hip_atomic_store((unsigned long long*)(xb + off), ((unsigned long long)cvtpk(v[2], v[3]) << 32) | cvtpk(v[0], v[1]), __ATOMIC_RELAXED, __HIP_MEMORY_SCOPE_AGENT);
                if (xb8) { unsigned w = 0; w = __builtin_amdgcn_cvt_pk_fp8_f32(v[0], v[1], w, false); w = __builtin_amdgcn_cvt_pk_fp8_f32(v[2], v[3], w, true); __hip_atomic_store((unsigned*)(xb8 + off), w, __ATOMIC_RELAXED, __HIP_MEMORY_SCOPE_AGENT); }
            }
        }
    }
};
struct EpiKVQ {
    bf16_t* KV2; bf16_t* Q; const float* rstd; int row0, pn; float osc;
    __device__ __forceinline__ void operator()(const AccT& acc, int wr, int wc, int fr, int fq) const {
#pragma unroll
        for (int ai = 0; ai < 2; ++ai)
#pragma unroll
            for (int m = 0; m < 4; ++m) {
                const size_t row = (size_t)(row0 + ai * 128 + wr * 64 + m * 16 + fr);
                float rs = rstd[row] * osc; if (pn >= 4) rs *= QSCALE;
#pragma unroll
                for (int bj = 0; bj < 2; ++bj) {
                    const int col8 = bj * 128 + wc * 32 + 8 * fq;
                    const f32x4 v0 = acc[ai][bj][m][0] * rs, v1 = acc[ai][bj][m][1] * rs;
                    if (pn < 4) *(u32x4*)(KV2 + row * 1024 + pn * 256 + col8) = pack8v(v0, v1);
                    else *(u32x4*)(Q + row * DM + (pn - 4) * 256 + col8) = pack8v(v0, v1);
                }
            }
    }
};
template <bool FP8> struct EpiGU {
    void* H; const int* list; const float* rstd; int hrow0, pn, nvalid;
    __device__ __forceinline__ void operator()(const AccT& acc, int wr, int wc, int fr, int fq) const {
#pragma unroll
        for (int ai = 0; ai < 2; ++ai)
#pragma unroll
            for (int m = 0; m < 4; ++m) {
                const int lr = ai * 128 + wr * 64 + m * 16 + fr;
                if (lr < nvalid) {
                    const float rs = rstd[list[lr] >> 1] * (FP8 ? W8_INV : 1.f);
                    f32x4 h0, h1;
#pragma unroll
                    for (int j = 0; j < 4; ++j) {
                        const float g0 = acc[ai][0][m][0][j] * rs, u0 = acc[ai][1][m][0][j] * rs, g1 = acc[ai][0][m][1][j] * rs, u1 = acc[ai][1][m][1][j] * rs;
                        h0[j] = g0 * sigmoidf_(g0) * u0; h1[j] = g1 * sigmoidf_(g1) * u1;
                    }
                    const size_t off = (size_t)(hrow0 + lr) * DEXP + pn * 128 + wc * 32 + 8 * fq;
                    if (FP8) { const u32x2 w8 = pack8_fp8(h0, h1);
                        __hip_atomic_store((unsigned long long*)((unsigned char*)H + off), ((unsigned long long)w8[1] << 32) | w8[0], __ATOMIC_RELAXED, __HIP_MEMORY_SCOPE_AGENT); }
                    else *(u32x4*)((bf16_t*)H + off) = pack8v(h0, h1);
                }
            }
    }
};
struct EpiDN {
    bf16_t* Y; const int* list; int pn, nvalid; float oscale;
    __device__ __forceinline__ void operator()(const AccT& acc, int wr, int wc, int fr, int fq) const {
#pragma unroll
        for (int ai = 0; ai < 2; ++ai)
#pragma unroll
            for (int m = 0; m < 4; ++m) {
                const int lr = ai * 128 + wr * 64 + m * 16 + fr;
                if (lr < nvalid) {
                    bf16_t* rowp = Y + (size_t)list[lr] * DM + pn * 256 + wc * 32 + 8 * fq;
#pragma unroll
                    for (int bj = 0; bj < 2; ++bj) *(u32x4*)(rowp + bj * 128) = pack8v(acc[ai][bj][m][0] * oscale, acc[ai][bj][m][1] * oscale);
                }
            }
    }
};

struct CvtJob { const float* src; bf16_t* dst; const float* gain; int K, ld, ncols, tilesN, tilesKN; size_t srcE, dstE; int pA, pB, pC; bool f8; };
constexpr int NJOBS = 13;
__device__ __forceinline__ int job_tiles(int j) {
    switch (j) { case 0: return 16 * 41; case 1: case 2: return 32 * 2; case 3: return 16 * 16; case 4: return 16 * 8; case 5: case 6: return 16 * 16; default: return 4096; }
}
__device__ __forceinline__ void get_job(const Params& P, int j, CvtJob& J) {
    unsigned char* ws = P.ws;
    J.gain = nullptr; J.srcE = 0; J.dstE = 0; J.pA = 1 << 30; J.pB = 0; J.pC = 0; J.f8 = ((j >= 7) && kFp8[(j >= 10) ? 1 : 0]) || (kFp8P && (j == 0 || j == 4 || j == 5));
    const int l = (j >= 10) ? 1 : 0;
    switch (j) {
    case 0: J.src = P.in[1]; J.dst = (bf16_t*)(ws + WS_WIN); J.K = 2048; J.ld = 5168; J.ncols = 5168; break;
    case 1: J.src = P.in[4]; J.dst = (bf16_t*)(ws + WS_CW1); J.K = 4096; J.ld = 256; J.ncols = 256; break;
    case 2: J.src = P.in[6]; J.dst = (bf16_t*)(ws + WS_CW1) + (size_t)256 * 4096; J.K = 4096; J.ld = 256; J.ncols = 256; break;
    case 3: J.src = P.in[8]; J.dst = (bf16_t*)(ws + WS_WOUT); J.K = 2048; J.ld = 2048; J.ncols = 2048; break;
    case 4: J.src = P.in[10]; J.dst = (bf16_t*)(ws + WS_WKVQ); J.K = 2048; J.ld = 1040; J.ncols = 1024; J.gain = P.in[9]; break;
    case 5: J.src = P.in[12]; J.dst = (bf16_t*)(ws + WS_WKVQ + (size_t)1024 * 2048 * (kFp8P ? 1 : 2)); J.K = 2048; J.ld = 2048; J.ncols = 2048; J.gain = P.in[14] + DM; break;
    case 6: J.src = P.in[13]; J.dst = (bf16_t*)(ws + WS_WFO); J.K = 2048; J.ld = 2048; J.ncols = 2048; break;
    case 7: case 10: J.src = P.in[18] + (size_t)l * 32 * 2048 * 1024; J.dst = (bf16_t*)(ws + WS_GU) + (size_t)l * 32 * 2048 * 2048; J.K = 2048; J.ld = 1024; J.ncols = 1024;
        J.gain = P.in[15] + l * DM; J.srcE = (size_t)2048 * 1024; J.dstE = (size_t)2048 * 2048; J.pA = 128; J.pB = 256; J.pC = 0; break;
    case 8: case 11: J.src = P.in[19] + (size_t)l * 32 * 2048 * 1024; J.dst = (bf16_t*)(ws + WS_GU) + (size_t)l * 32 * 2048 * 2048; J.K = 2048; J.ld = 1024; J.ncols = 1024;
        J.gain = P.in[15] + l * DM; J.srcE = (size_t)2048 * 1024; J.dstE = (size_t)2048 * 2048; J.pA = 128; J.pB = 256; J.pC = 128; break;
    default: J.src = P.in[20] + (size_t)l * 32 * 1024 * 2048; J.dst = (bf16_t*)(ws + WS_DN) + (size_t)l * 32 * 2048 * 1024; J.K = 1024; J.ld = 2048; J.ncols = 2048;
        J.srcE = (size_t)1024 * 2048; J.dstE = (size_t)2048 * 1024; break;
    }
    J.tilesN = (J.ncols + 127) / 128; J.tilesKN = J.tilesN * (J.K / 128);
}
struct CvtRegs { f32x4 v[8]; float gn[8]; };
__device__ __forceinline__ void cvt_load(const CvtJob& J, int idx, CvtRegs& R) {
    const int tid = threadIdx.x;
    const int e = idx / J.tilesKN, rem = idx - e * J.tilesKN, ktile = rem / J.tilesN, ntile = rem - ktile * J.tilesN;
    const float* src = J.src + (size_t)e * J.srcE;
    const int k0 = ktile * 128, n0 = ntile * 128, nn = (tid & 31) * 4;
    const bool okc = (n0 + nn) < J.ncols;
#pragma unroll
    for (int p = 0; p < 8; ++p) {
        const int kk = (tid >> 5) + 16 * p;
        R.v[p] = (f32x4){0.f, 0.f, 0.f, 0.f};
        if (okc) R.v[p] = __builtin_nontemporal_load((const f32x4*)(src + (size_t)(k0 + kk) * J.ld + n0 + nn));
        R.gn[p] = J.gain ? J.gain[k0 + kk] : 1.f;
    }
}
__device__ __forceinline__ void cvt_store(const CvtJob& J, int idx, const CvtRegs& R, float* T  ) {
    const int tid = threadIdx.x;
    const int e = idx / J.tilesKN, rem = idx - e * J.tilesKN, ktile = rem / J.tilesN, ntile = rem - ktile * J.tilesN;
    bf16_t* dst = J.dst + (size_t)e * J.dstE;
    const int k0 = ktile * 128, n0 = ntile * 128, nn = (tid & 31) * 4;
#pragma unroll
    for (int p = 0; p < 8; ++p) {
        const int kk = (tid >> 5) + 16 * p;
        float* t = T + kk * 129 + nn; const f32x4 v = R.v[p] * R.gn[p];
        t[0] = v[0]; t[1] = v[1]; t[2] = v[2]; t[3] = v[3];
    }
    __syncthreads();
    if (!J.f8) {
        const int kc = (tid & 15) * 8;
#pragma unroll
        for (int p = 0; p < 4; ++p) {
            const int n = (tid >> 4) + 32 * p, ng = n0 + n;
            if (ng < J.ncols) {
                const float* t = T + kc * 129 + n;
                f32x4 a = {t[0], t[129], t[258], t[387]}, b = {t[516], t[645], t[774], t[903]};
                const int drow = (ng / J.pA) * J.pB + J.pC + (ng % J.pA);
                *(u32x4*)(dst + (size_t)drow * J.K + k0 + kc) = pack8v(a, b);
            }
        }
    } else {
        const int kc = (tid & 7) * 16;
        unsigned char* dst8 = (unsigned char*)J.dst + (size_t)e * J.dstE;
#pragma unroll
        for (int p = 0; p < 2; ++p) {
            const int n = (tid >> 3) + 64 * p, ng = n0 + n;
            if (ng < J.ncols) {
                const float* t = T + kc * 129 + n;
                f32x4 a = {t[0], t[129], t[258], t[387]}, b = {t[516], t[645], t[774], t[903]}, c = {t[1032], t[1161], t[1290], t[1419]}, d = {t[1548], t[1677], t[1806], t[1935]};
                const u32x2 lo = pack8_fp8(a * W8_SCALE, b * W8_SCALE), hi = pack8_fp8(c * W8_SCALE, d * W8_SCALE);
                const int drow = (ng / J.pA) * J.pB + J.pC + (ng % J.pA);
                *(u32x4*)(dst8 + (size_t)drow * J.K + k0 + kc) = (u32x4){lo[0], lo[1], hi[0], hi[1]};
            }
        }
    }
    __syncthreads();
}
__device__ __forceinline__ int find_job(int g, int& jbase) { int b2 = 0, j = 0; for (; j < NJOBS - 1; ++j) { const int n = job_tiles(j); if (g < b2 + n) break; b2 += n; } jbase = b2; return j; }
__device__ __forceinline__ void phase_convert(const Params& P, unsigned char* lds, int jlo, int jhi) {
    float* T = (float*)lds;
    int base = 0;
    for (int j = 0; j < jlo; ++j) base += job_tiles(j);
    int total = base;
    for (int j = jlo; j < jhi; ++j) total += job_tiles(j);
    const int G = gridDim.x;
    int g0 = base + blockIdx.x;
    if (g0 >= total) return;
    CvtJob J0, J1, J2; CvtRegs R0, R1, R2; int b0, b1 = 0, b2 = 0;
    { const int j = find_job(g0, b0); get_job(P, j, J0); cvt_load(J0, g0 - b0, R0); }
    int g1 = g0 + G, g2 = g1 + G;
    if (g1 < total) { const int j = find_job(g1, b1); get_job(P, j, J1); cvt_load(J1, g1 - b1, R1); }
    for (;;) {
        if (g2 < total) { const int j = find_job(g2, b2); get_job(P, j, J2); cvt_load(J2, g2 - b2, R2); }
        cvt_store(J0, g0 - b0, R0, T);
        if (g1 >= total) break;
        J0 = J1; R0 = R1; b0 = b1; g0 = g1;
        J1 = J2; R1 = R2; b1 = b2; g1 = g2; g2 += G;
    }
}
__device__ __forceinline__ void phase0_misc(const Params& P, unsigned char* lds) {
    unsigned char* ws = P.ws;
    const int tid = threadIdx.x, lane = tid & 63, wave = tid >> 6;
    {
        const float* x = P.in[0]; const float* gain = P.in[14]; bf16_t* h0 = (bf16_t*)(ws + WS_XBA);
        for (int row = blockIdx.x * 8 + wave; row < NTOK; row += gridDim.x * 8) {
            const float* xr = x + (size_t)row * DM + lane * 4;
            f32x4 v[8]; float ss = 0.f;
#pragma unroll
            for (int j = 0; j < 8; ++j) { v[j] = *(const f32x4*)(xr + j * 256); ss += v[j][0] * v[j][0] + v[j][1] * v[j][1] + v[j][2] * v[j][2] + v[j][3] * v[j][3]; }
            ss = wave_sum(ss);
            const float rstd = rsqrtf(ss * (1.f / DM) + RMS_EPS);
#pragma unroll
            for (int j = 0; j < 8; ++j) {
                const f32x4 gv = *(const f32x4*)(gain + j * 256 + lane * 4);
                const f32x4 o = v[j] * rstd * gv;
                if (kFp8P) { unsigned w8 = 0; w8 = __builtin_amdgcn_cvt_pk_fp8_f32(o[0], o[1], w8, false); w8 = __builtin_amdgcn_cvt_pk_fp8_f32(o[2], o[3], w8, true); *(unsigned*)(ws + WS_XA8 + (size_t)row * DM + j * 256 + lane * 4) = w8; }
                else { u32x2 w = {cvtpk(o[0], o[1]), cvtpk(o[2], o[3])}; *(u32x2*)(h0 + (size_t)row * DM + j * 256 + lane * 4) = w; }
            }
        }
    }
    {
        float* rw = (float*)(ws + WS_RW); float* wf = (float*)(ws + WS_WF);
        const int gtid = blockIdx.x * NTHREADS + tid, gsz = gridDim.x * NTHREADS;
        for (int i = gtid; i < 2 * 2048 * 32; i += gsz) { const int l = i >> 16, k = (i >> 5) & 2047, e = i & 31; rw[i] = P.in[15][l * DM + k] * P.in[16][k * 32 + e]; }
        for (int i = gtid; i < 2048 * 32; i += gsz) { const int k = i >> 5, j = i & 31; wf[i] = (j < 16) ? P.in[9][k] * P.in[10][(size_t)k * 1040 + 1024 + j] : 0.f; }
    }
    for (int w = blockIdx.x; w < 64; w += gridDim.x) {
        const int kv = w >> 5, ch = w & 31; const float* pe = P.in[kv ? 3 : 2]; const float* w1 = P.in[kv ? 6 : 4];
        float* red = (float*)lds;
        const int j = tid & 255, half = tid >> 8; float s = 0.f;
        const int i0 = ch * 128 + half * 64;
#pragma unroll 16
        for (int i = i0; i < i0 + 64; ++i) s += pe[i] * w1[(size_t)i * 256 + j];
        __syncthreads();
        red[tid] = s; __syncthreads();
        if (tid < 256) ((float*)(ws + WS_BIAS1))[(kv * 32 + ch) * 256 + tid] = red[tid] + red[tid + 256];
        __syncthreads();
    }
}

__device__ __forceinline__ void lin_offsets(int tid, unsigned lda, unsigned& a0, unsigned& a1, unsigned& a2, unsigned& a3) {
    int R0, C; stage_rc(tid * 16, R0, C);
    a0 = (unsigned)R0 * lda + C * 2; a1 = (unsigned)(R0 + 64) * lda + C * 2; a2 = (unsigned)(R0 + 128) * lda + C * 2; a3 = (unsigned)(R0 + 192) * lda + C * 2;
}
__device__ __forceinline__ void phase_proj0(const Params& P, unsigned char* lds) {
    unsigned char* ws = P.ws;
    constexpr unsigned EB = kFp8P ? 1u : 2u;
    unsigned a0, a1, a2, a3; lin_offsets(threadIdx.x, DM * EB, a0, a1, a2, a3);
    for (int L = blockIdx.x; L < 64 * 21; L += gridDim.x) {
        int pm, pn; tile_order(L, 64, 21, pm, pn);
        EpiProj0 E{(bf16_t*)(ws + WS_Q), (bf16_t*)(ws + WS_KV6), (float*)(ws + WS_GATES), pm * 256, pn, kFp8P ? W8_INV : 1.f};
        gemm256<true, kFp8P>(lds, (const char*)(ws + (kFp8P ? WS_XA8 : WS_XBA)) + (size_t)pm * 256 * DM * EB, (const char*)(ws + WS_WIN) + (size_t)pn * 256 * DM * EB, DM * EB, 256u, DM * EB / 128,
                             a0, a1, a2, a3, E);
    }
}
__device__ __forceinline__ void phase_cmp1(const Params& P, unsigned char* lds) {
    unsigned char* ws = P.ws;
    int R0, C; stage_rc(threadIdx.x * 16, R0, C);
    for (int u = blockIdx.x; u < 256; u += gridDim.x) {
        const int kv = u >> 7, mt = (u >> 3) & 15, ks = u & 7;
        unsigned ao[4];
#pragma unroll
        for (int q = 0; q < 4; ++q) {
            int r = mt * 256 + R0 + 64 * q; if (r > 4063) r = 4063;
            const int b = r / 508, rem = r - b * 508, n = rem >> 2, g = rem & 3;
            ao[q] = (unsigned)(((b * SEQ + n * 16) * KV6_W + kv * 512 + g * 128 + C) * 2);
        }
        EpiF32 E{(float*)(ws + WS_CPART) + ((size_t)(kv * 8 + ks) * 4096 + mt * 256) * 256};
        gemm256<false, false>(lds, (const char*)(ws + WS_KV6) + (size_t)ks * 4 * KV6_W * 2, (const char*)(ws + WS_CW1) + ((size_t)kv * 256 * 4096 + ks * 512) * 2, 4096 * 2,
                       (unsigned)(KV6_W * 2), 8, ao[0], ao[1], ao[2], ao[3], E);
    }
}
__device__ __forceinline__ float gelu_tanh(float x) {
    const float u = 0.7978845608028654f * (x + 0.044715f * x * x * x);
    const float t = 1.f - 2.f * fast_rcp(1.f + fast_exp2(2.f * LOG2E * u));
    return 0.5f * x * (1.f + t);
}
__device__ __forceinline__ void phase_cmp2(const Params& P, unsigned char* lds) {
    unsigned char* ws = P.ws;
    const int tid = threadIdx.x;
    float* hid = (float*)lds;
    const float* part = (const float*)(ws + WS_CPART);
    bf16_t* kvc = (bf16_t*)(ws + WS_KVCMP);
    for (int grp = blockIdx.x; grp < 256; grp += gridDim.x) {
        const int kv = grp >> 7, r0 = (grp & 127) * 32;
        {
            const int col = tid & 255, i0 = tid >> 8;
            float bias = 0.f;
#pragma unroll 8
            for (int ch = 0; ch < 32; ++ch) bias += ((const float*)(ws + WS_BIAS1))[(kv * 32 + ch) * 256 + col];
#pragma unroll 4
            for (int ii = 0; ii < 16; ++ii) {
                const int i = i0 + 2 * ii, r = r0 + i;
                float s = bias;
#pragma unroll
                for (int ks = 0; ks < 8; ++ks) s += part[((size_t)(kv * 8 + ks) * 4096 + r) * 256 + col];
                hid[i * 256 + col] = gelu_tanh(s);
            }
        }
        __syncthreads();
        {
            const float* w2 = P.in[kv ? 7 : 5];
            const int j = tid & 127, i0 = tid >> 7;
            float acc[8];
#pragma unroll
            for (int ii = 0; ii < 8; ++ii) acc[ii] = 0.f;
            for (int k = 0; k < 256; k += 4) {
                const float w0 = w2[(k + 0) * 128 + j], w1 = w2[(k + 1) * 128 + j], w2v = w2[(k + 2) * 128 + j], w3 = w2[(k + 3) * 128 + j];
#pragma unroll
                for (int ii = 0; ii < 8; ++ii) {
                    const f32x4 h = *(const f32x4*)(hid + (i0 + 4 * ii) * 256 + k);
                    acc[ii] += h[0] * w0 + h[1] * w1 + h[2] * w2v + h[3] * w3;
                }
            }
#pragma unroll
            for (int ii = 0; ii < 8; ++ii) {
                const int r = r0 + i0 + 4 * ii;
                if (r < 4064) {
                    const int b = r / 508, rem = r - b * 508, n = rem >> 2, g = rem & 3;
                    const float v = acc[ii], vn = __shfl_xor(v, 1);
                    if ((j & 1) == 0) *(unsigned*)(kvc + (size_t)kv * (8 * 128 * 512) + ((size_t)(b * 128 + n) * 4 + g) * 128 + j) = cvtpk(v, vn);
                }
            }
        }
        __syncthreads();
    }
    if (blockIdx.x == 0) {
        for (int i = tid; i < 2 * 8 * 512 / 2; i += NTHREADS) { const int kv = i >> 11, b = (i >> 8) & 7, c2 = i & 255;
            *(unsigned*)(kvc + (size_t)kv * (8 * 128 * 512) + ((size_t)(b * 128 + 127) * 512) + c2 * 2) = 0u; }
    }
}
template <bool XBF>
__device__ __forceinline__ void phase_outproj(const Params& P, unsigned char* lds, size_t wsW, const void* xold, bf16_t* xb, unsigned char* xb8, int layer) {
    unsigned char* ws = P.ws;
    unsigned a0, a1, a2, a3; lin_offsets(threadIdx.x, DM * 2, a0, a1, a2, a3);
    for (int L = blockIdx.x; L < 64 * 8; L += gridDim.x) {
        int pm, pn; tile_order(L, 64, 8, pm, pn);
        {
            if (threadIdx.x < 64) {
                unsigned* cnt = (unsigned*)(ws + WS_CTL) + CW_AC + (layer * 64 + pm) * 16; unsigned* tmo = (unsigned*)(ws + WS_CTL) + CW_BAR + XB_TMO; unsigned sp = 0;
                while ((unsigned)__builtin_amdgcn_readfirstlane(__hip_atomic_load(cnt, __ATOMIC_RELAXED, __HIP_MEMORY_SCOPE_AGENT)) < 16u) {
                    __builtin_amdgcn_s_sleep(1);
                    if ((++sp & 255u) == 0u) { if (xb_ld(tmo)) break; if (sp > XB_SPIN_CAP) { if (threadIdx.x == 0) atomicAdd(tmo, 1u); break; } } }
                __builtin_amdgcn_fence(__ATOMIC_ACQUIRE, "agent");
                asm volatile("s_waitcnt vmcnt(0)" ::: "memory");
            }
            __syncthreads();
        }
        EpiOut<XBF> E{xold, xb, xb8, pm * 256, pn * 256, lds};
        gemm256<true, false>(lds, (const char*)(ws + WS_OATT) + (size_t)pm * 256 * DM * 2, (const char*)(ws + wsW) + (size_t)pn * 256 * DM * 2, DM * 2, 256u, DM / 64, a0, a1, a2, a3, E);
        asm volatile("s_waitcnt vmcnt(0)" ::: "memory"); __syncthreads();
        if (threadIdx.x == 0) __hip_atomic_fetch_add((unsigned*)(ws + WS_CTL) + CW_PC + (layer * 64 + pm) * 16, 1u, __ATOMIC_RELAXED, __HIP_MEMORY_SCOPE_AGENT);
    }
}
__device__ __forceinline__ void phase_kvq(const Params& P, unsigned char* lds) {
    unsigned char* ws = P.ws;
    constexpr unsigned EB = kFp8P ? 1u : 2u;
    unsigned a0, a1, a2, a3; lin_offsets(threadIdx.x, DM * EB, a0, a1, a2, a3);
    for (int L = blockIdx.x; L < 64 * 12; L += gridDim.x) {
        int pm, pn; tile_order(L, 64, 12, pm, pn);
        {
            if (threadIdx.x < 64) {
                unsigned* cnt = (unsigned*)(ws + WS_CTL) + CW_CC + pm * 16; unsigned* tmo = (unsigned*)(ws + WS_CTL) + CW_BAR + XB_TMO; unsigned sp = 0;
                while ((unsigned)__builtin_amdgcn_readfirstlane(__hip_atomic_load(cnt, __ATOMIC_RELAXED, __HIP_MEMORY_SCOPE_AGENT)) < 4u) {
                    __builtin_amdgcn_s_sleep(1);
                    if ((++sp & 255u) == 0u) { if (xb_ld(tmo)) break; if (sp > XB_SPIN_CAP) { if (threadIdx.x == 0) atomicAdd(tmo, 1u); break; } } }
                __builtin_amdgcn_fence(__ATOMIC_ACQUIRE, "agent");
                asm volatile("s_waitcnt vmcnt(0)" ::: "memory");
            }
            __syncthreads();
        }
        EpiKVQ E{(bf16_t*)(ws + WS_KV2), (bf16_t*)(ws + WS_Q), (const float*)(ws + WS_RSTD) + NTOK, pm * 256, pn, kFp8P ? W8_INV : 1.f};
        gemm256<true, kFp8P>(lds, (const char*)(ws + (kFp8P ? WS_XA8 : WS_XBA)) + (size_t)pm * 256 * DM * EB, (const char*)(ws + WS_WKVQ) + (size_t)pn * 256 * DM * EB, DM * EB, 256u, DM * EB / 128,
                             a0, a1, a2, a3, E);
    }
    const int wave = threadIdx.x >> 6, lane = threadIdx.x & 63;
    for (int gw = blockIdx.x * 8 + wave; gw < 128; gw += gridDim.x * 8) {
        const int b = gw >> 4, h = gw & 15;
        {
            unsigned* cnt = (unsigned*)(ws + WS_CTL) + CW_CC + (64 + b) * 16; unsigned* tmo = (unsigned*)(ws + WS_CTL) + CW_BAR + XB_TMO; unsigned sp = 0;
            while ((unsigned)__builtin_amdgcn_readfirstlane(__hip_atomic_load(cnt, __ATOMIC_RELAXED, __HIP_MEMORY_SCOPE_AGENT)) < 32u) {
                __builtin_amdgcn_s_sleep(1);
                if ((++sp & 255u) == 0u) { if (xb_ld(tmo)) break; if (sp > XB_SPIN_CAP) { if (lane == 0) atomicAdd(tmo, 1u); break; } } }
            __builtin_amdgcn_fence(__ATOMIC_ACQUIRE, "agent");
            asm volatile("s_waitcnt vmcnt(0)" ::: "memory");
        }
        const float* lf = (const float*)(ws + WS_LOGF) + ((size_t)b * SEQ + lane * 32) * 16 + h;
        float v[32]; float s = 0.f;
#pragma unroll
        for (int i = 0; i < 32; ++i) { s += lf[i * 16]; v[i] = s; }
        float incl = s;
#pragma unroll
        for (int o = 1; o < 64; o <<= 1) { const float t = __shfl_up(incl, o); if (lane >= o) incl += t; }
        const float excl = incl - s;
        float* c2 = (float*)(ws + WS_C2) + ((size_t)b * 16 + h) * SEQ + lane * 32;
#pragma unroll
        for (int i = 0; i < 32; ++i) c2[i] = (excl + v[i]) * LOG2E;
    }
}
__device__ __forceinline__ void moe_table(const unsigned* gcnt, int* tl  ) {
    if (threadIdx.x == 0) { int s = 0; for (int e = 0; e < 32; ++e) { const int c = (int)__hip_atomic_load(gcnt + e * 64, __ATOMIC_RELAXED, __HIP_MEMORY_SCOPE_AGENT); tl[40 + e] = c; tl[e] = s; s += (c + 255) >> 8; } tl[32] = s; }
    __syncthreads();
}
template <bool FP8>
__device__ __forceinline__ void phase_moe_gu(const Params& P, unsigned char* lds, int layer) {
    unsigned char* ws = P.ws;
    int* tl = (int*)(lds + 131072);
    moe_table((const unsigned*)(ws + WS_CTL) + CW_CNT + layer * 32 * 64, tl);
    const int ntiles = tl[32];
    int R0, C; stage_rc(threadIdx.x * 16, R0, C);
    const float* rstd = (const float*)(ws + WS_RSTD) + (layer ? 2 * NTOK : 0);
    constexpr unsigned EB = FP8 ? 1u : 2u;
    const char* xb = FP8 ? (const char*)(ws + WS_XB8) : (const char*)(ws + WS_XBB);
    for (int u = blockIdx.x; u < ntiles * 8; u += gridDim.x) {
        const int ti = u >> 3, pn = u & 7;
        int e = 0;
        for (int q = 1; q < 32; ++q) if (tl[q] <= ti) e = q;
        e = __builtin_amdgcn_readfirstlane(e);
        const int mt = __builtin_amdgcn_readfirstlane(ti - tl[e]), nvalid = __builtin_amdgcn_readfirstlane(min(256, tl[40 + e] - mt * 256));
        const int* list = (const int*)(ws + WS_LIST) + ((size_t)(layer * 32 + e) * LISTCAP + mt * 256);
        unsigned ao[4];
#pragma unroll
        for (int q = 0; q < 4; ++q) { const int lr = R0 + 64 * q; const int tok = (lr < nvalid) ? (list[lr] >> 1) : 0; ao[q] = (unsigned)tok * (DM * EB) + C * 2; }
        EpiGU<FP8> E{(void*)(ws + WS_H), list, rstd, ti * 256, pn, nvalid};
        gemm256<true, FP8>(lds, xb, (const char*)(ws + WS_GU) + (size_t)layer * 32 * 2048 * 2048 * 2 + ((size_t)e * 2048 + pn * 256) * DM * EB, DM * EB, 256u, DM * EB / 128, ao[0], ao[1], ao[2], ao[3], E);
        if (FP8) {
            asm volatile("s_waitcnt vmcnt(0)" ::: "memory"); __syncthreads();
            if (threadIdx.x == 0) __hip_atomic_fetch_add((unsigned*)(ws + WS_CTL) + CW_HC + (layer * 160 + ti) * 16, 1u, __ATOMIC_RELAXED, __HIP_MEMORY_SCOPE_AGENT);
        }
    }
}
template <bool FP8>
__device__ __forceinline__ void phase_moe_dn(const Params& P, unsigned char* lds, int layer) {
    unsigned char* ws = P.ws;
    int* tl = (int*)(lds + 131072);
    moe_table((const unsigned*)(ws + WS_CTL) + CW_CNT + layer * 32 * 64, tl);
    const int ntiles = tl[32];
    constexpr unsigned EB = FP8 ? 1u : 2u;
    unsigned a0, a1, a2, a3; lin_offsets(threadIdx.x, DEXP * EB, a0, a1, a2, a3);
    const int ngu = ntiles * 8, G = gridDim.x;
    int u0 = blockIdx.x; if (FP8) { u0 = (int)blockIdx.x + ((ngu - (int)blockIdx.x + G - 1) / G) * G - ngu; }
    for (int u = u0; u < ntiles * 8; u += G) {
        const int ti = u >> 3, pn = u & 7;
        if (FP8) {
            if (threadIdx.x < 64) {
                unsigned* cnt = (unsigned*)(ws + WS_CTL) + CW_HC + (layer * 160 + ti) * 16; unsigned* tmo = (unsigned*)(ws + WS_CTL) + CW_BAR + XB_TMO; unsigned sp = 0;
                while ((unsigned)__builtin_amdgcn_readfirstlane(__hip_atomic_load(cnt, __ATOMIC_RELAXED, __HIP_MEMORY_SCOPE_AGENT)) < 8u) {
                    __builtin_amdgcn_s_sleep(1);
                    if ((++sp & 255u) == 0u) { if (xb_ld(tmo)) break; if (sp > XB_SPIN_CAP) { if (threadIdx.x == 0) atomicAdd(tmo, 1u); break; } } }
                __builtin_amdgcn_fence(__ATOMIC_ACQUIRE, "agent");
                asm volatile("s_waitcnt vmcnt(0)" ::: "memory");
            }
            __syncthreads();
        }
        int e = 0;
        for (int q = 1; q < 32; ++q) if (tl[q] <= ti) e = q;
        e = __builtin_amdgcn_readfirstlane(e);
        const int mt = __builtin_amdgcn_readfirstlane(ti - tl[e]), nvalid = __builtin_amdgcn_readfirstlane(min(256, tl[40 + e] - mt * 256));
        const int* list = (const int*)(ws + WS_LIST) + ((size_t)(layer * 32 + e) * LISTCAP + mt * 256);
        EpiDN E{(bf16_t*)(ws + WS_Y), list, pn, nvalid, FP8 ? W8_INV : 1.f};
        gemm256<true, FP8>(lds, (const char*)(ws + WS_H) + (size_t)ti * 256 * DEXP * EB, (const char*)(ws + WS_DN) + (size_t)layer * 32 * 2048 * 1024 * 2 + ((size_t)e * 2048 + pn * 256) * DEXP * EB,
                           DEXP * EB, 256u, DEXP * EB / 128, a0, a1, a2, a3, E);
    }
}


constexpr int AT_V = 0, AT_K = 32768, AT_KB = 65536, AT_WS = 67584, AT_IMP = 69632, AT_VALS = 136192, AT_SEL = 144640;
#define KSWZ(row, colB) ((row) * 256 + ((colB) ^ (((row) & 7) << 4)))
__device__ __forceinline__ int v_st(int k, int c) { const int kk = (k & ~0xC) | ((k & 4) << 1) | ((k & 8) >> 1); return ((kk >> 3) * 4 + (c >> 5)) * 512 + ((kk & 7) * 32 + (c & 31)) * 2; }
__device__ __forceinline__ int v_rd_base(int lane) { return ((lane & 3) << 3) | (((lane >> 2) & 3) << 6) | (((lane >> 4) & 1) << 5) | (((lane >> 5) & 1) << 8); }
constexpr int v_rd_off(int d0, int ks, int half) { return d0 * 512 + ks * 4096 + half * 2048; }
__device__ __forceinline__ int crow(int r, int hi) { return (r & 3) + 8 * (r >> 2) + 4 * hi; }

template <int KB>
__device__ __forceinline__ void attn_qkt(f32x16& p0, f32x16& p1, const char* K_lds, int r32, int hi, const bf16x8 (&qr)[8]) {
    p0 = f32x16{}; p1 = f32x16{};
    __builtin_amdgcn_s_setprio(1);
    const char* kb[4];
#pragma unroll
    for (int dd = 0; dd < 4; ++dd) kb[dd] = K_lds + KB * 16384 + KSWZ(r32, (dd * 16 + hi * 8) * 2);
#pragma unroll
    for (int d0 = 0; d0 < 8; ++d0) { const char* a = kb[d0 & 3] + (d0 >> 2) * 128;
        bf16x8 b0 = *reinterpret_cast<const bf16x8*>(a);
        bf16x8 b1 = *reinterpret_cast<const bf16x8*>(a + 32 * 256);
        p0 = __builtin_amdgcn_mfma_f32_32x32x16_bf16(b0, qr[d0], p0, 0, 0, 0);
        p1 = __builtin_amdgcn_mfma_f32_32x32x16_bf16(b1, qr[d0], p1, 0, 0, 0); }
    __builtin_amdgcn_s_setprio(0);
}
template <int VB>
__device__ __forceinline__ void attn_pv(f32x16 (&o)[4], int vb0, bf16x8 pa0, bf16x8 pa1, bf16x8 pa2, bf16x8 pa3) {
#define TRRD(dst, off) asm volatile("ds_read_b64_tr_b16 %0, %1 offset:%2" : "=&v"(dst) : "v"(vb0), "i"(off) : "memory")
#define PV_D0(d0) do { s16x4 l0, l1, l2, l3, h0, h1, h2, h3; constexpr int b_ = VB * 16384 + v_rd_off(d0, 0, 0); \
        TRRD(l0, b_); TRRD(h0, b_ + 2048); TRRD(l1, b_ + 4096); TRRD(h1, b_ + 6144); TRRD(l2, b_ + 8192); TRRD(h2, b_ + 10240); TRRD(l3, b_ + 12288); TRRD(h3, b_ + 14336); \
        asm volatile("s_waitcnt lgkmcnt(0)" ::: "memory"); __builtin_amdgcn_sched_barrier(0); \
        o[d0] = __builtin_amdgcn_mfma_f32_32x32x16_bf16(pa0, (bf16x8){l0[0], l0[1], l0[2], l0[3], h0[0], h0[1], h0[2], h0[3]}, o[d0], 0, 0, 0); \
        o[d0] = __builtin_amdgcn_mfma_f32_32x32x16_bf16(pa1, (bf16x8){l1[0], l1[1], l1[2], l1[3], h1[0], h1[1], h1[2], h1[3]}, o[d0], 0, 0, 0); \
        o[d0] = __builtin_amdgcn_mfma_f32_32x32x16_bf16(pa2, (bf16x8){l2[0], l2[1], l2[2], l2[3], h2[0], h2[1], h2[2], h2[3]}, o[d0], 0, 0, 0); \
        o[d0] = __builtin_amdgcn_mfma_f32_32x32x16_bf16(pa3, (bf16x8){l3[0], l3[1], l3[2], l3[3], h3[0], h3[1], h3[2], h3[3]}, o[d0], 0, 0, 0); } while (0)
    __builtin_amdgcn_s_setprio(1);
    PV_D0(0); PV_D0(1); PV_D0(2); PV_D0(3);
    __builtin_amdgcn_s_setprio(0);
#undef PV_D0
#undef TRRD
}
#define PK4(P, B_, OUT) do { unsigned a0 = cvtpk(P[B_+0], P[B_+1]), a1 = cvtpk(P[B_+2], P[B_+3]); \
        unsigned b0 = cvtpk(P[B_+4], P[B_+5]), b1 = cvtpk(P[B_+6], P[B_+7]); \
        auto r0 = __builtin_amdgcn_permlane32_swap(a0, b0, false, false); auto r1 = __builtin_amdgcn_permlane32_swap(a1, b1, false, false); \
        u32x4 w = {r0[0], r1[0], r0[1], r1[1]}; OUT = *reinterpret_cast<bf16x8*>(&w); } while (0)
__device__ __forceinline__ float row_max2(float v) { auto rr = __builtin_amdgcn_permlane32_swap(__float_as_uint(v), __float_as_uint(v), false, false); return fmaxf(__uint_as_float(rr[0]), __uint_as_float(rr[1])); }
__device__ __forceinline__ float row_sum2(float v) { auto rr = __builtin_amdgcn_permlane32_swap(__float_as_uint(v), __float_as_uint(v), false, false); return __uint_as_float(rr[0]) + __uint_as_float(rr[1]); }

struct KVAddr { unsigned ldsw, ldsb, voffK, voffV, ldb; };
__device__ __forceinline__ KVAddr kv_addr(const char* lds, int tid, int wave, unsigned ldb) {
    KVAddr A; A.ldsb = lds_addr(lds); A.ldsw = A.ldsb + (unsigned)wave * 1024u; A.ldb = ldb;
    const int row = tid >> 4, cp = tid & 15;
    A.voffK = (unsigned)row * ldb + (unsigned)((cp ^ (row & 7)) * 16);
    const int k = ((tid >> 2) & 3) | (((tid >> 7) & 1) << 2) | (((tid >> 4) & 1) << 3) | (((tid >> 8) & 1) << 4);
    const int c = ((tid >> 5) & 3) * 32 + (tid & 3) * 8;
    A.voffV = (unsigned)k * ldb + (unsigned)c * 2u;
    return A;
}
template <int BUF>
__device__ __forceinline__ void kv_issue(const KVAddr& A, const bf16_t* Kp, const bf16_t* Vp, int key0, const float* ctab, int wave, int lane) {
    const char* kb = (const char*)Kp + (size_t)key0 * A.ldb; const char* vb = (const char*)Vp + (size_t)key0 * A.ldb;
    glds16(A.voffK, kb, A.ldsw + AT_K + BUF * 16384); glds16(A.voffK, kb + (size_t)32 * A.ldb, A.ldsw + AT_K + BUF * 16384 + 8192);
    glds16(A.voffV, vb, A.ldsw + AT_V + BUF * 16384); glds16(A.voffV, vb + (size_t)32 * A.ldb, A.ldsw + AT_V + BUF * 16384 + 8192);
    if (ctab != nullptr && wave < 4) glds4((unsigned)lane * 4u, ctab + (size_t)wave * SEQ + key0, A.ldsb + AT_KB + BUF * 1024 + (unsigned)wave * 256u);
}
template <int BUF>
__device__ __forceinline__ void kb_alibi(char* lds, int tid, float sl2_t, int key0) {
    if (tid < 256) ((float*)(lds + AT_KB))[BUF * 256 + tid] = -sl2_t * (float)(key0 + (tid & 63));
}
template <int BUF, bool ALIBI>
__device__ __forceinline__ void attn_tile(char* lds, const bf16x8 (&qr)[8], f32x16 (&o)[4], float& m_reg, float& l_reg, float rb, int dq, unsigned W,
                                          bool needmask, int wave, int r32, int hi, int vb0, float sl2w, int key0) {
    f32x16 p0, p1;
    attn_qkt<BUF>(p0, p1, lds + AT_K, r32, hi, qr);
    const float NEG = -__builtin_inff();
    if (ALIBI) {
        const float t0 = rb + sl2w * (float)(key0 + 4 * hi);
#pragma unroll
        for (int r = 0; r < 16; ++r) { const float cr = (float)((r & 3) + 8 * (r >> 2));
            p0[r] = fmaf(sl2w, cr, fmaf(p0[r], LOG2E, t0)); p1[r] = fmaf(sl2w, cr + 32.f, fmaf(p1[r], LOG2E, t0)); }
    } else {
        const float* kbp = (const float*)(lds + AT_KB) + BUF * 256 + (wave & 3) * 64 + 4 * hi;
#pragma unroll
        for (int g2 = 0; g2 < 4; ++g2) {
            const f32x4 ka = *(const f32x4*)(kbp + 8 * g2), kc = *(const f32x4*)(kbp + 32 + 8 * g2);
#pragma unroll
            for (int i = 0; i < 4; ++i) { p0[4 * g2 + i] = fmaf(p0[4 * g2 + i], LOG2E, rb - ka[i]); p1[4 * g2 + i] = fmaf(p1[4 * g2 + i], LOG2E, rb - kc[i]); }
        }
    }
    if (needmask) {
#pragma unroll
        for (int r = 0; r < 16; ++r) { const int c = (r & 3) + 8 * (r >> 2);
            if ((unsigned)(dq - c) >= W) p0[r] = NEG;
            if ((unsigned)(dq - c - 32) >= W) p1[r] = NEG; }
    }
    float pmax = p0[0];
#pragma unroll
    for (int r = 1; r < 16; ++r) pmax = fmaxf(pmax, p0[r]);
#pragma unroll
    for (int r = 0; r < 16; ++r) pmax = fmaxf(pmax, p1[r]);
    pmax = row_max2(pmax);
    const float mn = fmaxf(m_reg, pmax), alpha = fast_exp2(m_reg - mn);
    m_reg = mn;
    float ps = 0.f;
#pragma unroll
    for (int r = 0; r < 16; ++r) { p0[r] = fast_exp2(p0[r] - mn); ps += p0[r]; }
#pragma unroll
    for (int r = 0; r < 16; ++r) { p1[r] = fast_exp2(p1[r] - mn); ps += p1[r]; }
    ps = row_sum2(ps);
    l_reg = l_reg * alpha + ps;
    if (__any(alpha < 1.f)) {
        float* al = (float*)(lds + AT_WS) + wave * 64;
        if (hi == 0) al[r32] = alpha;
        asm volatile("s_waitcnt lgkmcnt(0)" ::: "memory");
#pragma unroll
        for (int g2 = 0; g2 < 4; ++g2) { const f32x4 a4 = *(const f32x4*)(al + 8 * g2 + 4 * hi);
#pragma unroll
            for (int d0 = 0; d0 < 4; ++d0)
#pragma unroll
                for (int i = 0; i < 4; ++i) o[d0][4 * g2 + i] *= a4[i]; }
    }
    bf16x8 pa0, pa1, pa2, pa3;
    PK4(p0, 0, pa0); PK4(p0, 8, pa1); PK4(p1, 0, pa2); PK4(p1, 8, pa3);
    attn_pv<BUF>(o, vb0, pa0, pa1, pa2, pa3);
}
template <bool SELB, bool ALIBI>
__device__ __forceinline__ void attn_branch(char* lds, const KVAddr& A, const bf16x8 (&qr)[8], f32x16 (&o)[4], float& m_reg, float& l_reg, unsigned tilemask,
                                            const bf16_t* Kp, const bf16_t* Vp, const float* ctab, float sl2_t, float rowb, unsigned selw,
                                            int tq, int tq0w, unsigned W, int wave, int lane, int r32, int hi, int vb0, float sl2w) {
    const int tid = wave * 64 + lane;
    unsigned tm = tilemask;
    int j = 31 - __builtin_clz(tm); tm &= ~(1u << j);
    kv_issue<0>(A, Kp, Vp, j * 64, ctab, wave, lane);
    if (!ALIBI && ctab == nullptr) kb_alibi<0>(lds, tid, sl2_t, j * 64);
    const float NEG = -__builtin_inff();
#define ATT_STEP(BUF, NBUF) { \
        asm volatile("s_waitcnt vmcnt(0)" ::: "memory"); \
        __syncthreads(); \
        int jn = -1; if (tm) { jn = 31 - __builtin_clz(tm); tm &= ~(1u << jn); kv_issue<NBUF>(A, Kp, Vp, jn * 64, ctab, wave, lane); if (!ALIBI && ctab == nullptr) kb_alibi<NBUF>(lds, tid, sl2_t, jn * 64); } \
        { const int key0 = j * 64; \
          const bool rsel = SELB ? (((selw >> j) & 1u) != 0u) : true; \
          bool active = (key0 <= tq0w + 31) && ((tq0w - key0 - 63) < (int)W); \
          if (SELB) active = active && __any(rsel); \
          if (active) { \
              const bool needmask = (key0 + 63 > tq0w) || ((unsigned)(tq0w + 31 - key0) >= W); \
              attn_tile<BUF, ALIBI>(lds, qr, o, m_reg, l_reg, rsel ? rowb : NEG, tq - key0 - 4 * hi, W, needmask, wave, r32, hi, vb0, sl2w, key0); } } \
        if (jn < 0) break; \
        j = jn; }
    for (;;) { ATT_STEP(0, 1) ATT_STEP(1, 0) }
#undef ATT_STEP
    __syncthreads();
}
template <bool ADD>
__device__ __forceinline__ void attn_store(bf16_t* Obase  , const f32x16 (&o)[4], char* lds, float srow, int wave, int lane, int r32, int hi, unsigned* done_cnt = nullptr) {
    float* sc = (float*)(lds + AT_WS) + wave * 64 + 32;
    if (hi == 0) sc[r32] = srow;
    asm volatile("s_waitcnt lgkmcnt(0)" ::: "memory");
    char* tile = lds + AT_V + wave * 8192;
    char* tb = tile + hi * 1024 + r32 * 2;
#pragma unroll
    for (int g2 = 0; g2 < 4; ++g2) { const f32x4 s4 = *(const f32x4*)(sc + 8 * g2 + 4 * hi);
#pragma unroll
        for (int i = 0; i < 4; ++i) { const int r = 4 * g2 + i;
#pragma unroll
            for (int d0 = 0; d0 < 4; ++d0) *(bf16_t*)(tb + ((r & 3) + 8 * (r >> 2)) * 256 + d0 * 64) = (bf16_t)(cvtpk(o[d0][r] * s4[i], 0.f) & 0xffffu); } }
    asm volatile("s_waitcnt lgkmcnt(0)" ::: "memory");
    int ln = lane; asm volatile("" : "+v"(ln));
    unsigned* gp = (unsigned*)Obase + ln;
    const unsigned* tp = (const unsigned*)tile + ln;
#pragma unroll
    for (int rb = 0; rb < 32; rb += 8) {
        unsigned w[8], old[8];
#pragma unroll
        for (int q = 0; q < 8; ++q) { w[q] = tp[(rb + q) * 64]; if (ADD) old[q] = gp[(size_t)(rb + q) * (DM / 2)]; }
#pragma unroll
        for (int q = 0; q < 8; ++q) {
            unsigned v = w[q];
            if (ADD) v = cvtpk(bflo(w[q]) + bflo(old[q]), bfhi(w[q]) + bfhi(old[q]));
            __hip_atomic_store(gp + (size_t)(rb + q) * (DM / 2), v, __ATOMIC_RELAXED, __HIP_MEMORY_SCOPE_AGENT); }
    }
    if (done_cnt) asm volatile("s_waitcnt vmcnt(0)" ::: "memory");
    __syncthreads();
    if (done_cnt && threadIdx.x == 0) __hip_atomic_fetch_add(done_cnt, 1u, __ATOMIC_RELAXED, __HIP_MEMORY_SCOPE_AGENT);
}

__device__ __forceinline__ void nsa_unit(const Params& P, char* lds, int b, int g, int qt) {
    unsigned char* ws = P.ws;
    int tid = threadIdx.x; asm volatile("" : "+v"(tid));
    const int wave = __builtin_amdgcn_readfirstlane(tid >> 6), lane = tid & 63, r32 = lane & 31, hi = lane >> 5;
    const int head = wave & 3, h = g * 4 + head, tq0w = qt * 64 + (wave >> 2) * 32, tq = tq0w + r32;
    const int vb0 = (int)lds_addr(lds + AT_V) + v_rd_base(lane);
    const bf16_t* Qg = (const bf16_t*)(ws + WS_Q); const bf16_t* KV6 = (const bf16_t*)(ws + WS_KV6);
    const size_t tokrow = (size_t)b * SEQ + tq;
    bf16x8 qr[8];
#pragma unroll
    for (int d0 = 0; d0 < 8; ++d0) qr[d0] = *(const bf16x8*)(Qg + tokrow * DM + h * 128 + d0 * 16 + hi * 8);
    const float* gp = (const float*)(ws + WS_GATES) + tokrow * 48 + h * 3;
    const float sl2 = fast_exp2(-0.5f * (float)(h + 1)) * LOG2E;
    const float sl2_t = fast_exp2(-0.5f * (float)(g * 4 + ((tid >> 6) & 3) + 1)) * LOG2E;
    const float rowb = -sl2 * (float)tq;
    const float NEG = -__builtin_inff();
    bf16_t* Ob = (bf16_t*)(ws + WS_OATT) + ((size_t)b * SEQ + tq0w) * DM + h * 128;
    f32x16 o[4];
    {
        const KVAddr A = kv_addr(lds, tid, wave, 512 * 2);
        const bf16_t* Kc = (const bf16_t*)(ws + WS_KVCMP) + (size_t)b * 128 * 512 + g * 128;
        const bf16_t* Vc = Kc + (size_t)8 * 128 * 512;
        kv_issue<0>(A, Kc, Vc, 0, nullptr, wave, lane);
        kv_issue<1>(A, Kc, Vc, 64, nullptr, wave, lane);
        asm volatile("s_waitcnt vmcnt(0)" ::: "memory");
        __syncthreads();
        f32x16 p0, p1, p2, p3;
        attn_qkt<0>(p0, p1, lds + AT_K, r32, hi, qr);
        attn_qkt<1>(p2, p3, lds + AT_K, r32, hi, qr);
        const int lim = tq - 64 * hi; const float sb = -sl2 * (float)lim;
        float pmax = NEG;
#define CMP_BIAS(PX, N0) _Pragma("unroll") for (int r = 0; r < 16; ++r) { const int kc_ = 16 * ((N0) + (r & 3) + 8 * (r >> 2)) + 31; \
            const float v = fmaf(PX[r], LOG2E, fmaf(sl2, (float)kc_, sb)); PX[r] = (kc_ <= lim) ? v : NEG; pmax = fmaxf(pmax, PX[r]); }
        CMP_BIAS(p0, 0) CMP_BIAS(p1, 32) CMP_BIAS(p2, 64) CMP_BIAS(p3, 96)
#undef CMP_BIAS
        pmax = row_max2(pmax);
        const float mn = fmaxf(pmax, -1e30f);
        float ps = 0.f;
#pragma unroll
        for (int r = 0; r < 16; ++r) { p0[r] = fast_exp2(p0[r] - mn); p1[r] = fast_exp2(p1[r] - mn); p2[r] = fast_exp2(p2[r] - mn); p3[r] = fast_exp2(p3[r] - mn); ps += (p0[r] + p1[r]) + (p2[r] + p3[r]); }
        ps = row_sum2(ps);
        const float invl = ps > 0.f ? 1.f / ps : 0.f;
        {
            float* ia = (float*)(lds + AT_IMP) + (head * 64 + (wave >> 2) * 32 + r32) * 65;
#define IMP_W(PX, J0) _Pragma("unroll") for (int g2 = 0; g2 < 4; ++g2) { const int jj = (J0) + 2 * g2 + hi; const float hb = 0.5f * PX[4 * g2 + 3] * invl; \
            ia[jj] = (PX[4 * g2] + PX[4 * g2 + 1] + PX[4 * g2 + 2]) * invl + hb; ia[32 + jj + 1] = hb; }
            IMP_W(p0, 0) IMP_W(p1, 8) IMP_W(p2, 16) IMP_W(p3, 24)
#undef IMP_W
            if (hi == 0) ia[32] = 0.f;
        }
#pragma unroll
        for (int d0 = 0; d0 < 4; ++d0) o[d0] = f32x16{};
        bf16x8 pa0, pa1, pa2, pa3;
        PK4(p0, 0, pa0); PK4(p0, 8, pa1); PK4(p1, 0, pa2); PK4(p1, 8, pa3);
        attn_pv<0>(o, vb0, pa0, pa1, pa2, pa3);
        PK4(p2, 0, pa0); PK4(p2, 8, pa1); PK4(p3, 0, pa2); PK4(p3, 8, pa3);
        attn_pv<1>(o, vb0, pa0, pa1, pa2, pa3);
        __syncthreads();
        attn_store<false>(Ob, o, lds, gp[0] * invl, wave, lane, r32, hi);
    }
    __syncthreads();
    {
        const float* ia = (const float*)(lds + AT_IMP);
        float* vals = (float*)(lds + AT_VALS);
        unsigned* selm = (unsigned*)(lds + AT_SEL);
        const int jb = tid & 31;
        float myv[4];
#pragma unroll
        for (int pass = 0; pass < 4; ++pass) {
            const int tokl = (tid >> 5) + 16 * pass;
            float v = 0.f;
#pragma unroll
            for (int hh = 0; hh < 4; ++hh) { const float* q = ia + (hh * 64 + tokl) * 65; v += q[jb] + q[32 + jb]; }
            const bool forced = (jb == 0) || (jb == qt) || (jb == qt - 1);
            v = (jb > qt) ? NEG : (forced ? __builtin_inff() : v);
            vals[tokl * 33 + jb] = v; myv[pass] = v;
        }
        __syncthreads();
#pragma unroll
        for (int pass = 0; pass < 4; ++pass) {
            const int tokl = (tid >> 5) + 16 * pass;
            const float v = myv[pass]; int rank = 0;
#pragma unroll 8
            for (int i = 0; i < 32; ++i) { const float vi = vals[tokl * 33 + i]; rank += (vi > v || (vi == v && i < jb)) ? 1 : 0; }
            const unsigned long long bal = __ballot(rank < 16);
            if ((lane & 31) == 0) selm[tokl] = (lane < 32) ? (unsigned)bal : (unsigned)(bal >> 32);
        }
        __syncthreads();
        if (tid < 64) { unsigned mk = selm[tid];
#pragma unroll
            for (int of = 32; of >= 1; of >>= 1) mk |= __shfl_xor(mk, of);
            if (tid == 0) selm[64] = mk; }
        __syncthreads();
    }
    const unsigned causal_bits = (qt >= 31) ? 0xffffffffu : ((2u << qt) - 1u);
    const unsigned selw = ((const unsigned*)(lds + AT_SEL))[(wave >> 2) * 32 + r32];
    const unsigned um = ((const unsigned*)(lds + AT_SEL))[64] & causal_bits;
    const KVAddr A = kv_addr(lds, tid, wave, KV6_W * 2);
    {
#pragma unroll
        for (int d0 = 0; d0 < 4; ++d0) o[d0] = f32x16{};
        float m_reg = -1e30f, l_reg = 0.f;
        const bf16_t* Kp = KV6 + (size_t)b * SEQ * KV6_W + 2 * 512 + g * 128;
        attn_branch<true, true>(lds, A, qr, o, m_reg, l_reg, um, Kp, Kp + 512, nullptr, sl2_t, rowb, selw, tq, tq0w, 1u << 30, wave, lane, r32, hi, vb0, sl2);
        attn_store<true>(Ob, o, lds, l_reg > 0.f ? gp[1] / l_reg : 0.f, wave, lane, r32, hi);
    }
    {
#pragma unroll
        for (int d0 = 0; d0 < 4; ++d0) o[d0] = f32x16{};
        float m_reg = -1e30f, l_reg = 0.f;
        const bf16_t* Kp = KV6 + (size_t)b * SEQ * KV6_W + 4 * 512 + g * 128;
        const unsigned wmask = causal_bits & ~((qt > 8) ? ((1u << (qt - 8)) - 1u) : 0u);
        attn_branch<false, true>(lds, A, qr, o, m_reg, l_reg, wmask, Kp, Kp + 512, nullptr, sl2_t, rowb, 0u, tq, tq0w, 512u, wave, lane, r32, hi, vb0, sl2);
        attn_store<true>(Ob, o, lds, l_reg > 0.f ? gp[2] / l_reg : 0.f, wave, lane, r32, hi, (unsigned*)(ws + WS_CTL) + CW_AC + (0 * 64 + b * 8 + (qt >> 2)) * 16);
    }
}
__device__ __forceinline__ void fox_unit(const Params& P, char* lds, int b, int kvh, int qt) {
    unsigned char* ws = P.ws;
    int tid = threadIdx.x; asm volatile("" : "+v"(tid));
    const int wave = __builtin_amdgcn_readfirstlane(tid >> 6), lane = tid & 63, r32 = lane & 31, hi = lane >> 5;
    const int head = wave & 3, h = kvh * 4 + head, tq0w = qt * 64 + (wave >> 2) * 32, tq = tq0w + r32;
    const int vb0 = (int)lds_addr(lds + AT_V) + v_rd_base(lane);
    const bf16_t* Qg = (const bf16_t*)(ws + WS_Q);
    const size_t tokrow = (size_t)b * SEQ + tq;
    bf16x8 qr[8];
#pragma unroll
    for (int d0 = 0; d0 < 8; ++d0) qr[d0] = *(const bf16x8*)(Qg + tokrow * DM + h * 128 + d0 * 16 + hi * 8);
    const float* ctab = (const float*)(ws + WS_C2) + ((size_t)b * 16 + kvh * 4) * SEQ;
    const float rowb = ctab[head * SEQ + tq];
    f32x16 o[4];
#pragma unroll
    for (int d0 = 0; d0 < 4; ++d0) o[d0] = f32x16{};
    float m_reg = -1e30f, l_reg = 0.f;
    const bf16_t* Kp = (const bf16_t*)(ws + WS_KV2) + (size_t)b * SEQ * 1024 + kvh * 128;
    const unsigned causal_bits = (qt >= 31) ? 0xffffffffu : ((2u << qt) - 1u);
    const KVAddr A = kv_addr(lds, tid, wave, 1024 * 2);
    { TIMER_BEGIN(6);
    attn_branch<false, false>(lds, A, qr, o, m_reg, l_reg, causal_bits, Kp, Kp + 512, ctab, 0.f, rowb, 0u, tq, tq0w, 1u << 30, wave, lane, r32, hi, vb0, 0.f);
    TIMER_END(6, lds); }
    bf16_t* Ob = (bf16_t*)(ws + WS_OATT) + ((size_t)b * SEQ + tq0w) * DM + h * 128;
    attn_store<false>(Ob, o, lds, l_reg > 0.f ? 1.f / l_reg : 0.f, wave, lane, r32, hi, (unsigned*)(ws + WS_CTL) + CW_AC + (1 * 64 + b * 8 + (qt >> 2)) * 16);
}
__device__ __forceinline__ void attn_unit_decode(int u, int& b, int& g, int& qt) {
    const int rnd = u >> 8, c = u & 255, k = c >> 5, j = c & 31;
    b = j >> 2; g = j & 3;
    qt = (rnd == 0) ? 31 - k : (rnd == 1) ? 16 + k : (rnd == 2) ? 15 - k : k;
}

__device__ __forceinline__ void rowgemm64(const bf16_t* X, int row0, const float* W, float* part, float* ssp) {
    const int tid = threadIdx.x, wave = tid >> 6, lane = tid & 63, m = lane & 31, jh = lane >> 5;
    const int rgrp = wave & 1, kq = wave >> 1;
    const bf16_t* xr = X + (size_t)(row0 + rgrp * 32 + m) * DM + kq * 512 + 4 * jh;
    const float* wp = W + (size_t)(kq * 512 + 4 * jh) * 32 + m;
    f32x16 acc = {};
    float ss = 0.f;
#pragma unroll 4
    for (int i = 0; i < 64; ++i) {
        const u32x2 xw = *(const u32x2*)(xr + 8 * i); const f32x4 xv = {bflo(xw[0]), bfhi(xw[0]), bflo(xw[1]), bfhi(xw[1])};
        const float w0 = wp[(8 * i + 0) * 32], w1 = wp[(8 * i + 1) * 32], w2 = wp[(8 * i + 2) * 32], w3 = wp[(8 * i + 3) * 32];
        acc = __builtin_amdgcn_mfma_f32_32x32x2f32(xv[0], w0, acc, 0, 0, 0);
        acc = __builtin_amdgcn_mfma_f32_32x32x2f32(xv[1], w1, acc, 0, 0, 0);
        acc = __builtin_amdgcn_mfma_f32_32x32x2f32(xv[2], w2, acc, 0, 0, 0);
        acc = __builtin_amdgcn_mfma_f32_32x32x2f32(xv[3], w3, acc, 0, 0, 0);
        ss += xv[0] * xv[0] + xv[1] * xv[1] + xv[2] * xv[2] + xv[3] * xv[3];
    }
    float* pw = part + wave * (32 * 33);
#pragma unroll
    for (int r = 0; r < 16; ++r) pw[crow(r, jh) * 33 + m] = acc[r];
    ss += __shfl_xor(ss, 32);
    if (jh == 0) ssp[wave * 32 + m] = ss;
}
__device__ __forceinline__ void phase_router(const Params& P, unsigned char* lds, int layer) {
    unsigned char* ws = P.ws;
    const int tid = threadIdx.x;
    float* part = (float*)lds;
    float* ssp = (float*)(lds + 34816);
    float* lg = (float*)(lds + 36864);
    float* sl = (float*)(lds + 36864 + 8448);
    int* lcnt = (int*)(lds + 36864 + 2 * 8448);
    int* asg = lcnt + 64;
    const bf16_t* X = (const bf16_t*)(ws + WS_XBB);
    const float* W = (const float*)(ws + WS_RW) + (size_t)layer * 2048 * 32;
    float* rstd_out = (float*)(ws + WS_RSTD) + (layer ? 2 * NTOK : 0);
    float* ew = (float*)(ws + WS_EW) + (size_t)layer * NTOK * 2;
    unsigned* gcnt = (unsigned*)(ws + WS_CTL) + CW_CNT + layer * 32 * 64;
    int* lists = (int*)(ws + WS_LIST) + (size_t)layer * 32 * LISTCAP;
    for (int rg = blockIdx.x; rg < NTOK / 64; rg += gridDim.x) {
        const int row0 = rg * 64;
        {
            if (tid < 64) {
                unsigned* cnt = (unsigned*)(ws + WS_CTL) + CW_PC + (layer * 64 + (rg >> 2)) * 16; unsigned* tmo = (unsigned*)(ws + WS_CTL) + CW_BAR + XB_TMO; unsigned sp = 0;
                while ((unsigned)__builtin_amdgcn_readfirstlane(__hip_atomic_load(cnt, __ATOMIC_RELAXED, __HIP_MEMORY_SCOPE_AGENT)) < 8u) {
                    __builtin_amdgcn_s_sleep(1);
                    if ((++sp & 255u) == 0u) { if (xb_ld(tmo)) break; if (sp > XB_SPIN_CAP) { if (tid == 0) atomicAdd(tmo, 1u); break; } } }
                __builtin_amdgcn_fence(__ATOMIC_ACQUIRE, "agent");
                asm volatile("s_waitcnt vmcnt(0)" ::: "memory");
            }
            __syncthreads();
        }
        if (tid < 32) lcnt[tid] = 0;
        rowgemm64(X, row0, W, part, ssp);
        __syncthreads();
        if (tid < 64) {
            const int rgrp = tid >> 5, mloc = tid & 31;
            float ss = 0.f;
#pragma unroll
            for (int kq = 0; kq < 4; ++kq) ss += ssp[(kq * 2 + rgrp) * 32 + mloc];
            const float rstd = rsqrtf(ss * (1.f / DM) + RMS_EPS);
            rstd_out[row0 + tid] = rstd;
            float mx = -__builtin_inff();
            for (int e = 0; e < 32; ++e) {
                float d = 0.f;
#pragma unroll
                for (int kq = 0; kq < 4; ++kq) d += part[(kq * 2 + rgrp) * (32 * 33) + mloc * 33 + e];
                d *= rstd; lg[tid * 33 + e] = d; mx = fmaxf(mx, d);
            }
            float sum = 0.f;
            for (int e = 0; e < 32; ++e) { const float p = __expf(lg[tid * 33 + e] - mx); lg[tid * 33 + e] = p; sum += p; }
            const float inv = 1.f / sum;
            for (int e = 0; e < 32; ++e) { const float p = lg[tid * 33 + e] * inv; lg[tid * 33 + e] = p; sl[tid * 33 + e] = p + P.in[17][e]; }
            int bestg = 0; float bests = -__builtin_inff();
            for (int gq = 0; gq < 4; ++gq) {
                float t1 = -__builtin_inff(), t2 = -__builtin_inff();
                for (int i = 0; i < 8; ++i) { const float v = sl[tid * 33 + gq * 8 + i]; if (v > t1) { t2 = t1; t1 = v; } else if (v > t2) t2 = v; }
                const float sc = t1 + t2;
                if (sc > bests) { bests = sc; bestg = gq; }
            }
            int i1 = 0, i2 = 0; float v1 = -__builtin_inff(), v2 = -__builtin_inff();
            for (int i = 0; i < 8; ++i) { const float v = sl[tid * 33 + bestg * 8 + i]; if (v > v1) { v2 = v1; i2 = i1; v1 = v; i1 = i; } else if (v > v2) { v2 = v; i2 = i; } }
            const int e1 = bestg * 8 + i1, e2 = bestg * 8 + i2;
            const float p1 = lg[tid * 33 + e1], p2 = lg[tid * 33 + e2], ip = 1.f / (p1 + p2);
            ew[(size_t)(row0 + tid) * 2 + 0] = p1 * ip; ew[(size_t)(row0 + tid) * 2 + 1] = p2 * ip;
            asg[tid * 2 + 0] = e1; asg[tid * 2 + 1] = e2;
            asg[128 + tid * 2 + 0] = atomicAdd(&lcnt[e1], 1); asg[128 + tid * 2 + 1] = atomicAdd(&lcnt[e2], 1);
        }
        __syncthreads();
        if (tid < 32) { const int c = lcnt[tid]; lcnt[32 + tid] = c ? (int)__hip_atomic_fetch_add(gcnt + tid * 64, (unsigned)c, __ATOMIC_RELAXED, __HIP_MEMORY_SCOPE_AGENT) : 0; }
        __syncthreads();
        if (tid < 128) { const int e = asg[tid], pos = lcnt[32 + e] + asg[128 + tid]; if (pos < LISTCAP) lists[(size_t)e * LISTCAP + pos] = (row0 + (tid >> 1)) * 2 + (tid & 1); }
        __syncthreads();
    }
}
__device__ __forceinline__ void phase_combine0(const Params& P, unsigned char* lds) {
    unsigned char* ws = P.ws;
    const int tid = threadIdx.x, wave = tid >> 6, lane = tid & 63;
    float* part = (float*)lds; float* ssp = (float*)(lds + 34816); float* rs = (float*)(lds + 36864);
    const bf16_t* X1 = (const bf16_t*)(ws + WS_XBB); bf16_t* XB = (bf16_t*)(ws + WS_XBA);
    const bf16_t* Y = (const bf16_t*)(ws + WS_Y); const float* ew = (const float*)(ws + WS_EW);
    float* rstd_out = (float*)(ws + WS_RSTD) + NTOK;
    for (int rg = blockIdx.x; rg < NTOK / 64; rg += gridDim.x) {
        const int row0 = rg * 64;
        for (int q = 0; q < 8; ++q) {
            const int row = row0 + wave * 8 + q;
            const float w0 = ew[(size_t)row * 2], w1 = ew[(size_t)row * 2 + 1];
            float ss = 0.f;
#pragma unroll
            for (int j = 0; j < 8; ++j) {
                const size_t off = (size_t)row * DM + j * 256 + lane * 4;
                const u32x2 xo = *(const u32x2*)(X1 + off); f32x4 v = {bflo(xo[0]), bfhi(xo[0]), bflo(xo[1]), bfhi(xo[1])};
                const u32x2 y0 = *(const u32x2*)(Y + (size_t)(2 * row) * DM + j * 256 + lane * 4), y1 = *(const u32x2*)(Y + (size_t)(2 * row + 1) * DM + j * 256 + lane * 4);
                v[0] += w0 * bflo(y0[0]) + w1 * bflo(y1[0]); v[1] += w0 * bfhi(y0[0]) + w1 * bfhi(y1[0]);
                v[2] += w0 * bflo(y0[1]) + w1 * bflo(y1[1]); v[3] += w0 * bfhi(y0[1]) + w1 * bfhi(y1[1]);
                __hip_atomic_store((unsigned long long*)(XB + off), ((unsigned long long)cvtpk(v[2], v[3]) << 32) | cvtpk(v[0], v[1]), __ATOMIC_RELAXED, __HIP_MEMORY_SCOPE_AGENT);
                if (kFp8P) { unsigned w8 = 0; w8 = __builtin_amdgcn_cvt_pk_fp8_f32(v[0], v[1], w8, false); w8 = __builtin_amdgcn_cvt_pk_fp8_f32(v[2], v[3], w8, true); __hip_atomic_store((unsigned*)(ws + WS_XA8 + off), w8, __ATOMIC_RELAXED, __HIP_MEMORY_SCOPE_AGENT); }
                ss += v[0] * v[0] + v[1] * v[1] + v[2] * v[2] + v[3] * v[3];
            }
            ss = wave_sum(ss);
            const float rstd = rsqrtf(ss * (1.f / DM) + RMS_EPS);
            if (lane == 0) { __hip_atomic_store((unsigned*)(rstd_out + row), __float_as_uint(rstd), __ATOMIC_RELAXED, __HIP_MEMORY_SCOPE_AGENT); rs[wave * 8 + q] = rstd; }
        }
        asm volatile("s_waitcnt vmcnt(0)" ::: "memory");
        __syncthreads();
        rowgemm64(XB, row0, (const float*)(ws + WS_WF), part, ssp);
        __syncthreads();
        for (int i = tid; i < 64 * 16; i += NTHREADS) {
            const int r = i >> 4, j = i & 15, rgrp = r >> 5, mloc = r & 31;
            float d = 0.f;
#pragma unroll
            for (int kq = 0; kq < 4; ++kq) d += part[(kq * 2 + rgrp) * (32 * 33) + mloc * 33 + j];
            const float z = d * rs[r] + P.in[11][j];
            __hip_atomic_store((unsigned*)(ws + WS_LOGF) + (size_t)(row0 + r) * 16 + j, __float_as_uint(fminf(z, 0.f) - log1pf(__expf(-fabsf(z)))), __ATOMIC_RELAXED, __HIP_MEMORY_SCOPE_AGENT);
        }
        asm volatile("s_waitcnt vmcnt(0)" ::: "memory"); __syncthreads();
        if (tid == 0) { __hip_atomic_fetch_add((unsigned*)(ws + WS_CTL) + CW_CC + (rg >> 2) * 16, 1u, __ATOMIC_RELAXED, __HIP_MEMORY_SCOPE_AGENT);
                        __hip_atomic_fetch_add((unsigned*)(ws + WS_CTL) + CW_CC + (64 + (rg >> 5)) * 16, 1u, __ATOMIC_RELAXED, __HIP_MEMORY_SCOPE_AGENT); }
    }
}
__device__ __forceinline__ void phase_final(const Params& P) {
    unsigned char* ws = P.ws;
    const int tid = threadIdx.x, wave = tid >> 6, lane = tid & 63;
    const bf16_t* X3 = (const bf16_t*)(ws + WS_XBB); const bf16_t* Y = (const bf16_t*)(ws + WS_Y); const float* ew = (const float*)(ws + WS_EW) + (size_t)NTOK * 2;
    const float* gain = P.in[21];
    for (int row = blockIdx.x * 8 + wave; row < NTOK; row += gridDim.x * 8) {
        const float w0 = ew[(size_t)row * 2], w1 = ew[(size_t)row * 2 + 1];
        f32x4 v[8]; float ss = 0.f;
#pragma unroll
        for (int j = 0; j < 8; ++j) {
            const size_t off = (size_t)row * DM + j * 256 + lane * 4;
            { const u32x2 xo = *(const u32x2*)(X3 + off); v[j] = (f32x4){bflo(xo[0]), bfhi(xo[0]), bflo(xo[1]), bfhi(xo[1])}; }
            const u32x2 y0 = *(const u32x2*)(Y + (size_t)(2 * row) * DM + j * 256 + lane * 4), y1 = *(const u32x2*)(Y + (size_t)(2 * row + 1) * DM + j * 256 + lane * 4);
            v[j][0] += w0 * bflo(y0[0]) + w1 * bflo(y1[0]); v[j][1] += w0 * bfhi(y0[0]) + w1 * bfhi(y1[0]);
            v[j][2] += w0 * bflo(y0[1]) + w1 * bflo(y1[1]); v[j][3] += w0 * bfhi(y0[1]) + w1 * bfhi(y1[1]);
            ss += v[j][0] * v[j][0] + v[j][1] * v[j][1] + v[j][2] * v[j][2] + v[j][3] * v[j][3];
        }
        ss = wave_sum(ss);
        const float rstd = rsqrtf(ss * (1.f / DM) + RMS_EPS);
#pragma unroll
        for (int j = 0; j < 8; ++j) {
            const f32x4 gv = *(const f32x4*)(gain + j * 256 + lane * 4);
            *(f32x4*)(P.out + (size_t)row * DM + j * 256 + lane * 4) = v[j] * rstd * gv;
        }
    }
}

__global__ void __launch_bounds__(NTHREADS, 2) yoco_fwd(Params P) {
    extern __shared__ __attribute__((aligned(16))) unsigned char lds[];
    unsigned char* ws = P.ws;
    const int lo = P.ph_lo, hi = P.ph_hi;
    XcdBarrier bar; bar.bar = (unsigned*)(ws + WS_CTL) + CW_BAR; bar.x = 0; bar.st = nullptr;
    const bool one = (hi - lo) > 1;
    if (TIMER_MODE != 0 && threadIdx.x == 0) *(volatile unsigned*)(lds + TIMER_LDS_OFF) = 0u;
    if (one) {
        if (threadIdx.x < 4) ((unsigned*)(lds + LDS_BYTES - 16))[threadIdx.x] = 0u;
        __syncthreads();
        bar = xcd_barrier_post((unsigned*)(ws + WS_CTL) + CW_BAR, (volatile LAS unsigned*)(lds + LDS_BYTES - 16));
    }
#ifdef ONLY_PHASE
#define IN(k) ((k) == ONLY_PHASE && lo <= (k) && (k) < hi)
#else
#define IN(k) (lo <= (k) && (k) < hi)
#endif
#define SEAM(k) do { if (IN(k) && IN((k) + 1)) { TIMER_BEGIN(1); xcd_barrier(bar); TIMER_END(1, lds); } } while (0)
#ifndef REP_MASK
#define REP_MASK 0
#endif
#define RUN(k, ...) do { if (IN(k)) { if (TIMER_MODE != 0 && threadIdx.x == 0) ((volatile unsigned*)(lds + TIMER_LDS_OFF))[1] = (unsigned)(k); TIMER_BEGIN(5); __VA_ARGS__; TIMER_END(5, lds); if ((REP_MASK >> (k)) & 1) { xcd_barrier(bar); __VA_ARGS__; } } SEAM(k); } while (0)
    RUN(0, { phase_convert(P, lds, 0, NJOBS); phase0_misc(P, lds); });
    RUN(1, phase_proj0(P, lds));
    RUN(2, phase_cmp1(P, lds));
    RUN(3, phase_cmp2(P, lds));
    RUN(4, { for (int u = blockIdx.x; u < 1024; u += gridDim.x) { int b, g, qt; attn_unit_decode(u, b, g, qt); nsa_unit(P, (char*)lds, b, g, qt); }
             phase_outproj<false>(P, lds, WS_WOUT, P.in[0], (bf16_t*)(ws + WS_XBB), kFp8[0] ? (unsigned char*)(ws + WS_XB8) : nullptr, 0);
             phase_router(P, lds, 0); });
    if (kFp8[0]) { RUN(7, { phase_moe_gu<kFp8[0]>(P, lds, 0); phase_moe_dn<kFp8[0]>(P, lds, 0); }); }
    else { RUN(7, phase_moe_gu<kFp8[0]>(P, lds, 0)); RUN(8, phase_moe_dn<kFp8[0]>(P, lds, 0)); }
    RUN(9, { phase_combine0(P, lds); phase_kvq(P, lds); });
    RUN(11, { for (int u = blockIdx.x; u < 1024; u += gridDim.x) { int b, g, qt; attn_unit_decode(u, b, g, qt); fox_unit(P, (char*)lds, b, g, qt); }
              phase_outproj<true>(P, lds, WS_WFO, (const void*)(ws + WS_XBA), (bf16_t*)(ws + WS_XBB), kFp8[1] ? (unsigned char*)(ws + WS_XB8) : nullptr, 1);
              phase_router(P, lds, 1); });
    if (kFp8[1]) { RUN(14, { phase_moe_gu<kFp8[1]>(P, lds, 1); phase_moe_dn<kFp8[1]>(P, lds, 1); }); }
    else { RUN(14, phase_moe_gu<kFp8[1]>(P, lds, 1)); RUN(15, phase_moe_dn<kFp8[1]>(P, lds, 1)); }
    RUN(16, phase_final(P));
#undef RUN
    if (TIMER_MODE != 0 && blockIdx.x == TIMER_BLOCK && threadIdx.x == 0) {
        const unsigned acc_ = *(volatile unsigned*)(lds + TIMER_LDS_OFF) + 30000u; const unsigned long long t0_ = rt_now();
        while (rt_now() - t0_ < (unsigned long long)acc_) __builtin_amdgcn_s_sleep(8);
    }
#undef IN
#undef SEAM
}

}

extern "C" void kernel_launch(void* const* d_in, const int* in_sizes, int n_in, void* d_out, int out_size, void* d_ws, size_t ws_size, hipStream_t stream) {
    static int grid = 0;
    if (grid == 0) {
        if (n_in != 22 || in_sizes[0] != NTOK * DM || out_size != NTOK * DM || ws_size < WS_END) {
            fprintf(stderr, "kernel_launch: unexpected shapes (n_in %d, in0 %d, out %d, ws %zu < %zu)\n", n_in, n_in > 0 ? in_sizes[0] : -1, out_size, ws_size, (size_t)WS_END); grid = -1; return; }
        int dev = 0, cus = 0, per_cu = 0;
        (void)hipGetDevice(&dev); (void)hipDeviceGetAttribute(&cus, hipDeviceAttributeMultiprocessorCount, dev);
        if (hipFuncSetAttribute((const void*)yoco_fwd, hipFuncAttributeMaxDynamicSharedMemorySize, LDS_BYTES) != hipSuccess) { fprintf(stderr, "kernel_launch: hipFuncSetAttribute failed\n"); grid = -1; return; }
        if (hipOccupancyMaxActiveBlocksPerMultiprocessor(&per_cu, (const void*)yoco_fwd, NTHREADS, LDS_BYTES) != hipSuccess || per_cu < 1) { fprintf(stderr, "kernel_launch: occupancy query says %d\n", per_cu); }
        (void)hipGetLastError();
        grid = cus > 0 ? cus : 256;
    }
    if (grid < 0) return;
    (void)hipMemsetAsync((char*)d_ws + WS_CTL, 0, CTL_BYTES, stream);
    Params p{};
    for (int i = 0; i < 22; ++i) p.in[i] = (const float*)d_in[i];
    p.out = (float*)d_out; p.ws = (unsigned char*)d_ws;
#if MK_LAUNCHES == 1
    p.ph_lo = 0; p.ph_hi = NPHASES;
    hipLaunchKernelGGL(yoco_fwd, dim3(grid), dim3(NTHREADS), LDS_BYTES, stream, p);
#else
    for (int k = 0; k < NPHASES; ++k) { p.ph_lo = k; p.ph_hi = k + 1; hipLaunchKernelGGL(yoco_fwd, dim3(grid), dim3(NTHREADS), LDS_BYTES, stream, p); }
#endif
}
```

```cpp
#include <hip/hip_runtime.h>
#include <cstdint>
#include <cstdio>

#ifndef MK_LAUNCHES
#define MK_LAUNCHES 1
#endif

#ifndef FP8_L1
#define FP8_L1 1
#endif
#ifndef FP8_L0
#define FP8_L0 1
#endif
#ifndef FP8_PROJ
#define FP8_PROJ 1
#endif

namespace {

typedef unsigned short bf16_t;
typedef int v8i __attribute__((ext_vector_type(8)));
typedef int v4i __attribute__((ext_vector_type(4)));
typedef short bf16x8 __attribute__((ext_vector_type(8)));
typedef short s16x4 __attribute__((ext_vector_type(4)));
typedef float f32x4 __attribute__((ext_vector_type(4)));
typedef float f32x16 __attribute__((ext_vector_type(16)));
typedef unsigned u32x4 __attribute__((ext_vector_type(4)));
typedef unsigned u32x2 __attribute__((ext_vector_type(2)));

constexpr int NTOK = 16384, DM = 2048, SEQ = 2048, NBATCH = 8, NH = 16, HD = 128;
constexpr int NSA_IN_W = 5168, KV6_W = 3072, NEXP = 32, DEXP = 1024, LISTCAP = 32768;
constexpr int NTHREADS = 512;
constexpr float LOG2E = 1.4426950408889634f;
constexpr float QSCALE = 0.08838834764831845f;
constexpr float RMS_EPS = 1e-6f;
constexpr int LDS_BYTES = 147456;
constexpr int NPHASES = 17;
constexpr bool kFp8[2] = {FP8_L0 != 0, FP8_L1 != 0};
constexpr bool kFp8P = FP8_PROJ != 0;
#ifndef FP8_OUT
#define FP8_OUT 1
#endif
constexpr bool kFp8O = FP8_OUT != 0;
constexpr float OATT_SCALE = 16.f;
constexpr float W8_SCALE = 64.f, W8_INV = 1.f / 64.f;

constexpr size_t al256(size_t x) { return (x + 255) & ~(size_t)255; }
constexpr size_t WS_CTL   = 0;
constexpr size_t CTL_BYTES = 131072;
constexpr size_t WS_WIN   = WS_CTL + CTL_BYTES;
constexpr size_t WS_CW1   = WS_WIN + (size_t)5376 * 2048 * 2;
constexpr size_t WS_WOUT  = WS_CW1 + (size_t)2 * 256 * 4096 * 2;
constexpr size_t WS_WKVQ  = WS_WOUT + (size_t)2048 * 2048 * 2;
constexpr size_t WS_WFO   = WS_WKVQ + (size_t)3072 * 2048 * 2;
constexpr size_t WS_GU    = WS_WFO + (size_t)2048 * 2048 * 2;
constexpr size_t WS_DN    = WS_GU + (size_t)2 * 32 * 2048 * 2048 * 2;
constexpr size_t WS_BIAS1 = WS_DN + (size_t)2 * 32 * 2048 * 1024 * 2;
constexpr size_t WS_RW    = WS_BIAS1 + 2 * 32 * 256 * 4;
constexpr size_t WS_WF    = WS_RW + (size_t)2 * 2048 * 32 * 4;
constexpr size_t WS_XBA   = al256(WS_WF + (size_t)2048 * 32 * 4);
constexpr size_t WS_XBB   = WS_XBA + (size_t)NTOK * DM * 2;
constexpr size_t WS_Q     = WS_XBB + (size_t)NTOK * DM * 2;
constexpr size_t WS_KV6   = WS_Q + (size_t)NTOK * DM * 2;
constexpr size_t WS_GATES = WS_KV6 + (size_t)NTOK * KV6_W * 2;
constexpr size_t WS_CPART = WS_GATES + (size_t)NTOK * 48 * 4;
constexpr size_t WS_KVCMP = WS_CPART + (size_t)2 * 8 * 4096 * 256 * 4;
constexpr size_t WS_OATT  = WS_KVCMP + (size_t)2 * 8 * 128 * 512 * 2;
constexpr size_t WS_X1    = WS_OATT + (size_t)NTOK * DM * 2;
constexpr size_t WS_X2    = WS_X1 + (size_t)NTOK * DM * 4;
constexpr size_t WS_H     = WS_X2 + (size_t)NTOK * DM * 4;
constexpr size_t WS_Y     = WS_H + (size_t)40960 * 1024 * 2;
constexpr size_t WS_LIST  = WS_Y + (size_t)32768 * 2048 * 2;
constexpr size_t WS_EW    = WS_LIST + (size_t)2 * 32 * LISTCAP * 4;
constexpr size_t WS_RSTD  = WS_EW + (size_t)2 * NTOK * 2 * 4;
constexpr size_t WS_KV2   = WS_RSTD + (size_t)3 * NTOK * 4;
constexpr size_t WS_LOGF  = WS_KV2 + (size_t)NTOK * 1024 * 2;
constexpr size_t WS_C2    = WS_LOGF + (size_t)NTOK * 16 * 4;
constexpr size_t WS_XB8   = WS_C2 + (size_t)8 * 16 * 2048 * 4;
constexpr size_t WS_XA8   = WS_XB8 + (size_t)NTOK * DM;
constexpr size_t WS_OATT8 = WS_XA8 + (size_t)NTOK * DM;
constexpr size_t WS_END   = WS_OATT8 + (size_t)NTOK * DM;
constexpr int CW_BAR = 0;
constexpr int CW_CNT = 4096;
constexpr int CW_HC  = CW_CNT + 2 * 32 * 64;
constexpr int CW_PC  = CW_HC + 2 * 160 * 16;
constexpr int CW_AC  = CW_PC + 2 * 64 * 16;
constexpr int CW_CC  = CW_AC + 2 * 64 * 16;
constexpr int CW_END = CW_CC + (64 + 8) * 16;
static_assert(CW_END * 4 <= (int)CTL_BYTES, "ctl");

struct Params {
    const float* in[22];
    float* out;
    unsigned char* ws;
    int ph_lo, ph_hi;
};

__device__ __forceinline__ unsigned cvtpk(float lo, float hi) {
    unsigned r; asm volatile("v_cvt_pk_bf16_f32 %0, %1, %2" : "=v"(r) : "v"(lo), "v"(hi)); return r;
}
__device__ __forceinline__ float bflo(unsigned w) { return __uint_as_float(w << 16); }
__device__ __forceinline__ float bfhi(unsigned w) { return __uint_as_float(w & 0xffff0000u); }
__device__ __forceinline__ bf16x8 pack8(f32x4 a, f32x4 b) {
    u32x4 w = {cvtpk(a[0], a[1]), cvtpk(a[2], a[3]), cvtpk(b[0], b[1]), cvtpk(b[2], b[3])};
    return *reinterpret_cast<bf16x8*>(&w);
}
__device__ __forceinline__ float wave_sum(float v) {
#pragma unroll
    for (int o = 32; o >= 1; o >>= 1) v += __shfl_xor(v, o);
    return v;
}
__device__ __forceinline__ float fast_exp2(float x) { return __builtin_amdgcn_exp2f(x); }
__device__ __forceinline__ float fast_rcp(float x) { return __builtin_amdgcn_rcpf(x); }

__device__ __forceinline__ const void* uniform_ptr(const void* p) {
    const unsigned long long a = (unsigned long long)p;
    const unsigned lo = __builtin_amdgcn_readfirstlane((unsigned)a), hi = __builtin_amdgcn_readfirstlane((unsigned)(a >> 32));
    return (const void*)(((unsigned long long)hi << 32) | lo);
}
__device__ __forceinline__ void glds16(unsigned voff, const void* sbase, unsigned ldsaddr) {
    unsigned keep; sbase = uniform_ptr(sbase); ldsaddr = __builtin_amdgcn_readfirstlane(ldsaddr);
    asm volatile("s_mov_b32 %0, m0\n\ts_mov_b32 m0, %3\n\ts_nop 0\n\tglobal_load_lds_dwordx4 %1, %2\n\ts_mov_b32 m0, %0"
                 : "=&s"(keep) : "v"(voff), "s"(sbase), "s"(ldsaddr) : "memory");
}
__device__ __forceinline__ void glds4(unsigned voff, const void* sbase, unsigned ldsaddr) {
    unsigned keep; sbase = uniform_ptr(sbase); ldsaddr = __builtin_amdgcn_readfirstlane(ldsaddr);
    asm volatile("s_mov_b32 %0, m0\n\ts_mov_b32 m0, %3\n\ts_nop 0\n\tglobal_load_lds_dword %1, %2\n\ts_mov_b32 m0, %0"
                 : "=&s"(keep) : "v"(voff), "s"(sbase), "s"(ldsaddr) : "memory");
}

#ifndef TIMER_MODE
#define TIMER_MODE 0
#endif
#ifndef TIMER_BLOCK
#define TIMER_BLOCK 0
#endif
#ifndef TIMER_PHASE
#define TIMER_PHASE -1
#endif
#define TIMER_LDS_OFF (LDS_BYTES - 32)
__device__ __forceinline__ unsigned long long rt_now() { return __builtin_amdgcn_s_memrealtime(); }
#define TIMER_BEGIN(mode) unsigned long long _tb##mode = 0; if (TIMER_MODE == (mode) && blockIdx.x == TIMER_BLOCK && threadIdx.x == 0) _tb##mode = rt_now();
#define TIMER_END(mode, ldsbase) if (TIMER_MODE == (mode) && blockIdx.x == TIMER_BLOCK && threadIdx.x == 0) { volatile unsigned* _w = (volatile unsigned*)((ldsbase) + TIMER_LDS_OFF); if (TIMER_PHASE < 0 || (int)_w[1] == TIMER_PHASE) _w[0] = _w[0] + (unsigned)(rt_now() - _tb##mode); }
__device__ __forceinline__ unsigned lds_addr(const void* p) { return (unsigned)(size_t)(__attribute__((address_space(3))) const char*)p; }

#define XB_TMO      128
#define XB_XCNT(j)  (256  + 64 * (j))
#define XB_XSUB(j)  (1280 + 64 * (j))
#define XB_XGEN(j)  (2304 + 64 * (j))
#define XB_TOP      3328
#define XB_TOPGEN   3392
#define XCD_BAR_WORDS 3456
#define XB_SPIN_CAP (1u << 20)
#define LAS __attribute__((address_space(3)))

__device__ __forceinline__ unsigned xb_ld(unsigned* p)              { return __hip_atomic_load(p, __ATOMIC_RELAXED, __HIP_MEMORY_SCOPE_AGENT); }
__device__ __forceinline__ unsigned xb_add(unsigned* p, unsigned v) { return __hip_atomic_fetch_add(p, v, __ATOMIC_RELAXED, __HIP_MEMORY_SCOPE_AGENT); }
__device__ __forceinline__ unsigned xb_xcc_id() { return (unsigned)__builtin_amdgcn_s_getreg((3 << 11) | 20) & 0xFu; }
#define XB_SPIN(cond, bar) do { unsigned _sp = 0; while (cond) { __builtin_amdgcn_s_sleep(1); \
    if ((++_sp & 255u) == 0u) { if (xb_ld(&(bar)[XB_TMO])) break; if (_sp > XB_SPIN_CAP) { atomicAdd(&(bar)[XB_TMO], 1u); break; } } } } while (0)

struct XcdBarrier { unsigned* bar; unsigned x; volatile LAS unsigned* st; };

__device__ __forceinline__ XcdBarrier xcd_barrier_post(unsigned* bar, volatile LAS unsigned* st) {
    XcdBarrier b; b.bar = bar; b.x = xb_xcc_id(); b.st = st;
    if (threadIdx.x == 0) (void)xb_add(&bar[XB_XCNT(b.x)], 1u);
    return b;
}
__device__ __forceinline__ void xcd_barrier_complete(unsigned* bar, unsigned x, unsigned& nloc, unsigned& nx) {
    const unsigned G = gridDim.x * gridDim.y * gridDim.z;
    unsigned sum, cnt, mine, sp = 0u;
    for (;;) {
        sum = 0u; cnt = 0u; mine = 0u;
#pragma unroll
        for (unsigned j = 0; j < 16; ++j) { const unsigned c = xb_ld(&bar[XB_XCNT(j)]); sum += c; cnt += (c > 0u) ? 1u : 0u; mine = (j == x) ? c : mine; }
        if (sum == G) break;
        __builtin_amdgcn_s_sleep(1);
        if ((++sp & 255u) == 0u) { if (xb_ld(&bar[XB_TMO])) break; if (sp > XB_SPIN_CAP) { atomicAdd(&bar[XB_TMO], 1u); break; } }
    }
    nloc = mine > 0u ? mine : 1u; nx = cnt > 0u ? cnt : 1u;
}
__device__ __forceinline__ void xcd_barrier(const XcdBarrier& b) {
    asm volatile("s_waitcnt vmcnt(0)" ::: "memory");
    __syncthreads();
    if (threadIdx.x == 0) {
        unsigned* bar = b.bar;
        __builtin_amdgcn_s_waitcnt(0);
        unsigned nloc = b.st[0], nx = b.st[1];
        if (nloc == 0u) { xcd_barrier_complete(bar, b.x, nloc, nx); b.st[0] = nloc; b.st[1] = nx; }
        const unsigned old = xb_add(&bar[XB_XSUB(b.x)], 1u);
        const unsigned gen = old / nloc;
        if (old + 1u == (gen + 1u) * nloc) {
            __builtin_amdgcn_fence(__ATOMIC_RELEASE, "agent");
            asm volatile("s_waitcnt vmcnt(0)" ::: "memory");
            const unsigned og = xb_add(&bar[XB_TOP], 1u);
            const unsigned tg = og / nx;
            if (og + 1u == (tg + 1u) * nx) xb_add(&bar[XB_TOPGEN], 1u);
            else XB_SPIN(xb_ld(&bar[XB_TOPGEN]) == tg, bar);
            __builtin_amdgcn_fence(__ATOMIC_ACQUIRE, "agent");
            xb_add(&bar[XB_XGEN(b.x)], 1u);
            asm volatile("s_waitcnt vmcnt(0)" ::: "memory");
        } else {
            XB_SPIN(xb_ld(&bar[XB_XGEN(b.x)]) == gen, bar);
            __builtin_amdgcn_fence(__ATOMIC_ACQUIRE, "agent");
            asm volatile("s_waitcnt vmcnt(0)" ::: "memory");
        }
    }
    __syncthreads();
}

__device__ __forceinline__ int lds_byte(int r, int c) { const int st = (r >> 4) * 2 + (c >> 5), rr = r & 15, cc = c & 31, ob = rr * 64 + cc * 2; return st * 1024 + (ob ^ (((ob >> 9) & 1) << 5)); }
__device__ __forceinline__ void stage_rc(int b, int& R, int& C) { const int st = b / 1024, sb = b % 1024, swz = sb ^ (((sb >> 9) & 1) << 5); R = (st >> 1) * 16 + swz / 64; C = (st & 1) * 32 + (swz % 64) / 2; }
__device__ __forceinline__ int perm32(int rho) { const int n = rho >> 4, i = rho & 15; return 8 * (i >> 2) + 4 * n + (i & 3); }

typedef f32x4 AccT[2][2][4][2];

#define G_SA(b, h) (ldsb + (((b) * 2 + (h)) * 16384))
#define G_SB(b, h) (ldsb + ((4 + (b) * 2 + (h)) * 16384))
#define AKOFF(t) ((size_t)((unsigned)((t) >> 1) * astep2 + (unsigned)((t) & 1) * 128u))
#define STAGE_A(buf, h, t) do { const char* _p = Ab + AKOFF(t); \
    glds16((h) ? ao2 : ao0, _p, ldsw + ((buf) * 2 + (h)) * 16384); glds16((h) ? ao3 : ao1, _p, ldsw + ((buf) * 2 + (h)) * 16384 + 8192); } while (0)
#define STAGE_B(buf, h, t) do { const char* _p = Bb + (size_t)(h) * 128 * ldb + (size_t)(t) * 128u; \
    glds16(bo, _p, ldsw + (4 + (buf) * 2 + (h)) * 16384); glds16(bo, _p + (size_t)64 * ldb, ldsw + (4 + (buf) * 2 + (h)) * 16384 + 8192); } while (0)
#define LDA(dst, b, h) for (int m = 0; m < 4; ++m) for (int k = 0; k < 2; ++k) \
    dst[m][k] = *reinterpret_cast<const bf16x8*>(G_SA(b, h) + lds_byte(wr * 64 + m * 16 + fr, k * 32 + fq * 8))
#define LDB(dst, b, h) for (int n = 0; n < 2; ++n) for (int k = 0; k < 2; ++k) \
    dst[n][k] = *reinterpret_cast<const bf16x8*>(G_SB(b, h) + lds_byte(wc * 32 + n * 16 + fr, k * 32 + fq * 8))
#define MMA(ai, bj, At_, Bt_) do { __builtin_amdgcn_s_setprio(1); \
    for (int m = 0; m < 4; ++m) for (int n = 0; n < 2; ++n) for (int k = 0; k < 2; ++k) \
      acc[ai][bj][m][n] = __builtin_amdgcn_mfma_f32_16x16x32_bf16(Bt_[n][k], At_[m][k], acc[ai][bj][m][n], 0, 0, 0); \
    __builtin_amdgcn_s_setprio(0); } while (0)
typedef short s16x16 __attribute__((ext_vector_type(16)));
__device__ __forceinline__ v8i cat8(bf16x8 a, bf16x8 b) { const s16x16 t = __builtin_shufflevector(a, b, 0, 1, 2, 3, 4, 5, 6, 7, 8, 9, 10, 11, 12, 13, 14, 15); return __builtin_bit_cast(v8i, t); }
#define CAT8(x, y) cat8(x, y)
__device__ __forceinline__ void mfma8(f32x4& acc, v8i a, v8i b, unsigned sc) {
    asm volatile("v_mfma_scale_f32_16x16x128_f8f6f4 %0, %1, %2, %0, %3, %3 op_sel_hi:[0,0,0]" : "+v"(acc) : "v"(a), "v"(b), "v"(sc));
}
#define MMA8(ai, bj, At_, Bt_) do { __builtin_amdgcn_s_setprio(1); \
    _Pragma("unroll") for (int m = 0; m < 4; ++m) _Pragma("unroll") for (int n = 0; n < 2; ++n) \
      mfma8(acc[ai][bj][m][n], CAT8(Bt_[n][0], Bt_[n][1]), CAT8(At_[m][0], At_[m][1]), sc127); \
    __builtin_amdgcn_s_setprio(0); } while (0)
#define MMAX(ai, bj, At_, Bt_) do { if (FP8) MMA8(ai, bj, At_, Bt_); else MMA(ai, bj, At_, Bt_); } while (0)
#define WAIT_V(n) asm volatile("s_waitcnt vmcnt(" #n ")" ::: "memory")
#define WAIT_L(n) asm volatile("s_waitcnt lgkmcnt(" #n ")" ::: "memory")
#define BAR __builtin_amdgcn_s_barrier()
#define SCHED __builtin_amdgcn_sched_barrier(0)

template <bool PERM, bool FP8, class Epi>
__device__ __forceinline__ void gemm256(unsigned char* lds, const char* __restrict__ Ab, const char* __restrict__ Bb, const unsigned ldb,
                                        const unsigned astep2, const int nt, const unsigned ao0, const unsigned ao1, const unsigned ao2,
                                        const unsigned ao3, const Epi& epi) {
    char* ldsb = (char*)lds;
    int tid = threadIdx.x;
    const unsigned ldsw = lds_addr(lds) + (unsigned)__builtin_amdgcn_readfirstlane(tid >> 6) * 1024u;
    int wid = tid >> 6, lane = tid & 63, wr = wid >> 2, wc = wid & 3, fr = lane & 15, fq = lane >> 4;
    unsigned bo; { int R, C; stage_rc(tid * 16, R, C); const int pr = PERM ? ((R & ~31) | perm32(R & 31)) : R; bo = (unsigned)pr * ldb + (unsigned)C * 2u; }
    AccT acc = {};
    bf16x8 At[4][2], B0[2][2], B1[2][2];
    unsigned sc127 = 127u; if (FP8) asm volatile("" : "+v"(sc127));
    STAGE_B(0, 0, 0); STAGE_A(0, 0, 0);
    STAGE_B(0, 1, 0); STAGE_A(0, 1, 0);
    if (wr == 1) BAR;
    WAIT_V(4); BAR;
    STAGE_B(1, 0, 1); STAGE_A(1, 0, 1); STAGE_B(1, 1, 1);
    WAIT_V(6); BAR;
    for (int t = 0; t < nt - 2; t += 2) {
        LDB(B0, 0, 0); SCHED; LDA(At, 0, 0); STAGE_A(1, 1, t + 1);
        WAIT_L(8); BAR; WAIT_L(0); MMAX(0, 0, At, B0); BAR; SCHED;
        LDB(B1, 0, 1); STAGE_B(0, 0, t + 2);
        BAR; WAIT_L(0); MMAX(0, 1, At, B1); BAR;
        LDA(At, 0, 1); STAGE_A(0, 0, t + 2);
        BAR; WAIT_L(0); MMAX(1, 0, At, B0); BAR; SCHED;
        STAGE_B(0, 1, t + 2);
        WAIT_V(6); BAR; MMAX(1, 1, At, B1); BAR;
        LDB(B0, 1, 0); SCHED; LDA(At, 1, 0); STAGE_A(0, 1, t + 2);
        WAIT_L(8); BAR; WAIT_L(0); MMAX(0, 0, At, B0); BAR; SCHED;
        LDB(B1, 1, 1); STAGE_B(1, 0, t + 3);
        BAR; WAIT_L(0); MMAX(0, 1, At, B1); BAR;
        LDA(At, 1, 1); STAGE_A(1, 0, t + 3);
        BAR; WAIT_L(0); MMAX(1, 0, At, B0); BAR; SCHED;
        STAGE_B(1, 1, t + 3);
        WAIT_V(6); BAR; MMAX(1, 1, At, B1); BAR;
    }
    { int tz = threadIdx.x; asm volatile("" : "+v"(tz)); tid = tz; wid = tz >> 6; lane = tz & 63; wr = wid >> 2; wc = wid & 3; fr = lane & 15; fq = lane >> 4; }
    { LDB(B0, 0, 0); WAIT_V(0); LDA(At, 0, 0); STAGE_A(1, 1, nt - 1);
      BAR; WAIT_L(0); MMAX(0, 0, At, B0); BAR;
      LDB(B1, 0, 1); BAR; WAIT_L(0); MMAX(0, 1, At, B1); BAR;
      LDA(At, 0, 1); WAIT_V(4); BAR; WAIT_L(0); MMAX(1, 0, At, B0); MMAX(1, 1, At, B1); BAR; }
    { LDB(B0, 1, 0); LDA(At, 1, 0); WAIT_V(2); BAR; WAIT_L(0); MMAX(0, 0, At, B0); BAR;
      LDB(B1, 1, 1); WAIT_V(0); BAR; WAIT_L(0); MMAX(0, 1, At, B1); BAR;
      LDA(At, 1, 1); BAR; WAIT_L(0); MMAX(1, 0, At, B0); MMAX(1, 1, At, B1); BAR; }
    if (wr == 0) BAR;
    epi(acc, wr, wc, fr, fq);
    __syncthreads();
}

__device__ __forceinline__ void tile_order(int L, int nM, int nN, int& pm, int& pn) {
    const int nwg = nM * nN; int wgid = L;
    { const int q = nwg / 8, r = nwg % 8, xcd = wgid % 8, off = wgid / 8; wgid = (xcd < r ? xcd * (q + 1) : r * (q + 1) + (xcd - r) * q) + off; }
    const int nig = 8 * nN, gid = wgid / nig, fm = gid * 8, gsz = (nM - fm) < 8 ? (nM - fm) : 8;
    pm = fm + ((wgid % nig) % gsz); pn = (wgid % nig) / gsz;
}
__device__ __forceinline__ void stage_row_col(int tid, int& R0, int& C) { stage_rc(tid * 16, R0, C); }


__device__ __forceinline__ u32x4 pack8v(f32x4 a, f32x4 b) { u32x4 w = {cvtpk(a[0], a[1]), cvtpk(a[2], a[3]), cvtpk(b[0], b[1]), cvtpk(b[2], b[3])}; return w; }
__device__ __forceinline__ u32x2 pack8_fp8(f32x4 a, f32x4 b) {
    unsigned w0 = 0, w1 = 0;
    w0 = __builtin_amdgcn_cvt_pk_fp8_f32(a[0], a[1], w0, false); w0 = __builtin_amdgcn_cvt_pk_fp8_f32(a[2], a[3], w0, true);
    w1 = __builtin_amdgcn_cvt_pk_fp8_f32(b[0], b[1], w1, false); w1 = __builtin_amdgcn_cvt_pk_fp8_f32(b[2], b[3], w1, true);
    return (u32x2){w0, w1};
}
__device__ __forceinline__ float sigmoidf_(float x) { return fast_rcp(1.f + fast_exp2(-x * LOG2E)); }

struct EpiProj0 {
    bf16_t* Q; bf16_t* KV6; float* gates; int row0, pn; float osc;
    __device__ __forceinline__ void operator()(const AccT& acc, int wr, int wc, int fr, int fq) const {
#pragma unroll
        for (int ai = 0; ai < 2; ++ai)
#pragma unroll
            for (int m = 0; m < 4; ++m) {
                const size_t row = (size_t)(row0 + ai * 128 + wr * 64 + m * 16 + fr);
#pragma unroll
                for (int bj = 0; bj < 2; ++bj) {
                    const int col8 = bj * 128 + wc * 32 + 8 * fq;
                    f32x4 v0 = acc[ai][bj][m][0] * osc, v1 = acc[ai][bj][m][1] * osc;
                    if (pn < 8) { v0 *= QSCALE; v1 *= QSCALE; *(u32x4*)(Q + row * DM + pn * 256 + col8) = pack8v(v0, v1); }
                    else if (pn < 20) { *(u32x4*)(KV6 + row * KV6_W + (pn - 8) * 256 + col8) = pack8v(v0, v1); }
                    else if (col8 < 48) {
                        f32x4 s0, s1;
#pragma unroll
                        for (int j = 0; j < 4; ++j) { s0[j] = sigmoidf_(v0[j]); s1[j] = sigmoidf_(v1[j]); }
                        *(f32x4*)(gates + row * 48 + col8) = s0; *(f32x4*)(gates + row * 48 + col8 + 4) = s1;
                    }
                }
            }
    }
};
struct EpiF32 {
    float* C;
    __device__ __forceinline__ void operator()(const AccT& acc, int wr, int wc, int fr, int fq) const {
#pragma unroll
        for (int ai = 0; ai < 2; ++ai)
#pragma unroll
            for (int m = 0; m < 4; ++m) {
                float* rowp = C + (size_t)(ai * 128 + wr * 64 + m * 16 + fr) * 256 + wc * 32 + 4 * fq;
#pragma unroll
                for (int bj = 0; bj < 2; ++bj)
#pragma unroll
                    for (int n = 0; n < 2; ++n) *(f32x4*)(rowp + bj * 128 + n * 16) = acc[ai][bj][m][n];
            }
    }
};
template <bool XBF> struct EpiOut {
    const void* xold; bf16_t* xb; unsigned char* xb8; int row0, col0; unsigned char* lds; float osc;
    __device__ __forceinline__ void operator()(const AccT& acc, int wr, int wc, int fr, int fq) const {
        float* T = (float*)lds;
        int tid = threadIdx.x; asm volatile("" : "+v"(tid));
        const int wave = tid >> 6, lane = tid & 63;
#pragma unroll
        for (int ai = 0; ai < 2; ++ai) {
            if (ai) __syncthreads();
#pragma unroll
            for (int m = 0; m < 4; ++m) {
                float* rp = T + (wr * 64 + m * 16 + fr) * 260 + wc * 32 + 8 * fq;
#pragma unroll
                for (int bj = 0; bj < 2; ++bj) { *(f32x4*)(rp + bj * 128) = acc[ai][bj][m][0]; *(f32x4*)(rp + bj * 128 + 4) = acc[ai][bj][m][1]; }
            }
            __syncthreads();
#pragma unroll 4
            for (int q = 0; q < 16; ++q) {
                const int r = wave * 16 + q;
                const size_t off = (size_t)(row0 + ai * 128 + r) * DM + col0 + lane * 4;
                f32x4 v = *(const f32x4*)(T + r * 260 + lane * 4);
                if (kFp8O) v *= osc;
                if (XBF) { const u32x2 xo = *(const u32x2*)((const bf16_t*)xold + off); v[0] += bflo(xo[0]); v[1] += bfhi(xo[0]); v[2] += bflo(xo[1]); v[3] += bfhi(xo[1]); }
                else v += *(const f32x4*)((const float*)xold + off);
                __hip_atomic_store((unsigned long long*)(xb + off), ((unsigned long long)cvtpk(v[2], v[3]) << 32) | cvtpk(v[0], v[1]), __ATOMIC_RELAXED, __HIP_MEMORY_SCOPE_AGENT);
                if (xb8) { unsigned w = 0; w = __builtin_amdgcn_cvt_pk_fp8_f32(v[0], v[1], w, false); w = __builtin_amdgcn_cvt_pk_fp8_f32(v[2], v[3], w, true); __hip_atomic_store((unsigned*)(xb8 + off), w, __ATOMIC_RELAXED, __HIP_MEMORY_SCOPE_AGENT); }
            }
        }
    }
};
struct EpiKVQ {
    bf16_t* KV2; bf16_t* Q; const float* rstd; int row0, pn; float osc;
    __device__ __forceinline__ void operator()(const AccT& acc, int wr, int wc, int fr, int fq) const {
#pragma unroll
        for (int ai = 0; ai < 2; ++ai)
#pragma unroll
            for (int m = 0; m < 4; ++m) {
                const size_t row = (size_t)(row0 + ai * 128 + wr * 64 + m * 16 + fr);
                float rs = rstd[row] * osc; if (pn >= 4) rs *= QSCALE;
#pragma unroll
                for (int bj = 0; bj < 2; ++bj) {
                    const int col8 = bj * 128 + wc * 32 + 8 * fq;
                    const f32x4 v0 = acc[ai][bj][m][0] * rs, v1 = acc[ai][bj][m][1] * rs;
                    if (pn < 4) *(u32x4*)(KV2 + row * 1024 + pn * 256 + col8) = pack8v(v0, v1);
                    else *(u32x4*)(Q + row * DM + (pn - 4) * 256 + col8) = pack8v(v0, v1);
                }
            }
    }
};
template <bool FP8> struct EpiGU {
    void* H; const int* list; const float* rstd; int hrow0, pn, nvalid;
    __device__ __forceinline__ void operator()(const AccT& acc, int wr, int wc, int fr, int fq) const {
#pragma unroll
        for (int ai = 0; ai < 2; ++ai)
#pragma unroll
            for (int m = 0; m < 4; ++m) {
                const int lr = ai * 128 + wr * 64 + m * 16 + fr;
                if (lr < nvalid) {
                    const float rs = rstd[list[lr] >> 1] * (FP8 ? W8_INV : 1.f);
                    f32x4 h0, h1;
#pragma unroll
                    for (int j = 0; j < 4; ++j) {
                        const float g0 = acc[ai][0][m][0][j] * rs, u0 = acc[ai][1][m][0][j] * rs, g1 = acc[ai][0][m][1][j] * rs, u1 = acc[ai][1][m][1][j] * rs;
                        h0[j] = g0 * sigmoidf_(g0) * u0; h1[j] = g1 * sigmoidf_(g1) * u1;
                    }
                    const size_t off = (size_t)(hrow0 + lr) * DEXP + pn * 128 + wc * 32 + 8 * fq;
                    if (FP8) { const u32x2 w8 = pack8_fp8(h0, h1);
                        __hip_atomic_store((unsigned long long*)((unsigned char*)H + off), ((unsigned long long)w8[1] << 32) | w8[0], __ATOMIC_RELAXED, __HIP_MEMORY_SCOPE_AGENT); }
                    else *(u32x4*)((bf16_t*)H + off) = pack8v(h0, h1);
                }
            }
    }
};
struct EpiDN {
    bf16_t* Y; const int* list; int pn, nvalid; float oscale;
    __device__ __forceinline__ void operator()(const AccT& acc, int wr, int wc, int fr, int fq) const {
#pragma unroll
        for (int ai = 0; ai < 2; ++ai)
#pragma unroll
            for (int m = 0; m < 4; ++m) {
                const int lr = ai * 128 + wr * 64 + m * 16 + fr;
                if (lr < nvalid) {
                    bf16_t* rowp = Y + (size_t)list[lr] * DM + pn * 256 + wc * 32 + 8 * fq;
#pragma unroll
                    for (int bj = 0; bj < 2; ++bj) *(u32x4*)(rowp + bj * 128) = pack8v(acc[ai][bj][m][0] * oscale, acc[ai][bj][m][1] * oscale);
                }
            }
    }
};

struct CvtJob { const float* src; bf16_t* dst; const float* gain; int K, ld, ncols, tilesN, tilesKN; size_t srcE, dstE; int pA, pB, pC; bool f8; };
constexpr int NJOBS = 13;
__device__ __forceinline__ int job_tiles(int j) {
    switch (j) { case 0: return 16 * 41; case 1: case 2: return 32 * 2; case 3: return 16 * 16; case 4: return 16 * 8; case 5: case 6: return 16 * 16; default: return 4096; }
}
__device__ __forceinline__ void get_job(const Params& P, int j, CvtJob& J) {
    unsigned char* ws = P.ws;
    J.gain = nullptr; J.srcE = 0; J.dstE = 0; J.pA = 1 << 30; J.pB = 0; J.pC = 0; J.f8 = ((j >= 7) && kFp8[(j >= 10) ? 1 : 0]) || (kFp8P && (j == 0 || j == 4 || j == 5)) || (kFp8O && (j == 3 || j == 6));
    const int l = (j >= 10) ? 1 : 0;
    switch (j) {
    case 0: J.src = P.in[1]; J.dst = (bf16_t*)(ws + WS_WIN); J.K = 2048; J.ld = 5168; J.ncols = 5168; break;
    case 1: J.src = P.in[4]; J.dst = (bf16_t*)(ws + WS_CW1); J.K = 4096; J.ld = 256; J.ncols = 256; break;
    case 2: J.src = P.in[6]; J.dst = (bf16_t*)(ws + WS_CW1) + (size_t)256 * 4096; J.K = 4096; J.ld = 256; J.ncols = 256; break;
    case 3: J.src = P.in[8]; J.dst = (bf16_t*)(ws + WS_WOUT); J.K = 2048; J.ld = 2048; J.ncols = 2048; break;
    case 4: J.src = P.in[10]; J.dst = (bf16_t*)(ws + WS_WKVQ); J.K = 2048; J.ld = 1040; J.ncols = 1024; J.gain = P.in[9]; break;
    case 5: J.src = P.in[12]; J.dst = (bf16_t*)(ws + WS_WKVQ + (size_t)1024 * 2048 * (kFp8P ? 1 : 2)); J.K = 2048; J.ld = 2048; J.ncols = 2048; J.gain = P.in[14] + DM; break;
    case 6: J.src = P.in[13]; J.dst = (bf16_t*)(ws + WS_WFO); J.K = 2048; J.ld = 2048; J.ncols = 2048; break;
    case 7: case 10: J.src = P.in[18] + (size_t)l * 32 * 2048 * 1024; J.dst = (bf16_t*)(ws + WS_GU) + (size_t)l * 32 * 2048 * 2048; J.K = 2048; J.ld = 1024; J.ncols = 1024;
        J.gain = P.in[15] + l * DM; J.srcE = (size_t)2048 * 1024; J.dstE = (size_t)2048 * 2048; J.pA = 128; J.pB = 256; J.pC = 0; break;
    case 8: case 11: J.src = P.in[19] + (size_t)l * 32 * 2048 * 1024; J.dst = (bf16_t*)(ws + WS_GU) + (size_t)l * 32 * 2048 * 2048; J.K = 2048; J.ld = 1024; J.ncols = 1024;
        J.gain = P.in[15] + l * DM; J.srcE = (size_t)2048 * 1024; J.dstE = (size_t)2048 * 2048; J.pA = 128; J.pB = 256; J.pC = 128; break;
    default: J.src = P.in[20] + (size_t)l * 32 * 1024 * 2048; J.dst = (bf16_t*)(ws + WS_DN) + (size_t)l * 32 * 2048 * 1024; J.K = 1024; J.ld = 2048; J.ncols = 2048;
        J.srcE = (size_t)1024 * 2048; J.dstE = (size_t)2048 * 1024; break;
    }
    J.tilesN = (J.ncols + 127) / 128; J.tilesKN = J.tilesN * (J.K / 128);
}
struct CvtRegs { f32x4 v[8]; float gn[8]; };
__device__ __forceinline__ void cvt_load(const CvtJob& J, int idx, CvtRegs& R) {
    const int tid = threadIdx.x;
    const int e = idx / J.tilesKN, rem = idx - e * J.tilesKN, ktile = rem / J.tilesN, ntile = rem - ktile * J.tilesN;
    const float* src = J.src + (size_t)e * J.srcE;
    const int k0 = ktile * 128, n0 = ntile * 128, nn = (tid & 31) * 4;
    const bool okc = (n0 + nn) < J.ncols;
#pragma unroll
    for (int p = 0; p < 8; ++p) {
        const int kk = (tid >> 5) + 16 * p;
        R.v[p] = (f32x4){0.f, 0.f, 0.f, 0.f};
        if (okc) R.v[p] = __builtin_nontemporal_load((const f32x4*)(src + (size_t)(k0 + kk) * J.ld + n0 + nn));
        R.gn[p] = J.gain ? J.gain[k0 + kk] : 1.f;
    }
}
__device__ __forceinline__ void cvt_store(const CvtJob& J, int idx, const CvtRegs& R, float* T  ) {
    const int tid = threadIdx.x;
    const int e = idx / J.tilesKN, rem = idx - e * J.tilesKN, ktile = rem / J.tilesN, ntile = rem - ktile * J.tilesN;
    bf16_t* dst = J.dst + (size_t)e * J.dstE;
    const int k0 = ktile * 128, n0 = ntile * 128, nn = (tid & 31) * 4;
#pragma unroll
    for (int p = 0; p < 8; ++p) {
        const int kk = (tid >> 5) + 16 * p;
        float* t = T + kk * 129 + nn; const f32x4 v = R.v[p] * R.gn[p];
        t[0] = v[0]; t[1] = v[1]; t[2] = v[2]; t[3] = v[3];
    }
    __syncthreads();
    if (!J.f8) {
        const int kc = (tid & 15) * 8;
#pragma unroll
        for (int p = 0; p < 4; ++p) {
            const int n = (tid >> 4) + 32 * p, ng = n0 + n;
            if (ng < J.ncols) {
                const float* t = T + kc * 129 + n;
                f32x4 a = {t[0], t[129], t[258], t[387]}, b = {t[516], t[645], t[774], t[903]};
                const int drow = (ng / J.pA) * J.pB + J.pC + (ng % J.pA);
                *(u32x4*)(dst + (size_t)drow * J.K + k0 + kc) = pack8v(a, b);
            }
        }
    } else {
        const int kc = (tid & 7) * 16;
        unsigned char* dst8 = (unsigned char*)J.dst + (size_t)e * J.dstE;
#pragma unroll
        for (int p = 0; p < 2; ++p) {
            const int n = (tid >> 3) + 64 * p, ng = n0 + n;
            if (ng < J.ncols) {
                const float* t = T + kc * 129 + n;
                f32x4 a = {t[0], t[129], t[258], t[387]}, b = {t[516], t[645], t[774], t[903]}, c = {t[1032], t[1161], t[1290], t[1419]}, d = {t[1548], t[1677], t[1806], t[1935]};
                const u32x2 lo = pack8_fp8(a * W8_SCALE, b * W8_SCALE), hi = pack8_fp8(c * W8_SCALE, d * W8_SCALE);
                const int drow = (ng / J.pA) * J.pB + J.pC + (ng % J.pA);
                *(u32x4*)(dst8 + (size_t)drow * J.K + k0 + kc) = (u32x4){lo[0], lo[1], hi[0], hi[1]};
            }
        }
    }
    __syncthreads();
}
__device__ __forceinline__ int find_job(int g, int& jbase) { int b2 = 0, j = 0; for (; j < NJOBS - 1; ++j) { const int n = job_tiles(j); if (g < b2 + n) break; b2 += n; } jbase = b2; return j; }
__device__ __forceinline__ void phase_convert(const Params& P, unsigned char* lds, int jlo, int jhi) {
    float* T = (float*)lds;
    int base = 0;
    for (int j = 0; j < jlo; ++j) base += job_tiles(j);
    int total = base;
    for (int j = jlo; j < jhi; ++j) total += job_tiles(j);
    const int G = gridDim.x;
    int g0 = base + blockIdx.x;
    if (g0 >= total) return;
    CvtJob J0, J1, J2; CvtRegs R0, R1, R2; int b0, b1 = 0, b2 = 0;
    { const int j = find_job(g0, b0); get_job(P, j, J0); cvt_load(J0, g0 - b0, R0); }
    int g1 = g0 + G, g2 = g1 + G;
    if (g1 < total) { const int j = find_job(g1, b1); get_job(P, j, J1); cvt_load(J1, g1 - b1, R1); }
    for (;;) {
        if (g2 < total) { const int j = find_job(g2, b2); get_job(P, j, J2); cvt_load(J2, g2 - b2, R2); }
        cvt_store(J0, g0 - b0, R0, T);
        if (g1 >= total) break;
        J0 = J1; R0 = R1; b0 = b1; g0 = g1;
        J1 = J2; R1 = R2; b1 = b2; g1 = g2; g2 += G;
    }
}
__device__ __forceinline__ void phase0_misc(const Params& P, unsigned char* lds) {
    unsigned char* ws = P.ws;
    const int tid = threadIdx.x, lane = tid & 63, wave = tid >> 6;
    {
        const float* x = P.in[0]; const float* gain = P.in[14]; bf16_t* h0 = (bf16_t*)(ws + WS_XBA);
        for (int row = blockIdx.x * 8 + wave; row < NTOK; row += gridDim.x * 8) {
            const float* xr = x + (size_t)row * DM + lane * 4;
            f32x4 v[8]; float ss = 0.f;
#pragma unroll
            for (int j = 0; j < 8; ++j) { v[j] = *(const f32x4*)(xr + j * 256); ss += v[j][0] * v[j][0] + v[j][1] * v[j][1] + v[j][2] * v[j][2] + v[j][3] * v[j][3]; }
            ss = wave_sum(ss);
            const float rstd = rsqrtf(ss * (1.f / DM) + RMS_EPS);
#pragma unroll
            for (int j = 0; j < 8; ++j) {
                const f32x4 gv = *(const f32x4*)(gain + j * 256 + lane * 4);
                const f32x4 o = v[j] * rstd * gv;
                if (kFp8P) { unsigned w8 = 0; w8 = __builtin_amdgcn_cvt_pk_fp8_f32(o[0], o[1], w8, false); w8 = __builtin_amdgcn_cvt_pk_fp8_f32(o[2], o[3], w8, true); *(unsigned*)(ws + WS_XA8 + (size_t)row * DM + j * 256 + lane * 4) = w8; }
                else { u32x2 w = {cvtpk(o[0], o[1]), cvtpk(o[2], o[3])}; *(u32x2*)(h0 + (size_t)row * DM + j * 256 + lane * 4) = w; }
            }
        }
    }
    {
        float* rw = (float*)(ws + WS_RW); float* wf = (float*)(ws + WS_WF);
        const int gtid = blockIdx.x * NTHREADS + tid, gsz = gridDim.x * NTHREADS;
        for (int i = gtid; i < 2 * 2048 * 32; i += gsz) { const int l = i >> 16, k = (i >> 5) & 2047, e = i & 31; rw[i] = P.in[15][l * DM + k] * P.in[16][k * 32 + e]; }
        for (int i = gtid; i < 2048 * 32; i += gsz) { const int k = i >> 5, j = i & 31; wf[i] = (j < 16) ? P.in[9][k] * P.in[10][(size_t)k * 1040 + 1024 + j] : 0.f; }
    }
    for (int w = blockIdx.x; w < 64; w += gridDim.x) {
        const int kv = w >> 5, ch = w & 31; const float* pe = P.in[kv ? 3 : 2]; const float* w1 = P.in[kv ? 6 : 4];
        float* red = (float*)lds;
        const int j = tid & 255, half = tid >> 8; float s = 0.f;
        const int i0 = ch * 128 + half * 64;
#pragma unroll 16
        for (int i = i0; i < i0 + 64; ++i) s += pe[i] * w1[(size_t)i * 256 + j];
        __syncthreads();
        red[tid] = s; __syncthreads();
        if (tid < 256) ((float*)(ws + WS_BIAS1))[(kv * 32 + ch) * 256 + tid] = red[tid] + red[tid + 256];
        __syncthreads();
    }
}

__device__ __forceinline__ void lin_offsets(int tid, unsigned lda, unsigned& a0, unsigned& a1, unsigned& a2, unsigned& a3) {
    int R0, C; stage_rc(tid * 16, R0, C);
    a0 = (unsigned)R0 * lda + C * 2; a1 = (unsigned)(R0 + 64) * lda + C * 2; a2 = (unsigned)(R0 + 128) * lda + C * 2; a3 = (unsigned)(R0 + 192) * lda + C * 2;
}
__device__ __forceinline__ void phase_proj0(const Params& P, unsigned char* lds) {
    unsigned char* ws = P.ws;
    constexpr unsigned EB = kFp8P ? 1u : 2u;
    unsigned a0, a1, a2, a3; lin_offsets(threadIdx.x, DM * EB, a0, a1, a2, a3);
    for (int L = blockIdx.x; L < 64 * 21; L += gridDim.x) {
        int pm, pn; tile_order(L, 64, 21, pm, pn);
        EpiProj0 E{(bf16_t*)(ws + WS_Q), (bf16_t*)(ws + WS_KV6), (float*)(ws + WS_GATES), pm * 256, pn, kFp8P ? W8_INV : 1.f};
        gemm256<true, kFp8P>(lds, (const char*)(ws + (kFp8P ? WS_XA8 : WS_XBA)) + (size_t)pm * 256 * DM * EB, (const char*)(ws + WS_WIN) + (size_t)pn * 256 * DM * EB, DM * EB, 256u, DM * EB / 128,
                             a0, a1, a2, a3, E);
    }
}
__device__ __forceinline__ void phase_cmp1(const Params& P, unsigned char* lds) {
    unsigned char* ws = P.ws;
    int R0, C; stage_rc(threadIdx.x * 16, R0, C);
    for (int u = blockIdx.x; u < 256; u += gridDim.x) {
        const int kv = u >> 7, mt = (u >> 3) & 15, ks = u & 7;
        unsigned ao[4];
#pragma unroll
        for (int q = 0; q < 4; ++q) {
            int r = mt * 256 + R0 + 64 * q; if (r > 4063) r = 4063;
            const int b = r / 508, rem = r - b * 508, n = rem >> 2, g = rem & 3;
            ao[q] = (unsigned)(((b * SEQ + n * 16) * KV6_W + kv * 512 + g * 128 + C) * 2);
        }
        EpiF32 E{(float*)(ws + WS_CPART) + ((size_t)(kv * 8 + ks) * 4096 + mt * 256) * 256};
        gemm256<false, false>(lds, (const char*)(ws + WS_KV6) + (size_t)ks * 4 * KV6_W * 2, (const char*)(ws + WS_CW1) + ((size_t)kv * 256 * 4096 + ks * 512) * 2, 4096 * 2,
                       (unsigned)(KV6_W * 2), 8, ao[0], ao[1], ao[2], ao[3], E);
    }
}
__device__ __forceinline__ float gelu_tanh(float x) {
    const float u = 0.7978845608028654f * (x + 0.044715f * x * x * x);
    const float t = 1.f - 2.f * fast_rcp(1.f + fast_exp2(2.f * LOG2E * u));
    return 0.5f * x * (1.f + t);
}
__device__ __forceinline__ void phase_cmp2(const Params& P, unsigned char* lds) {
    unsigned char* ws = P.ws;
    const int tid = threadIdx.x;
    float* hid = (float*)lds;
    const float* part = (const float*)(ws + WS_CPART);
    bf16_t* kvc = (bf16_t*)(ws + WS_KVCMP);
    for (int grp = blockIdx.x; grp < 256; grp += gridDim.x) {
        const int kv = grp >> 7, r0 = (grp & 127) * 32;
        {
            const int col = tid & 255, i0 = tid >> 8;
            float bias = 0.f;
#pragma unroll 8
            for (int ch = 0; ch < 32; ++ch) bias += ((const float*)(ws + WS_BIAS1))[(kv * 32 + ch) * 256 + col];
#pragma unroll 4
            for (int ii = 0; ii < 16; ++ii) {
                const int i = i0 + 2 * ii, r = r0 + i;
                float s = bias;
#pragma unroll
                for (int ks = 0; ks < 8; ++ks) s += part[((size_t)(kv * 8 + ks) * 4096 + r) * 256 + col];
                hid[i * 256 + col] = gelu_tanh(s);
            }
        }
        __syncthreads();
        {
            const float* w2 = P.in[kv ? 7 : 5];
            const int j = tid & 127, i0 = tid >> 7;
            float acc[8];
#pragma unroll
            for (int ii = 0; ii < 8; ++ii) acc[ii] = 0.f;
            for (int k = 0; k < 256; k += 4) {
                const float w0 = w2[(k + 0) * 128 + j], w1 = w2[(k + 1) * 128 + j], w2v = w2[(k + 2) * 128 + j], w3 = w2[(k + 3) * 128 + j];
#pragma unroll
                for (int ii = 0; ii < 8; ++ii) {
                    const f32x4 h = *(const f32x4*)(hid + (i0 + 4 * ii) * 256 + k);
                    acc[ii] += h[0] * w0 + h[1] * w1 + h[2] * w2v + h[3] * w3;
                }
            }
#pragma unroll
            for (int ii = 0; ii < 8; ++ii) {
                const int r = r0 + i0 + 4 * ii;
                if (r < 4064) {
                    const int b = r / 508, rem = r - b * 508, n = rem >> 2, g = rem & 3;
                    const float v = acc[ii], vn = __shfl_xor(v, 1);
                    if ((j & 1) == 0) *(unsigned*)(kvc + (size_t)kv * (8 * 128 * 512) + ((size_t)(b * 128 + n) * 4 + g) * 128 + j) = cvtpk(v, vn);
                }
            }
        }
        __syncthreads();
    }
    if (blockIdx.x == 0) {
        for (int i = tid; i < 2 * 8 * 512 / 2; i += NTHREADS) { const int kv = i >> 11, b = (i >> 8) & 7, c2 = i & 255;
            *(unsigned*)(kvc + (size_t)kv * (8 * 128 * 512) + ((size_t)(b * 128 + 127) * 512) + c2 * 2) = 0u; }
    }
}
template <bool XBF>
__device__ __forceinline__ void phase_outproj(const Params& P, unsigned char* lds, size_t wsW, const void* xold, bf16_t* xb, unsigned char* xb8, int layer) {
    unsigned char* ws = P.ws;
    constexpr unsigned EB = kFp8O ? 1u : 2u;
    unsigned a0, a1, a2, a3; lin_offsets(threadIdx.x, DM * EB, a0, a1, a2, a3);
    for (int L = blockIdx.x; L < 64 * 8; L += gridDim.x) {
        int pm, pn; tile_order(L, 64, 8, pm, pn);
        {
            if (threadIdx.x < 64) {
                unsigned* cnt = (unsigned*)(ws + WS_CTL) + CW_AC + (layer * 64 + pm) * 16; unsigned* tmo = (unsigned*)(ws + WS_CTL) + CW_BAR + XB_TMO; unsigned sp = 0;
                while ((unsigned)__builtin_amdgcn_readfirstlane(__hip_atomic_load(cnt, __ATOMIC_RELAXED, __HIP_MEMORY_SCOPE_AGENT)) < 16u) {
                    __builtin_amdgcn_s_sleep(1);
                    if ((++sp & 255u) == 0u) { if (xb_ld(tmo)) break; if (sp > XB_SPIN_CAP) { if (threadIdx.x == 0) atomicAdd(tmo, 1u); break; } } }
                __builtin_amdgcn_fence(__ATOMIC_ACQUIRE, "agent");
                asm volatile("s_waitcnt vmcnt(0)" ::: "memory");
            }
            __syncthreads();
        }
        EpiOut<XBF> E{xold, xb, xb8, pm * 256, pn * 256, lds, W8_INV / OATT_SCALE};
        gemm256<true, kFp8O>(lds, (const char*)(ws + (kFp8O ? WS_OATT8 : WS_OATT)) + (size_t)pm * 256 * DM * EB, (const char*)(ws + wsW) + (size_t)pn * 256 * DM * EB, DM * EB, 256u, DM * EB / 128, a0, a1, a2, a3, E);
        asm volatile("s_waitcnt vmcnt(0)" ::: "memory"); __syncthreads();
        if (threadIdx.x == 0) __hip_atomic_fetch_add((unsigned*)(ws + WS_CTL) + CW_PC + (layer * 64 + pm) * 16, 1u, __ATOMIC_RELAXED, __HIP_MEMORY_SCOPE_AGENT);
    }
}
__device__ __forceinline__ void phase_kvq(const Params& P, unsigned char* lds) {
    unsigned char* ws = P.ws;
    constexpr unsigned EB = kFp8P ? 1u : 2u;
    unsigned a0, a1, a2, a3; lin_offsets(threadIdx.x, DM * EB, a0, a1, a2, a3);
    for (int L = blockIdx.x; L < 64 * 12; L += gridDim.x) {
        int pm, pn; tile_order(L, 64, 12, pm, pn);
        {
            if (threadIdx.x < 64) {
                unsigned* cnt = (unsigned*)(ws + WS_CTL) + CW_CC + pm * 16; unsigned* tmo = (unsigned*)(ws + WS_CTL) + CW_BAR + XB_TMO; unsigned sp = 0;
                while ((unsigned)__builtin_amdgcn_readfirstlane(__hip_atomic_load(cnt, __ATOMIC_RELAXED, __HIP_MEMORY_SCOPE_AGENT)) < 4u) {
                    __builtin_amdgcn_s_sleep(1);
                    if ((++sp & 255u) == 0u) { if (xb_ld(tmo)) break; if (sp > XB_SPIN_CAP) { if (threadIdx.x == 0) atomicAdd(tmo, 1u); break; } } }
                __builtin_amdgcn_fence(__ATOMIC_ACQUIRE, "agent");
                asm volatile("s_waitcnt vmcnt(0)" ::: "memory");
            }
            __syncthreads();
        }
        EpiKVQ E{(bf16_t*)(ws + WS_KV2), (bf16_t*)(ws + WS_Q), (const float*)(ws + WS_RSTD) + NTOK, pm * 256, pn, kFp8P ? W8_INV : 1.f};
        gemm256<true, kFp8P>(lds, (const char*)(ws + (kFp8P ? WS_XA8 : WS_XBA)) + (size_t)pm * 256 * DM * EB, (const char*)(ws + WS_WKVQ) + (size_t)pn * 256 * DM * EB, DM * EB, 256u, DM * EB / 128,
                             a0, a1, a2, a3, E);
    }
    const int wave = threadIdx.x >> 6, lane = threadIdx.x & 63;
    for (int gw = blockIdx.x * 8 + wave; gw < 128; gw += gridDim.x * 8) {
        const int b = gw >> 4, h = gw & 15;
        {
            unsigned* cnt = (unsigned*)(ws + WS_CTL) + CW_CC + (64 + b) * 16; unsigned* tmo = (unsigned*)(ws + WS_CTL) + CW_BAR + XB_TMO; unsigned sp = 0;
            while ((unsigned)__builtin_amdgcn_readfirstlane(__hip_atomic_load(cnt, __ATOMIC_RELAXED, __HIP_MEMORY_SCOPE_AGENT)) < 32u) {
                __builtin_amdgcn_s_sleep(1);
                if ((++sp & 255u) == 0u) { if (xb_ld(tmo)) break; if (sp > XB_SPIN_CAP) { if (lane == 0) atomicAdd(tmo, 1u); break; } } }
            __builtin_amdgcn_fence(__ATOMIC_ACQUIRE, "agent");
            asm volatile("s_waitcnt vmcnt(0)" ::: "memory");
        }
        const float* lf = (const float*)(ws + WS_LOGF) + ((size_t)b * SEQ + lane * 32) * 16 + h;
        float v[32]; float s = 0.f;
#pragma unroll
        for (int i = 0; i < 32; ++i) { s += lf[i * 16]; v[i] = s; }
        float incl = s;
#pragma unroll
        for (int o = 1; o < 64; o <<= 1) { const float t = __shfl_up(incl, o); if (lane >= o) incl += t; }
        const float excl = incl - s;
        float* c2 = (float*)(ws + WS_C2) + ((size_t)b * 16 + h) * SEQ + lane * 32;
#pragma unroll
        for (int i = 0; i < 32; ++i) c2[i] = (excl + v[i]) * LOG2E;
    }
}
__device__ __forceinline__ void moe_table(const unsigned* gcnt, int* tl  ) {
    if (threadIdx.x == 0) { int s = 0; for (int e = 0; e < 32; ++e) { const int c = (int)__hip_atomic_load(gcnt + e * 64, __ATOMIC_RELAXED, __HIP_MEMORY_SCOPE_AGENT); tl[40 + e] = c; tl[e] = s; s += (c + 255) >> 8; } tl[32] = s; }
    __syncthreads();
}
template <bool FP8>
__device__ __forceinline__ void phase_moe_gu(const Params& P, unsigned char* lds, int layer) {
    unsigned char* ws = P.ws;
    int* tl = (int*)(lds + 131072);
    moe_table((const unsigned*)(ws + WS_CTL) + CW_CNT + layer * 32 * 64, tl);
    const int ntiles = tl[32];
    int R0, C; stage_rc(threadIdx.x * 16, R0, C);
    const float* rstd = (const float*)(ws + WS_RSTD) + (layer ? 2 * NTOK : 0);
    constexpr unsigned EB = FP8 ? 1u : 2u;
    const char* xb = FP8 ? (const char*)(ws + WS_XB8) : (const char*)(ws + WS_XBB);
    for (int u = blockIdx.x; u < ntiles * 8; u += gridDim.x) {
        const int ti = u >> 3, pn = u & 7;
        int e = 0;
        for (int q = 1; q < 32; ++q) if (tl[q] <= ti) e = q;
        e = __builtin_amdgcn_readfirstlane(e);
        const int mt = __builtin_amdgcn_readfirstlane(ti - tl[e]), nvalid = __builtin_amdgcn_readfirstlane(min(256, tl[40 + e] - mt * 256));
        const int* list = (const int*)(ws + WS_LIST) + ((size_t)(layer * 32 + e) * LISTCAP + mt * 256);
        unsigned ao[4];
#pragma unroll
        for (int q = 0; q < 4; ++q) { const int lr = R0 + 64 * q; const int tok = (lr < nvalid) ? (list[lr] >> 1) : 0; ao[q] = (unsigned)tok * (DM * EB) + C * 2; }
        EpiGU<FP8> E{(void*)(ws + WS_H), list, rstd, ti * 256, pn, nvalid};
        gemm256<true, FP8>(lds, xb, (const char*)(ws + WS_GU) + (size_t)layer * 32 * 2048 * 2048 * 2 + ((size_t)e * 2048 + pn * 256) * DM * EB, DM * EB, 256u, DM * EB / 128, ao[0], ao[1], ao[2], ao[3], E);
        if (FP8) {
            asm volatile("s_waitcnt vmcnt(0)" ::: "memory"); __syncthreads();
            if (threadIdx.x == 0) __hip_atomic_fetch_add((unsigned*)(ws + WS_CTL) + CW_HC + (layer * 160 + ti) * 16, 1u, __ATOMIC_RELAXED, __HIP_MEMORY_SCOPE_AGENT);
        }
    }
}
template <bool FP8>
__device__ __forceinline__ void phase_moe_dn(const Params& P, unsigned char* lds, int layer) {
    unsigned char* ws = P.ws;
    int* tl = (int*)(lds + 131072);
    moe_table((const unsigned*)(ws + WS_CTL) + CW_CNT + layer * 32 * 64, tl);
    const int ntiles = tl[32];
    constexpr unsigned EB = FP8 ? 1u : 2u;
    unsigned a0, a1, a2, a3; lin_offsets(threadIdx.x, DEXP * EB, a0, a1, a2, a3);
    const int ngu = ntiles * 8, G = gridDim.x;
    int u0 = blockIdx.x; if (FP8) { u0 = (int)blockIdx.x + ((ngu - (int)blockIdx.x + G - 1) / G) * G - ngu; }
    for (int u = u0; u < ntiles * 8; u += G) {
        const int ti = u >> 3, pn = u & 7;
        if (FP8) {
            if (threadIdx.x < 64) {
                unsigned* cnt = (unsigned*)(ws + WS_CTL) + CW_HC + (layer * 160 + ti) * 16; unsigned* tmo = (unsigned*)(ws + WS_CTL) + CW_BAR + XB_TMO; unsigned sp = 0;
                while ((unsigned)__builtin_amdgcn_readfirstlane(__hip_atomic_load(cnt, __ATOMIC_RELAXED, __HIP_MEMORY_SCOPE_AGENT)) < 8u) {
                    __builtin_amdgcn_s_sleep(1);
                    if ((++sp & 255u) == 0u) { if (xb_ld(tmo)) break; if (sp > XB_SPIN_CAP) { if (threadIdx.x == 0) atomicAdd(tmo, 1u); break; } } }
                __builtin_amdgcn_fence(__ATOMIC_ACQUIRE, "agent");
                asm volatile("s_waitcnt vmcnt(0)" ::: "memory");
            }
            __syncthreads();
        }
        int e = 0;
        for (int q = 1; q < 32; ++q) if (tl[q] <= ti) e = q;
        e = __builtin_amdgcn_readfirstlane(e);
        const int mt = __builtin_amdgcn_readfirstlane(ti - tl[e]), nvalid = __builtin_amdgcn_readfirstlane(min(256, tl[40 + e] - mt * 256));
        const int* list = (const int*)(ws + WS_LIST) + ((size_t)(layer * 32 + e) * LISTCAP + mt * 256);
        EpiDN E{(bf16_t*)(ws + WS_Y), list, pn, nvalid, FP8 ? W8_INV : 1.f};
        gemm256<true, FP8>(lds, (const char*)(ws + WS_H) + (size_t)ti * 256 * DEXP * EB, (const char*)(ws + WS_DN) + (size_t)layer * 32 * 2048 * 1024 * 2 + ((size_t)e * 2048 + pn * 256) * DEXP * EB,
                           DEXP * EB, 256u, DEXP * EB / 128, a0, a1, a2, a3, E);
    }
}


constexpr int AT_V = 0, AT_K = 32768, AT_KB = 65536, AT_WS = 67584, AT_IMP = 69632, AT_VALS = 136192, AT_SEL = 144640;
#define KSWZ(row, colB) ((row) * 256 + ((colB) ^ (((row) & 7) << 4)))
__device__ __forceinline__ int v_st(int k, int c) { const int kk = (k & ~0xC) | ((k & 4) << 1) | ((k & 8) >> 1); return ((kk >> 3) * 4 + (c >> 5)) * 512 + ((kk & 7) * 32 + (c & 31)) * 2; }
__device__ __forceinline__ int v_rd_base(int lane) { return ((lane & 3) << 3) | (((lane >> 2) & 3) << 6) | (((lane >> 4) & 1) << 5) | (((lane >> 5) & 1) << 8); }
constexpr int v_rd_off(int d0, int ks, int half) { return d0 * 512 + ks * 4096 + half * 2048; }
__device__ __forceinline__ int crow(int r, int hi) { return (r & 3) + 8 * (r >> 2) + 4 * hi; }

template <int KB>
__device__ __forceinline__ void attn_qkt(f32x16& p0, f32x16& p1, const char* K_lds, int r32, int hi, const bf16x8 (&qr)[8]) {
    p0 = f32x16{}; p1 = f32x16{};
    const char* kb[4];
#pragma unroll
    for (int dd = 0; dd < 4; ++dd) kb[dd] = K_lds + KB * 16384 + KSWZ(r32, (dd * 16 + hi * 8) * 2);
#pragma unroll
    for (int d0 = 0; d0 < 8; ++d0) { const char* a = kb[d0 & 3] + (d0 >> 2) * 128;
        bf16x8 b0 = *reinterpret_cast<const bf16x8*>(a);
        bf16x8 b1 = *reinterpret_cast<const bf16x8*>(a + 32 * 256);
        p0 = __builtin_amdgcn_mfma_f32_32x32x16_bf16(b0, qr[d0], p0, 0, 0, 0);
        p1 = __builtin_amdgcn_mfma_f32_32x32x16_bf16(b1, qr[d0], p1, 0, 0, 0); }
}
template <int VB>
__device__ __forceinline__ void attn_pv(f32x16 (&o)[4], int vb0, bf16x8 pa0, bf16x8 pa1, bf16x8 pa2, bf16x8 pa3) {
#define TRRD(dst, off) asm volatile("ds_read_b64_tr_b16 %0, %1 offset:%2" : "=&v"(dst) : "v"(vb0), "i"(off) : "memory")
#define PV_D0(d0) do { s16x4 l0, l1, l2, l3, h0, h1, h2, h3; constexpr int b_ = VB * 16384 + v_rd_off(d0, 0, 0); \
        TRRD(l0, b_); TRRD(h0, b_ + 2048); TRRD(l1, b_ + 4096); TRRD(h1, b_ + 6144); TRRD(l2, b_ + 8192); TRRD(h2, b_ + 10240); TRRD(l3, b_ + 12288); TRRD(h3, b_ + 14336); \
        asm volatile("s_waitcnt lgkmcnt(0)" ::: "memory"); __builtin_amdgcn_sched_barrier(0); \
        o[d0] = __builtin_amdgcn_mfma_f32_32x32x16_bf16(pa0, (bf16x8){l0[0], l0[1], l0[2], l0[3], h0[0], h0[1], h0[2], h0[3]}, o[d0], 0, 0, 0); \
        o[d0] = __builtin_amdgcn_mfma_f32_32x32x16_bf16(pa1, (bf16x8){l1[0], l1[1], l1[2], l1[3], h1[0], h1[1], h1[2], h1[3]}, o[d0], 0, 0, 0); \
        o[d0] = __builtin_amdgcn_mfma_f32_32x32x16_bf16(pa2, (bf16x8){l2[0], l2[1], l2[2], l2[3], h2[0], h2[1], h2[2], h2[3]}, o[d0], 0, 0, 0); \
        o[d0] = __builtin_amdgcn_mfma_f32_32x32x16_bf16(pa3, (bf16x8){l3[0], l3[1], l3[2], l3[3], h3[0], h3[1], h3[2], h3[3]}, o[d0], 0, 0, 0); } while (0)
    PV_D0(0); PV_D0(1); PV_D0(2); PV_D0(3);
#undef PV_D0
#undef TRRD
}
#define PK4(P, B_, OUT) do { unsigned a0 = cvtpk(P[B_+0], P[B_+1]), a1 = cvtpk(P[B_+2], P[B_+3]); \
        unsigned b0 = cvtpk(P[B_+4], P[B_+5]), b1 = cvtpk(P[B_+6], P[B_+7]); \
        auto r0 = __builtin_amdgcn_permlane32_swap(a0, b0, false, false); auto r1 = __builtin_amdgcn_permlane32_swap(a1, b1, false, false); \
        u32x4 w = {r0[0], r1[0], r0[1], r1[1]}; OUT = *reinterpret_cast<bf16x8*>(&w); } while (0)
__device__ __forceinline__ float row_max2(float v) { auto rr = __builtin_amdgcn_permlane32_swap(__float_as_uint(v), __float_as_uint(v), false, false); return fmaxf(__uint_as_float(rr[0]), __uint_as_float(rr[1])); }
__device__ __forceinline__ float row_sum2(float v) { auto rr = __builtin_amdgcn_permlane32_swap(__float_as_uint(v), __float_as_uint(v), false, false); return __uint_as_float(rr[0]) + __uint_as_float(rr[1]); }

struct KVAddr { unsigned ldsw, ldsb, voffK, voffV, ldb; };
__device__ __forceinline__ KVAddr kv_addr(const char* lds, int tid, int wave, unsigned ldb) {
    KVAddr A; A.ldsb = lds_addr(lds); A.ldsw = A.ldsb + (unsigned)wave * 1024u; A.ldb = ldb;
    const int row = tid >> 4, cp = tid & 15;
    A.voffK = (unsigned)row * ldb + (unsigned)((cp ^ (row & 7)) * 16);
    const int k = ((tid >> 2) & 3) | (((tid >> 7) & 1) << 2) | (((tid >> 4) & 1) << 3) | (((tid >> 8) & 1) << 4);
    const int c = ((tid >> 5) & 3) * 32 + (tid & 3) * 8;
    A.voffV = (unsigned)k * ldb + (unsigned)c * 2u;
    return A;
}
template <int BUF>
__device__ __forceinline__ void kv_issue(const KVAddr& A, const bf16_t* Kp, const bf16_t* Vp, int key0, const float* ctab, int wave, int lane) {
    const char* kb = (const char*)Kp + (size_t)key0 * A.ldb; const char* vb = (const char*)Vp + (size_t)key0 * A.ldb;
    glds16(A.voffK, kb, A.ldsw + AT_K + BUF * 16384); glds16(A.voffK, kb + (size_t)32 * A.ldb, A.ldsw + AT_K + BUF * 16384 + 8192);
    glds16(A.voffV, vb, A.ldsw + AT_V + BUF * 16384); glds16(A.voffV, vb + (size_t)32 * A.ldb, A.ldsw + AT_V + BUF * 16384 + 8192);
    if (ctab != nullptr && wave < 4) glds4((unsigned)lane * 4u, ctab + (size_t)wave * SEQ + key0, A.ldsb + AT_KB + BUF * 1024 + (unsigned)wave * 256u);
}
template <int BUF>
__device__ __forceinline__ void kb_alibi(char* lds, int tid, float sl2_t, int key0) {
    if (tid < 256) ((float*)(lds + AT_KB))[BUF * 256 + tid] = -sl2_t * (float)(key0 + (tid & 63));
}
template <int BUF, bool ALIBI>
__device__ __forceinline__ void attn_tile(char* lds, const bf16x8 (&qr)[8], f32x16 (&o)[4], float& m_reg, float& l_reg, float rb, int dq, unsigned W,
                                          bool needmask, int wave, int r32, int hi, int vb0, float sl2w, int key0) {
    f32x16 p0, p1;
    attn_qkt<BUF>(p0, p1, lds + AT_K, r32, hi, qr);
    const float NEG = -__builtin_inff();
    if (ALIBI) {
        const float t0 = rb + sl2w * (float)(key0 + 4 * hi);
#pragma unroll
        for (int r = 0; r < 16; ++r) { const float cr = (float)((r & 3) + 8 * (r >> 2));
            p0[r] = fmaf(sl2w, cr, fmaf(p0[r], LOG2E, t0)); p1[r] = fmaf(sl2w, cr + 32.f, fmaf(p1[r], LOG2E, t0)); }
    } else {
        const float* kbp = (const float*)(lds + AT_KB) + BUF * 256 + (wave & 3) * 64 + 4 * hi;
#pragma unroll
        for (int g2 = 0; g2 < 4; ++g2) {
            const f32x4 ka = *(const f32x4*)(kbp + 8 * g2), kc = *(const f32x4*)(kbp + 32 + 8 * g2);
#pragma unroll
            for (int i = 0; i < 4; ++i) { p0[4 * g2 + i] = fmaf(p0[4 * g2 + i], LOG2E, rb - ka[i]); p1[4 * g2 + i] = fmaf(p1[4 * g2 + i], LOG2E, rb - kc[i]); }
        }
    }
    if (needmask) {
#pragma unroll
        for (int r = 0; r < 16; ++r) { const int c = (r & 3) + 8 * (r >> 2);
            if ((unsigned)(dq - c) >= W) p0[r] = NEG;
            if ((unsigned)(dq - c - 32) >= W) p1[r] = NEG; }
    }
    float pmax = p0[0];
#pragma unroll
    for (int r = 1; r < 16; ++r) pmax = fmaxf(pmax, p0[r]);
#pragma unroll
    for (int r = 0; r < 16; ++r) pmax = fmaxf(pmax, p1[r]);
    pmax = row_max2(pmax);
    const float mn = fmaxf(m_reg, pmax), alpha = fast_exp2(m_reg - mn);
    m_reg = mn;
    float ps = 0.f;
#pragma unroll
    for (int r = 0; r < 16; ++r) { p0[r] = fast_exp2(p0[r] - mn); ps += p0[r]; }
#pragma unroll
    for (int r = 0; r < 16; ++r) { p1[r] = fast_exp2(p1[r] - mn); ps += p1[r]; }
    ps = row_sum2(ps);
    l_reg = l_reg * alpha + ps;
    if (__any(alpha < 1.f)) {
        float* al = (float*)(lds + AT_WS) + wave * 64;
        if (hi == 0) al[r32] = alpha;
        asm volatile("s_waitcnt lgkmcnt(0)" ::: "memory");
#pragma unroll
        for (int g2 = 0; g2 < 4; ++g2) { const f32x4 a4 = *(const f32x4*)(al + 8 * g2 + 4 * hi);
#pragma unroll
            for (int d0 = 0; d0 < 4; ++d0)
#pragma unroll
                for (int i = 0; i < 4; ++i) o[d0][4 * g2 + i] *= a4[i]; }
    }
    bf16x8 pa0, pa1, pa2, pa3;
    PK4(p0, 0, pa0); PK4(p0, 8, pa1); PK4(p1, 0, pa2); PK4(p1, 8, pa3);
    attn_pv<BUF>(o, vb0, pa0, pa1, pa2, pa3);
}
template <bool SELB, bool ALIBI>
__device__ __forceinline__ void attn_branch(char* lds, const KVAddr& A, const bf16x8 (&qr)[8], f32x16 (&o)[4], float& m_reg, float& l_reg, unsigned tilemask,
                                            const bf16_t* Kp, const bf16_t* Vp, const float* ctab, float sl2_t, float rowb, unsigned selw,
                                            int tq, int tq0w, unsigned W, int wave, int lane, int r32, int hi, int vb0, float sl2w) {
    const int tid = wave * 64 + lane;
    unsigned tm = tilemask;
    int j = 31 - __builtin_clz(tm); tm &= ~(1u << j);
    kv_issue<0>(A, Kp, Vp, j * 64, ctab, wave, lane);
    if (!ALIBI && ctab == nullptr) kb_alibi<0>(lds, tid, sl2_t, j * 64);
    const float NEG = -__builtin_inff();
#define ATT_STEP(BUF, NBUF) { \
        asm volatile("s_waitcnt vmcnt(0)" ::: "memory"); \
        __syncthreads(); \
        int jn = -1; if (tm) { jn = 31 - __builtin_clz(tm); tm &= ~(1u << jn); kv_issue<NBUF>(A, Kp, Vp, jn * 64, ctab, wave, lane); if (!ALIBI && ctab == nullptr) kb_alibi<NBUF>(lds, tid, sl2_t, jn * 64); } \
        { const int key0 = j * 64; \
          const bool rsel = SELB ? (((selw >> j) & 1u) != 0u) : true; \
          bool active = (key0 <= tq0w + 31) && ((tq0w - key0 - 63) < (int)W); \
          if (SELB) active = active && __any(rsel); \
          if (active) { \
              const bool needmask = (key0 + 63 > tq0w) || ((unsigned)(tq0w + 31 - key0) >= W); \
              attn_tile<BUF, ALIBI>(lds, qr, o, m_reg, l_reg, rsel ? rowb : NEG, tq - key0 - 4 * hi, W, needmask, wave, r32, hi, vb0, sl2w, key0); } } \
        if (jn < 0) break; \
        j = jn; }
    for (;;) { ATT_STEP(0, 1) ATT_STEP(1, 0) }
#undef ATT_STEP
    __syncthreads();
}
template <bool ADD, bool F8 = false>
__device__ __forceinline__ void attn_store(bf16_t* Obase  , const f32x16 (&o)[4], char* lds, float srow, int wave, int lane, int r32, int hi, unsigned* done_cnt = nullptr, unsigned char* O8base = nullptr) {
    float* sc = (float*)(lds + AT_WS) + wave * 64 + 32;
    if (hi == 0) sc[r32] = srow;
    asm volatile("s_waitcnt lgkmcnt(0)" ::: "memory");
    char* tile = lds + AT_V + wave * 8192;
    char* tb = tile + hi * 1024 + r32 * 2;
#pragma unroll
    for (int g2 = 0; g2 < 4; ++g2) { const f32x4 s4 = *(const f32x4*)(sc + 8 * g2 + 4 * hi);
#pragma unroll
        for (int i = 0; i < 4; ++i) { const int r = 4 * g2 + i;
#pragma unroll
            for (int d0 = 0; d0 < 4; ++d0) *(bf16_t*)(tb + ((r & 3) + 8 * (r >> 2)) * 256 + d0 * 64) = (bf16_t)(cvtpk(o[d0][r] * s4[i], 0.f) & 0xffffu); } }
    asm volatile("s_waitcnt lgkmcnt(0)" ::: "memory");
    int ln = lane; asm volatile("" : "+v"(ln));
    unsigned* gp = (unsigned*)Obase + ln;
    const unsigned* tp = (const unsigned*)tile + ln;
#pragma unroll
    for (int rb = 0; rb < 32; rb += 8) {
        unsigned w[8], old[8];
#pragma unroll
        for (int q = 0; q < 8; ++q) { w[q] = tp[(rb + q) * 64]; if (ADD) old[q] = gp[(size_t)(rb + q) * (DM / 2)]; }
#pragma unroll
        for (int q = 0; q < 8; ++q) {
            unsigned v = w[q];
            if (F8) {
                float lo = bflo(w[q]), hv = bfhi(w[q]); if (ADD) { lo += bflo(old[q]); hv += bfhi(old[q]); }
                const unsigned p8 = __builtin_amdgcn_cvt_pk_fp8_f32(lo * OATT_SCALE, hv * OATT_SCALE, 0u, false);
                __hip_atomic_store((unsigned short*)O8base + (size_t)(rb + q) * (DM / 2) + ln, (unsigned short)(p8 & 0xffffu), __ATOMIC_RELAXED, __HIP_MEMORY_SCOPE_AGENT);
                continue; }
            if (ADD) v = cvtpk(bflo(w[q]) + bflo(old[q]), bfhi(w[q]) + bfhi(old[q]));
            __hip_atomic_store(gp + (size_t)(rb + q) * (DM / 2), v, __ATOMIC_RELAXED, __HIP_MEMORY_SCOPE_AGENT); }
    }
    if (done_cnt) asm volatile("s_waitcnt vmcnt(0)" ::: "memory");
    __syncthreads();
    if (done_cnt && threadIdx.x == 0) __hip_atomic_fetch_add(done_cnt, 1u, __ATOMIC_RELAXED, __HIP_MEMORY_SCOPE_AGENT);
}

__device__ __forceinline__ void nsa_unit(const Params& P, char* lds, int b, int g, int qt) {
    unsigned char* ws = P.ws;
    int tid = threadIdx.x; asm volatile("" : "+v"(tid));
    const int wave = __builtin_amdgcn_readfirstlane(tid >> 6), lane = tid & 63, r32 = lane & 31, hi = lane >> 5;
    const int head = wave & 3, h = g * 4 + head, tq0w = qt * 64 + (wave >> 2) * 32, tq = tq0w + r32;
    const int vb0 = (int)lds_addr(lds + AT_V) + v_rd_base(lane);
    const bf16_t* Qg = (const bf16_t*)(ws + WS_Q); const bf16_t* KV6 = (const bf16_t*)(ws + WS_KV6);
    const size_t tokrow = (size_t)b * SEQ + tq;
    bf16x8 qr[8];
#pragma unroll
    for (int d0 = 0; d0 < 8; ++d0) qr[d0] = *(const bf16x8*)(Qg + tokrow * DM + h * 128 + d0 * 16 + hi * 8);
    const float* gp = (const float*)(ws + WS_GATES) + tokrow * 48 + h * 3;
    const float sl2 = fast_exp2(-0.5f * (float)(h + 1)) * LOG2E;
    const float sl2_t = fast_exp2(-0.5f * (float)(g * 4 + ((tid >> 6) & 3) + 1)) * LOG2E;
    const float rowb = -sl2 * (float)tq;
    const float NEG = -__builtin_inff();
    bf16_t* Ob = (bf16_t*)(ws + WS_OATT) + ((size_t)b * SEQ + tq0w) * DM + h * 128;
    f32x16 o[4];
    {
        const KVAddr A = kv_addr(lds, tid, wave, 512 * 2);
        const bf16_t* Kc = (const bf16_t*)(ws + WS_KVCMP) + (size_t)b * 128 * 512 + g * 128;
        const bf16_t* Vc = Kc + (size_t)8 * 128 * 512;
        kv_issue<0>(A, Kc, Vc, 0, nullptr, wave, lane);
        kv_issue<1>(A, Kc, Vc, 64, nullptr, wave, lane);
        asm volatile("s_waitcnt vmcnt(0)" ::: "memory");
        __syncthreads();
        f32x16 p0, p1, p2, p3;
        attn_qkt<0>(p0, p1, lds + AT_K, r32, hi, qr);
        attn_qkt<1>(p2, p3, lds + AT_K, r32, hi, qr);
        const int lim = tq - 64 * hi; const float sb = -sl2 * (float)lim;
        float pmax = NEG;
#define CMP_BIAS(PX, N0) _Pragma("unroll") for (int r = 0; r < 16; ++r) { const int kc_ = 16 * ((N0) + (r & 3) + 8 * (r >> 2)) + 31; \
            const float v = fmaf(PX[r], LOG2E, fmaf(sl2, (float)kc_, sb)); PX[r] = (kc_ <= lim) ? v : NEG; pmax = fmaxf(pmax, PX[r]); }
        CMP_BIAS(p0, 0) CMP_BIAS(p1, 32) CMP_BIAS(p2, 64) CMP_BIAS(p3, 96)
#undef CMP_BIAS
        pmax = row_max2(pmax);
        const float mn = fmaxf(pmax, -1e30f);
        float ps = 0.f;
#pragma unroll
        for (int r = 0; r < 16; ++r) { p0[r] = fast_exp2(p0[r] - mn); p1[r] = fast_exp2(p1[r] - mn); p2[r] = fast_exp2(p2[r] - mn); p3[r] = fast_exp2(p3[r] - mn); ps += (p0[r] + p1[r]) + (p2[r] + p3[r]); }
        ps = row_sum2(ps);
        const float invl = ps > 0.f ? 1.f / ps : 0.f;
        {
            float* ia = (float*)(lds + AT_IMP) + (head * 64 + (wave >> 2) * 32 + r32) * 65;
#define IMP_W(PX, J0) _Pragma("unroll") for (int g2 = 0; g2 < 4; ++g2) { const int jj = (J0) + 2 * g2 + hi; const float hb = 0.5f * PX[4 * g2 + 3] * invl; \
            ia[jj] = (PX[4 * g2] + PX[4 * g2 + 1] + PX[4 * g2 + 2]) * invl + hb; ia[32 + jj + 1] = hb; }
            IMP_W(p0, 0) IMP_W(p1, 8) IMP_W(p2, 16) IMP_W(p3, 24)
#undef IMP_W
            if (hi == 0) ia[32] = 0.f;
        }
#pragma unroll
        for (int d0 = 0; d0 < 4; ++d0) o[d0] = f32x16{};
        bf16x8 pa0, pa1, pa2, pa3;
        PK4(p0, 0, pa0); PK4(p0, 8, pa1); PK4(p1, 0, pa2); PK4(p1, 8, pa3);
        attn_pv<0>(o, vb0, pa0, pa1, pa2, pa3);
        PK4(p2, 0, pa0); PK4(p2, 8, pa1); PK4(p3, 0, pa2); PK4(p3, 8, pa3);
        attn_pv<1>(o, vb0, pa0, pa1, pa2, pa3);
        __syncthreads();
        attn_store<false>(Ob, o, lds, gp[0] * invl, wave, lane, r32, hi);
    }
    __syncthreads();
    {
        const float* ia = (const float*)(lds + AT_IMP);
        float* vals = (float*)(lds + AT_VALS);
        unsigned* selm = (unsigned*)(lds + AT_SEL);
        const int jb = tid & 31;
        float myv[4];
#pragma unroll
        for (int pass = 0; pass < 4; ++pass) {
            const int tokl = (tid >> 5) + 16 * pass;
            float v = 0.f;
#pragma unroll
            for (int hh = 0; hh < 4; ++hh) { const float* q = ia + (hh * 64 + tokl) * 65; v += q[jb] + q[32 + jb]; }
            const bool forced = (jb == 0) || (jb == qt) || (jb == qt - 1);
            v = (jb > qt) ? NEG : (forced ? __builtin_inff() : v);
            vals[tokl * 33 + jb] = v; myv[pass] = v;
        }
        __syncthreads();
#pragma unroll
        for (int pass = 0; pass < 4; ++pass) {
            const int tokl = (tid >> 5) + 16 * pass;
            const float v = myv[pass]; int rank = 0;
#pragma unroll 8
            for (int i = 0; i < 32; ++i) { const float vi = vals[tokl * 33 + i]; rank += (vi > v || (vi == v && i < jb)) ? 1 : 0; }
            const unsigned long long bal = __ballot(rank < 16);
            if ((lane & 31) == 0) selm[tokl] = (lane < 32) ? (unsigned)bal : (unsigned)(bal >> 32);
        }
        __syncthreads();
        if (tid < 64) { unsigned mk = selm[tid];
#pragma unroll
            for (int of = 32; of >= 1; of >>= 1) mk |= __shfl_xor(mk, of);
            if (tid == 0) selm[64] = mk; }
        __syncthreads();
    }
    const unsigned causal_bits = (qt >= 31) ? 0xffffffffu : ((2u << qt) - 1u);
    const unsigned selw = ((const unsigned*)(lds + AT_SEL))[(wave >> 2) * 32 + r32];
    const unsigned um = ((const unsigned*)(lds + AT_SEL))[64] & causal_bits;
    const KVAddr A = kv_addr(lds, tid, wave, KV6_W * 2);
    {
#pragma unroll
        for (int d0 = 0; d0 < 4; ++d0) o[d0] = f32x16{};
        float m_reg = -1e30f, l_reg = 0.f;
        const bf16_t* Kp = KV6 + (size_t)b * SEQ * KV6_W + 2 * 512 + g * 128;
        attn_branch<true, true>(lds, A, qr, o, m_reg, l_reg, um, Kp, Kp + 512, nullptr, sl2_t, rowb, selw, tq, tq0w, 1u << 30, wave, lane, r32, hi, vb0, sl2);
        attn_store<true>(Ob, o, lds, l_reg > 0.f ? gp[1] / l_reg : 0.f, wave, lane, r32, hi);
    }
    {
#pragma unroll
        for (int d0 = 0; d0 < 4; ++d0) o[d0] = f32x16{};
        float m_reg = -1e30f, l_reg = 0.f;
        const bf16_t* Kp = KV6 + (size_t)b * SEQ * KV6_W + 4 * 512 + g * 128;
        const unsigned wmask = causal_bits & ~((qt > 8) ? ((1u << (qt - 8)) - 1u) : 0u);
        attn_branch<false, true>(lds, A, qr, o, m_reg, l_reg, wmask, Kp, Kp + 512, nullptr, sl2_t, rowb, 0u, tq, tq0w, 512u, wave, lane, r32, hi, vb0, sl2);
        attn_store<true, kFp8O>(Ob, o, lds, l_reg > 0.f ? gp[2] / l_reg : 0.f, wave, lane, r32, hi, (unsigned*)(ws + WS_CTL) + CW_AC + (0 * 64 + b * 8 + (qt >> 2)) * 16,
                                ws + WS_OATT8 + ((size_t)b * SEQ + tq0w) * DM + h * 128);
    }
}
__device__ __forceinline__ void fox_unit(const Params& P, char* lds, int b, int kvh, int qt) {
    unsigned char* ws = P.ws;
    int tid = threadIdx.x; asm volatile("" : "+v"(tid));
    const int wave = __builtin_amdgcn_readfirstlane(tid >> 6), lane = tid & 63, r32 = lane & 31, hi = lane >> 5;
    const int head = wave & 3, h = kvh * 4 + head, tq0w = qt * 64 + (wave >> 2) * 32, tq = tq0w + r32;
    const int vb0 = (int)lds_addr(lds + AT_V) + v_rd_base(lane);
    const bf16_t* Qg = (const bf16_t*)(ws + WS_Q);
    const size_t tokrow = (size_t)b * SEQ + tq;
    bf16x8 qr[8];
#pragma unroll
    for (int d0 = 0; d0 < 8; ++d0) qr[d0] = *(const bf16x8*)(Qg + tokrow * DM + h * 128 + d0 * 16 + hi * 8);
    const float* ctab = (const float*)(ws + WS_C2) + ((size_t)b * 16 + kvh * 4) * SEQ;
    const float rowb = ctab[head * SEQ + tq];
    f32x16 o[4];
#pragma unroll
    for (int d0 = 0; d0 < 4; ++d0) o[d0] = f32x16{};
    float m_reg = -1e30f, l_reg = 0.f;
    const bf16_t* Kp = (const bf16_t*)(ws + WS_KV2) + (size_t)b * SEQ * 1024 + kvh * 128;
    const unsigned causal_bits = (qt >= 31) ? 0xffffffffu : ((2u << qt) - 1u);
    const KVAddr A = kv_addr(lds, tid, wave, 1024 * 2);
    { TIMER_BEGIN(6);
    attn_branch<false, false>(lds, A, qr, o, m_reg, l_reg, causal_bits, Kp, Kp + 512, ctab, 0.f, rowb, 0u, tq, tq0w, 1u << 30, wave, lane, r32, hi, vb0, 0.f);
    TIMER_END(6, lds); }
    bf16_t* Ob = (bf16_t*)(ws + WS_OATT) + ((size_t)b * SEQ + tq0w) * DM + h * 128;
    attn_store<false, kFp8O>(Ob, o, lds, l_reg > 0.f ? 1.f / l_reg : 0.f, wave, lane, r32, hi, (unsigned*)(ws + WS_CTL) + CW_AC + (1 * 64 + b * 8 + (qt >> 2)) * 16,
                             ws + WS_OATT8 + ((size_t)b * SEQ + tq0w) * DM + h * 128);
}
__device__ __forceinline__ void attn_unit_decode(int u, int& b, int& g, int& qt) {
    const int rnd = u >> 8, c = u & 255, k = c >> 5, j = c & 31;
    b = j >> 2; g = j & 3;
    qt = (rnd == 0) ? 31 - k : (rnd == 1) ? 16 + k : (rnd == 2) ? 15 - k : k;
}

__device__ __forceinline__ void rowgemm64(const bf16_t* X, int row0, const float* W, float* part, float* ssp) {
    const int tid = threadIdx.x, wave = tid >> 6, lane = tid & 63, m = lane & 31, jh = lane >> 5;
    const int rgrp = wave & 1, kq = wave >> 1;
    const bf16_t* xr = X + (size_t)(row0 + rgrp * 32 + m) * DM + kq * 512 + 4 * jh;
    const float* wp = W + (size_t)(kq * 512 + 4 * jh) * 32 + m;
    f32x16 acc = {};
    float ss = 0.f;
#pragma unroll 4
    for (int i = 0; i < 64; ++i) {
        const u32x2 xw = *(const u32x2*)(xr + 8 * i); const f32x4 xv = {bflo(xw[0]), bfhi(xw[0]), bflo(xw[1]), bfhi(xw[1])};
        const float w0 = wp[(8 * i + 0) * 32], w1 = wp[(8 * i + 1) * 32], w2 = wp[(8 * i + 2) * 32], w3 = wp[(8 * i + 3) * 32];
        acc = __builtin_amdgcn_mfma_f32_32x32x2f32(xv[0], w0, acc, 0, 0, 0);
        acc = __builtin_amdgcn_mfma_f32_32x32x2f32(xv[1], w1, acc, 0, 0, 0);
        acc = __builtin_amdgcn_mfma_f32_32x32x2f32(xv[2], w2, acc, 0, 0, 0);
        acc = __builtin_amdgcn_mfma_f32_32x32x2f32(xv[3], w3, acc, 0, 0, 0);
        ss += xv[0] * xv[0] + xv[1] * xv[1] + xv[2] * xv[2] + xv[3] * xv[3];
    }
    float* pw = part + wave * (32 * 33);
#pragma unroll
    for (int r = 0; r < 16; ++r) pw[crow(r, jh) * 33 + m] = acc[r];
    ss += __shfl_xor(ss, 32);
    if (jh == 0) ssp[wave * 32 + m] = ss;
}
__device__ __forceinline__ void phase_router(const Params& P, unsigned char* lds, int layer) {
    unsigned char* ws = P.ws;
    const int tid = threadIdx.x;
    float* part = (float*)lds;
    float* ssp = (float*)(lds + 34816);
    float* lg = (float*)(lds + 36864);
    float* sl = (float*)(lds + 36864 + 8448);
    int* lcnt = (int*)(lds + 36864 + 2 * 8448);
    int* asg = lcnt + 64;
    const bf16_t* X = (const bf16_t*)(ws + WS_XBB);
    const float* W = (const float*)(ws + WS_RW) + (size_t)layer * 2048 * 32;
    float* rstd_out = (float*)(ws + WS_RSTD) + (layer ? 2 * NTOK : 0);
    float* ew = (float*)(ws + WS_EW) + (size_t)layer * NTOK * 2;
    unsigned* gcnt = (unsigned*)(ws + WS_CTL) + CW_CNT + layer * 32 * 64;
    int* lists = (int*)(ws + WS_LIST) + (size_t)layer * 32 * LISTCAP;
    for (int rg = blockIdx.x; rg < NTOK / 64; rg += gridDim.x) {
        const int row0 = rg * 64;
        {
            if (tid < 64) {
                unsigned* cnt = (unsigned*)(ws + WS_CTL) + CW_PC + (layer * 64 + (rg >> 2)) * 16; unsigned* tmo = (unsigned*)(ws + WS_CTL) + CW_BAR + XB_TMO; unsigned sp = 0;
                while ((unsigned)__builtin_amdgcn_readfirstlane(__hip_atomic_load(cnt, __ATOMIC_RELAXED, __HIP_MEMORY_SCOPE_AGENT)) < 8u) {
                    __builtin_amdgcn_s_sleep(1);
                    if ((++sp & 255u) == 0u) { if (xb_ld(tmo)) break; if (sp > XB_SPIN_CAP) { if (tid == 0) atomicAdd(tmo, 1u); break; } } }
                __builtin_amdgcn_fence(__ATOMIC_ACQUIRE, "agent");
                asm volatile("s_waitcnt vmcnt(0)" ::: "memory");
            }
            __syncthreads();
        }
        if (tid < 32) lcnt[tid] = 0;
        rowgemm64(X, row0, W, part, ssp);
        __syncthreads();
        if (tid < 64) {
            const int rgrp = tid >> 5, mloc = tid & 31;
            float ss = 0.f;
#pragma unroll
            for (int kq = 0; kq < 4; ++kq) ss += ssp[(kq * 2 + rgrp) * 32 + mloc];
            const float rstd = rsqrtf(ss * (1.f / DM) + RMS_EPS);
            rstd_out[row0 + tid] = rstd;
            float mx = -__builtin_inff();
            for (int e = 0; e < 32; ++e) {
                float d = 0.f;
#pragma unroll
                for (int kq = 0; kq < 4; ++kq) d += part[(kq * 2 + rgrp) * (32 * 33) + mloc * 33 + e];
                d *= rstd; lg[tid * 33 + e] = d; mx = fmaxf(mx, d);
            }
            float sum = 0.f;
            for (int e = 0; e < 32; ++e) { const float p = __expf(lg[tid * 33 + e] - mx); lg[tid * 33 + e] = p; sum += p; }
            const float inv = 1.f / sum;
            for (int e = 0; e < 32; ++e) { const float p = lg[tid * 33 + e] * inv; lg[tid * 33 + e] = p; sl[tid * 33 + e] = p + P.in[17][e]; }
            int bestg = 0; float bests = -__builtin_inff();
            for (int gq = 0; gq < 4; ++gq) {
                float t1 = -__builtin_inff(), t2 = -__builtin_inff();
                for (int i = 0; i < 8; ++i) { const float v = sl[tid * 33 + gq * 8 + i]; if (v > t1) { t2 = t1; t1 = v; } else if (v > t2) t2 = v; }
                const float sc = t1 + t2;
                if (sc > bests) { bests = sc; bestg = gq; }
            }
            int i1 = 0, i2 = 0; float v1 = -__builtin_inff(), v2 = -__builtin_inff();
            for (int i = 0; i < 8; ++i) { const float v = sl[tid * 33 + bestg * 8 + i]; if (v > v1) { v2 = v1; i2 = i1; v1 = v; i1 = i; } else if (v > v2) { v2 = v; i2 = i; } }
            const int e1 = bestg * 8 + i1, e2 = bestg * 8 + i2;
            const float p1 = lg[tid * 33 + e1], p2 = lg[tid * 33 + e2], ip = 1.f / (p1 + p2);
            ew[(size_t)(row0 + tid) * 2 + 0] = p1 * ip; ew[(size_t)(row0 + tid) * 2 + 1] = p2 * ip;
            asg[tid * 2 + 0] = e1; asg[tid * 2 + 1] = e2;
            asg[128 + tid * 2 + 0] = atomicAdd(&lcnt[e1], 1); asg[128 + tid * 2 + 1] = atomicAdd(&lcnt[e2], 1);
        }
        __syncthreads();
        if (tid < 32) { const int c = lcnt[tid]; lcnt[32 + tid] = c ? (int)__hip_atomic_fetch_add(gcnt + tid * 64, (unsigned)c, __ATOMIC_RELAXED, __HIP_MEMORY_SCOPE_AGENT) : 0; }
        __syncthreads();
        if (tid < 128) { const int e = asg[tid], pos = lcnt[32 + e] + asg[128 + tid]; if (pos < LISTCAP) lists[(size_t)e * LISTCAP + pos] = (row0 + (tid >> 1)) * 2 + (tid & 1); }
        __syncthreads();
    }
}
__device__ __forceinline__ void phase_combine0(const Params& P, unsigned char* lds) {
    unsigned char* ws = P.ws;
    const int tid = threadIdx.x, wave = tid >> 6, lane = tid & 63;
    float* part = (float*)lds; float* ssp = (float*)(lds + 34816); float* rs = (float*)(lds + 36864);
    const bf16_t* X1 = (const bf16_t*)(ws + WS_XBB); bf16_t* XB = (bf16_t*)(ws + WS_XBA);
    const bf16_t* Y = (const bf16_t*)(ws + WS_Y); const float* ew = (const float*)(ws + WS_EW);
    float* rstd_out = (float*)(ws + WS_RSTD) + NTOK;
    for (int rg = blockIdx.x; rg < NTOK / 64; rg += gridDim.x) {
        const int row0 = rg * 64;
        for (int q = 0; q < 8; ++q) {
            const int row = row0 + wave * 8 + q;
            const float w0 = ew[(size_t)row * 2], w1 = ew[(size_t)row * 2 + 1];
            float ss = 0.f;
#pragma unroll
            for (int j = 0; j < 8; ++j) {
                const size_t off = (size_t)row * DM + j * 256 + lane * 4;
                const u32x2 xo = *(const u32x2*)(X1 + off); f32x4 v = {bflo(xo[0]), bfhi(xo[0]), bflo(xo[1]), bfhi(xo[1])};
                const u32x2 y0 = *(const u32x2*)(Y + (size_t)(2 * row) * DM + j * 256 + lane * 4), y1 = *(const u32x2*)(Y + (size_t)(2 * row + 1) * DM + j * 256 + lane * 4);
                v[0] += w0 * bflo(y0[0]) + w1 * bflo(y1[0]); v[1] += w0 * bfhi(y0[0]) + w1 * bfhi(y1[0]);
                v[2] += w0 * bflo(y0[1]) + w1 * bflo(y1[1]); v[3] += w0 * bfhi(y0[1]) + w1 * bfhi(y1[1]);
                __hip_atomic_store((unsigned long long*)(XB + off), ((unsigned long long)cvtpk(v[2], v[3]) << 32) | cvtpk(v[0], v[1]), __ATOMIC_RELAXED, __HIP_MEMORY_SCOPE_AGENT);
                if (kFp8P) { unsigned w8 = 0; w8 = __builtin_amdgcn_cvt_pk_fp8_f32(v[0], v[1], w8, false); w8 = __builtin_amdgcn_cvt_pk_fp8_f32(v[2], v[3], w8, true); __hip_atomic_store((unsigned*)(ws + WS_XA8 + off), w8, __ATOMIC_RELAXED, __HIP_MEMORY_SCOPE_AGENT); }
                ss += v[0] * v[0] + v[1] * v[1] + v[2] * v[2] + v[3] * v[3];
            }
            ss = wave_sum(ss);
            const float rstd = rsqrtf(ss * (1.f / DM) + RMS_EPS);
            if (lane == 0) { __hip_atomic_store((unsigned*)(rstd_out + row), __float_as_uint(rstd), __ATOMIC_RELAXED, __HIP_MEMORY_SCOPE_AGENT); rs[wave * 8 + q] = rstd; }
        }
        asm volatile("s_waitcnt vmcnt(0)" ::: "memory");
        __syncthreads();
        rowgemm64(XB, row0, (const float*)(ws + WS_WF), part, ssp);
        __syncthreads();
        for (int i = tid; i < 64 * 16; i += NTHREADS) {
            const int r = i >> 4, j = i & 15, rgrp = r >> 5, mloc = r & 31;
            float d = 0.f;
#pragma unroll
            for (int kq = 0; kq < 4; ++kq) d += part[(kq * 2 + rgrp) * (32 * 33) + mloc * 33 + j];
            const float z = d * rs[r] + P.in[11][j];
            __hip_atomic_store((unsigned*)(ws + WS_LOGF) + (size_t)(row0 + r) * 16 + j, __float_as_uint(fminf(z, 0.f) - log1pf(__expf(-fabsf(z)))), __ATOMIC_RELAXED, __HIP_MEMORY_SCOPE_AGENT);
        }
        asm volatile("s_waitcnt vmcnt(0)" ::: "memory"); __syncthreads();
        if (tid == 0) { __hip_atomic_fetch_add((unsigned*)(ws + WS_CTL) + CW_CC + (rg >> 2) * 16, 1u, __ATOMIC_RELAXED, __HIP_MEMORY_SCOPE_AGENT);
                        __hip_atomic_fetch_add((unsigned*)(ws + WS_CTL) + CW_CC + (64 + (rg >> 5)) * 16, 1u, __ATOMIC_RELAXED, __HIP_MEMORY_SCOPE_AGENT); }
    }
}
__device__ __forceinline__ void phase_final(const Params& P) {
    unsigned char* ws = P.ws;
    const int tid = threadIdx.x, wave = tid >> 6, lane = tid & 63;
    const bf16_t* X3 = (const bf16_t*)(ws + WS_XBB); const bf16_t* Y = (const bf16_t*)(ws + WS_Y); const float* ew = (const float*)(ws + WS_EW) + (size_t)NTOK * 2;
    const float* gain = P.in[21];
    for (int row = blockIdx.x * 8 + wave; row < NTOK; row += gridDim.x * 8) {
        const float w0 = ew[(size_t)row * 2], w1 = ew[(size_t)row * 2 + 1];
        f32x4 v[8]; float ss = 0.f;
#pragma unroll
        for (int j = 0; j < 8; ++j) {
            const size_t off = (size_t)row * DM + j * 256 + lane * 4;
            { const u32x2 xo = *(const u32x2*)(X3 + off); v[j] = (f32x4){bflo(xo[0]), bfhi(xo[0]), bflo(xo[1]), bfhi(xo[1])}; }
            const u32x2 y0 = *(const u32x2*)(Y + (size_t)(2 * row) * DM + j * 256 + lane * 4), y1 = *(const u32x2*)(Y + (size_t)(2 * row + 1) * DM + j * 256 + lane * 4);
            v[j][0] += w0 * bflo(y0[0]) + w1 * bflo(y1[0]); v[j][1] += w0 * bfhi(y0[0]) + w1 * bfhi(y1[0]);
            v[j][2] += w0 * bflo(y0[1]) + w1 * bflo(y1[1]); v[j][3] += w0 * bfhi(y0[1]) + w1 * bfhi(y1[1]);
            ss += v[j][0] * v[j][0] + v[j][1] * v[j][1] + v[j][2] * v[j][2] + v[j][3] * v[j][3];
        }
        ss = wave_sum(ss);
        const float rstd = rsqrtf(ss * (1.f / DM) + RMS_EPS);
#pragma unroll
        for (int j = 0; j < 8; ++j) {
            const f32x4 gv = *(const f32x4*)(gain + j * 256 + lane * 4);
            *(f32x4*)(P.out + (size_t)row * DM + j * 256 + lane * 4) = v[j] * rstd * gv;
        }
    }
}

__global__ void __launch_bounds__(NTHREADS, 2) yoco_fwd(Params P) {
    extern __shared__ __attribute__((aligned(16))) unsigned char lds[];
    unsigned char* ws = P.ws;
    const int lo = P.ph_lo, hi = P.ph_hi;
    XcdBarrier bar; bar.bar = (unsigned*)(ws + WS_CTL) + CW_BAR; bar.x = 0; bar.st = nullptr;
    const bool one = (hi - lo) > 1;
    if (TIMER_MODE != 0 && threadIdx.x == 0) *(volatile unsigned*)(lds + TIMER_LDS_OFF) = 0u;
    if (one) {
        if (threadIdx.x < 4) ((unsigned*)(lds + LDS_BYTES - 16))[threadIdx.x] = 0u;
        __syncthreads();
        bar = xcd_barrier_post((unsigned*)(ws + WS_CTL) + CW_BAR, (volatile LAS unsigned*)(lds + LDS_BYTES - 16));
    }
#ifdef ONLY_PHASE
#define IN(k) ((k) == ONLY_PHASE && lo <= (k) && (k) < hi)
#else
#define IN(k) (lo <= (k) && (k) < hi)
#endif
#define SEAM(k) do { if (IN(k) && IN((k) + 1)) { TIMER_BEGIN(1); xcd_barrier(bar); TIMER_END(1, lds); } } while (0)
#ifndef REP_MASK
#define REP_MASK 0
#endif
#define RUN(k, ...) do { if (IN(k)) { if (TIMER_MODE != 0 && threadIdx.x == 0) ((volatile unsigned*)(lds + TIMER_LDS_OFF))[1] = (unsigned)(k); TIMER_BEGIN(5); __VA_ARGS__; TIMER_END(5, lds); if ((REP_MASK >> (k)) & 1) { xcd_barrier(bar); __VA_ARGS__; } } SEAM(k); } while (0)
    RUN(0, { phase_convert(P, lds, 0, NJOBS); phase0_misc(P, lds); });
    RUN(1, phase_proj0(P, lds));
    RUN(2, phase_cmp1(P, lds));
    RUN(3, phase_cmp2(P, lds));
    RUN(4, { for (int u = blockIdx.x; u < 1024; u += gridDim.x) { int b, g, qt; attn_unit_decode(u, b, g, qt); nsa_unit(P, (char*)lds, b, g, qt); }
             phase_outproj<false>(P, lds, WS_WOUT, P.in[0], (bf16_t*)(ws + WS_XBB), kFp8[0] ? (unsigned char*)(ws + WS_XB8) : nullptr, 0);
             phase_router(P, lds, 0); });
    if (kFp8[0]) { RUN(7, { phase_moe_gu<kFp8[0]>(P, lds, 0); phase_moe_dn<kFp8[0]>(P, lds, 0); }); }
    else { RUN(7, phase_moe_gu<kFp8[0]>(P, lds, 0)); RUN(8, phase_moe_dn<kFp8[0]>(P, lds, 0)); }
    RUN(9, { phase_combine0(P, lds); phase_kvq(P, lds); });
    RUN(11, { for (int u = blockIdx.x; u < 1024; u += gridDim.x) { int b, g, qt; attn_unit_decode(u, b, g, qt); fox_unit(P, (char*)lds, b, g, qt); }
              phase_outproj<true>(P, lds, WS_WFO, (const void*)(ws + WS_XBA), (bf16_t*)(ws + WS_XBB), kFp8[1] ? (unsigned char*)(ws + WS_XB8) : nullptr, 1);
              phase_router(P, lds, 1); });
    if (kFp8[1]) { RUN(14, { phase_moe_gu<kFp8[1]>(P, lds, 1); phase_moe_dn<kFp8[1]>(P, lds, 1); }); }
    else { RUN(14, phase_moe_gu<kFp8[1]>(P, lds, 1)); RUN(15, phase_moe_dn<kFp8[1]>(P, lds, 1)); }
    RUN(16, phase_final(P));
#undef RUN
    if (TIMER_MODE != 0 && blockIdx.x == TIMER_BLOCK && threadIdx.x == 0) {
        const unsigned acc_ = *(volatile unsigned*)(lds + TIMER_LDS_OFF) + 30000u; const unsigned long long t0_ = rt_now();
        while (rt_now() - t0_ < (unsigned long long)acc_) __builtin_amdgcn_s_sleep(8);
    }
#undef IN
#undef SEAM
}

}

extern "C" void kernel_launch(void* const* d_in, const int* in_sizes, int n_in, void* d_out, int out_size, void* d_ws, size_t ws_size, hipStream_t stream) {
    static int grid = 0;
    if (grid == 0) {
        if (n_in != 22 || in_sizes[0] != NTOK * DM || out_size != NTOK * DM || ws_size < WS_END) {
            fprintf(stderr, "kernel_launch: unexpected shapes (n_in %d, in0 %d, out %d, ws %zu < %zu)\n", n_in, n_in > 0 ? in_sizes[0] : -1, out_size, ws_size, (size_t)WS_END); grid = -1; return; }
        int dev = 0, cus = 0, per_cu = 0;
        (void)hipGetDevice(&dev); (void)hipDeviceGetAttribute(&cus, hipDeviceAttributeMultiprocessorCount, dev);
        if (hipFuncSetAttribute((const void*)yoco_fwd, hipFuncAttributeMaxDynamicSharedMemorySize, LDS_BYTES) != hipSuccess) { fprintf(stderr, "kernel_launch: hipFuncSetAttribute failed\n"); grid = -1; return; }
        if (hipOccupancyMaxActiveBlocksPerMultiprocessor(&per_cu, (const void*)yoco_fwd, NTHREADS, LDS_BYTES) != hipSuccess || per_cu < 1) { fprintf(stderr, "kernel_launch: occupancy query says %d\n", per_cu); }
        (void)hipGetLastError();
        grid = cus > 0 ? cus : 256;
    }
    if (grid < 0) return;
    (void)hipMemsetAsync((char*)d_ws + WS_CTL, 0, CTL_BYTES, stream);
    Params p{};
    for (int i = 0; i < 22; ++i) p.in[i] = (const float*)d_in[i];
    p.out = (float*)d_out; p.ws = (unsigned char*)d_ws;
#if MK_LAUNCHES == 1
    p.ph_lo = 0; p.ph_hi = NPHASES;
    hipLaunchKernelGGL(yoco_fwd, dim3(grid), dim3(NTHREADS), LDS_BYTES, stream, p);
#else
    for (int k = 0; k < NPHASES; ++k) { p.ph_lo = k; p.ph_hi = k + 1; hipLaunchKernelGGL(yoco_fwd, dim3(grid), dim3(NTHREADS), LDS_BYTES, stream, p); }
#endif
}
```
